# Optimizing an MI355X kernel written in HIP

```python
import math, functools
import jax, jax.numpy as jnp
from jax import lax
import numpy as np

D_MODEL = 2048
BATCH = 32
SEQ = 256
DEPTH = 2
DEC_BATCH = 2
DEC_SEQ = 4096
PAST_LEN = 256

GRID_W = 64
HEAD_DIM = 128
A_HEADS = 8
A_KV_HEADS = 2
A_GROUP = A_HEADS // A_KV_HEADS
B_HEADS = 4
B_V_DIM = 2 * HEAD_DIM
ATTN_SPLITS = [A_HEADS * HEAD_DIM, A_KV_HEADS * HEAD_DIM, A_KV_HEADS * HEAD_DIM,
               B_HEADS * 2 * HEAD_DIM, B_HEADS * 2 * HEAD_DIM, B_HEADS * B_V_DIM]
ATTN_IN = sum(ATTN_SPLITS)
Q_BLOCK = 128
ROPE_BASE = 10000.0
ROPE_PAIRS_PER_AXIS = HEAD_DIM // 4
S5_GROUP_CH = 16
S5_GROUPS = D_MODEL // S5_GROUP_CH
S5_STATE = 64
D_FF = 4 * D_MODEL
N_ATTN_LAYERS = (DEPTH + 1) // 2
N_SSM_LAYERS = DEPTH // 2
N_MOD = 6
EPS = 1e-6
F32 = jnp.float32

kernel_name = "hybrid_diffusion_gqa_diffattn_s5_step"


def _rms(x, g):
    xf = x.astype(F32)
    y = xf * lax.rsqrt(jnp.mean(xf * xf, axis=-1, keepdims=True) + EPS)
    return (y * g.astype(F32)).astype(x.dtype)


def _modulation(cond, ada_w, ada_b):
    m = jax.nn.silu(cond) @ ada_w + ada_b
    return [t[:, None, :] for t in jnp.split(m, N_MOD, axis=-1)]


def _modulate(x, g, shift, scale):
    return _rms(x, g) * (1.0 + scale) + shift


def _mlp(n, w1, w2):
    h = jax.nn.relu(n @ w1)
    return (h * h) @ w2


def _axial_rope(L):
    rows = L // GRID_W
    row = jnp.repeat(jnp.arange(rows, dtype=F32), GRID_W)
    col = jnp.tile(jnp.arange(GRID_W, dtype=F32), rows)
    inv = ROPE_BASE ** (-jnp.arange(ROPE_PAIRS_PER_AXIS, dtype=F32) / ROPE_PAIRS_PER_AXIS)
    ang = jnp.concatenate([row[:, None] * inv, col[:, None] * inv], axis=-1)
    return jnp.cos(ang), jnp.sin(ang)


def _apply_rope(x, rope):
    cos, sin = rope
    shp = (1, x.shape[1]) + (1,) * (x.ndim - 3) + (HEAD_DIM // 2,)
    cos, sin = cos.reshape(shp), sin.reshape(shp)
    xf = x.astype(F32)
    x1, x2 = xf[..., :HEAD_DIM // 2], xf[..., HEAD_DIM // 2:]
    return jnp.concatenate([x1 * cos - x2 * sin, x1 * sin + x2 * cos], axis=-1).astype(x.dtype)


def _attn_qkv(n, w_in, qk_g, rope):
    B, L, _ = n.shape
    idx = [int(i) for i in np.cumsum(ATTN_SPLITS)[:-1]]
    qa, ka, va, qb, kb, vb = jnp.split(n @ w_in, idx, axis=-1)
    qa = _rms(qa.reshape(B, L, A_HEADS, HEAD_DIM), qk_g[0])
    ka = _rms(ka.reshape(B, L, A_KV_HEADS, HEAD_DIM), qk_g[1])
    va = va.reshape(B, L, A_KV_HEADS, HEAD_DIM)
    qb = qb.reshape(B, L, B_HEADS, 2, HEAD_DIM)
    kb = kb.reshape(B, L, B_HEADS, 2, HEAD_DIM)
    vb = vb.reshape(B, L, B_HEADS, B_V_DIM)
    if rope is not None:
        qa, ka, qb, kb = (_apply_rope(t, rope) for t in (qa, ka, qb, kb))
    return qa, ka, va, qb, kb, vb


def _gqa_block(q, k, v):
    B, Q = q.shape[:2]
    qg = q.reshape(B, Q, A_KV_HEADS, A_GROUP, HEAD_DIM)
    s = jnp.einsum("bqhgd,bkhd->bhgqk", qg, k).astype(F32) * (HEAD_DIM ** -0.5)
    p = jax.nn.softmax(s, axis=-1).astype(v.dtype)
    o = jnp.einsum("bhgqk,bkhd->bqhgd", p, v)
    return o.reshape(B, Q, A_HEADS * HEAD_DIM)


def _diff_block(q, k, v, lam):
    s = jnp.einsum("bqhmd,bkhmd->bhmqk", q, k).astype(F32) * (HEAD_DIM ** -0.5)
    p = jax.nn.softmax(s, axis=-1)
    w = (p[:, :, 0] - lam * p[:, :, 1]).astype(v.dtype)
    return jnp.einsum("bhqk,bkhe->bqhe", w, v)


def _sweep(fn, q):
    B, L = q.shape[:2]
    nb = L // Q_BLOCK
    qb = jnp.moveaxis(q.reshape((B, nb, Q_BLOCK) + q.shape[2:]), 1, 0)
    o = lax.map(fn, qb)
    return jnp.moveaxis(o, 0, 1).reshape((B, L) + o.shape[3:])


def _attn_mix(qa, ka, va, qb, kb, vb, lam_p, lam_init, subln_g, w_out):
    lp = lam_p.astype(F32)
    lam = jnp.exp(jnp.sum(lp[0] * lp[1])) - jnp.exp(jnp.sum(lp[2] * lp[3])) + lam_init
    oa = _sweep(lambda q: _gqa_block(q, ka, va), qa)
    ob = _sweep(lambda q: _diff_block(q, kb, vb, lam), qb)
    ob = _rms(ob, subln_g) * (1.0 - lam_init)
    B, L = oa.shape[:2]
    o = jnp.concatenate([oa, ob.reshape(B, L, B_HEADS * B_V_DIM)], axis=-1)
    return o @ w_out


def _ssm_combine(x, y):
    a1, b1 = x
    a2, b2 = y
    return a1 * a2, a2 * b1 + b2


def _s5_scan(u, a_re, a_im, log_dt, b_re, b_im, c_re, c_im, h0):
    Bsz, L, _ = u.shape
    lam = lax.complex(a_re.astype(F32), a_im.astype(F32))
    dt = jnp.exp(log_dt.astype(F32))[:, None]
    a_bar = jnp.exp(lam * dt)
    b_bar = ((a_bar - 1.0) / lam)[..., None] * lax.complex(b_re.astype(F32), b_im.astype(F32))
    ug = u.astype(F32).reshape(Bsz, L, S5_GROUPS, S5_GROUP_CH).astype(jnp.complex64)
    bu = jnp.einsum("gnc,blgc->blgn", b_bar, ug)
    if h0 is not None:
        bu = bu.at[:, 0].add(a_bar * h0)
    a_seq = jnp.broadcast_to(a_bar, bu.shape)
    _, h = lax.associative_scan(_ssm_combine, (a_seq, bu), axis=1)
    cc = lax.complex(c_re.astype(F32), c_im.astype(F32))
    y = jnp.einsum("gcn,blgn->blgc", cc, h).real
    return y.reshape(Bsz, L, D_MODEL), h[:, -1]


def _ssm_mix(n, sp, h0):
    w_in, a_re, a_im, log_dt, b_re, b_im, c_re, c_im, d, glu_w, w_out = sp
    u = n @ w_in
    per_dir = lambda k: (a_re[k], a_im[k], log_dt[k], b_re[k], b_im[k], c_re[k], c_im[k])
    y_f, h_f = _s5_scan(u, *per_dir(0), None if h0 is None else h0[:, 0])
    y_b, h_b = _s5_scan(u[:, ::-1], *per_dir(1), None if h0 is None else h0[:, 1])
    y = y_f + y_b[:, ::-1] + d.astype(F32) * u.astype(F32)
    z = jax.nn.gelu(y).astype(n.dtype)
    z = z * jax.nn.sigmoid(z @ glu_w)
    return z @ w_out, jnp.stack([h_f, h_b], axis=1)


def setup_inputs(seed: int = 0) -> dict:
    key = jax.random.key(seed)
    ks = iter(jax.random.split(key, 40))
    nrm = lambda shape, s: jax.random.normal(next(ks), shape, F32) * s
    D = D_MODEL
    G, N, C = S5_GROUPS, S5_STATE, S5_GROUP_CH
    return {
        "x_prompt": nrm((BATCH, SEQ, D), 1.0),
        "x_sample": nrm((DEC_BATCH, DEC_SEQ, D), 1.0),
        "c": nrm((DEC_BATCH, D), 1.0),
        "cache_a_k": nrm((DEC_BATCH, N_ATTN_LAYERS, PAST_LEN, A_KV_HEADS, HEAD_DIM), 1.0),
        "cache_a_v": nrm((DEC_BATCH, N_ATTN_LAYERS, PAST_LEN, A_KV_HEADS, HEAD_DIM), 1.0),
        "cache_b_k": nrm((DEC_BATCH, N_ATTN_LAYERS, PAST_LEN, B_HEADS, 2, HEAD_DIM), 1.0),
        "cache_b_v": nrm((DEC_BATCH, N_ATTN_LAYERS, PAST_LEN, B_HEADS, B_V_DIM), 1.0),
        "state_ssm": nrm((DEC_BATCH, N_SSM_LAYERS, 2, G, N, 2), 0.3),
        "c_ctx": nrm((D,), 1.0),
        "ada_w": nrm((DEPTH, D, N_MOD * D), D ** -0.5),
        "ada_b": nrm((DEPTH, N_MOD * D), 0.02),
        "norm_g": 1.0 + nrm((DEPTH, 4, D), 0.02),
        "mlp_w1": nrm((DEPTH, D, D_FF), D ** -0.5),
        "mlp_w2": nrm((DEPTH, D_FF, D), D_FF ** -0.5),
        "attn_w_in": nrm((N_ATTN_LAYERS, D, ATTN_IN), D ** -0.5),
        "attn_w_out": nrm((N_ATTN_LAYERS, D, D), D ** -0.5),
        "attn_qk_norm": 1.0 + nrm((N_ATTN_LAYERS, 2, HEAD_DIM), 0.02),
        "diff_lambda": nrm((N_ATTN_LAYERS, 4, HEAD_DIM), 0.1),
        "diff_subln": 1.0 + nrm((N_ATTN_LAYERS, B_V_DIM), 0.02),
        "ssm_w_in": nrm((N_SSM_LAYERS, D, D), D ** -0.5),
        "ssm_a_re": -0.5 + nrm((N_SSM_LAYERS, 2, G, N), 0.01),
        "ssm_a_im": math.pi * jnp.arange(N, dtype=F32) + nrm((N_SSM_LAYERS, 2, G, N), 0.01),
        "ssm_log_dt": jax.random.uniform(next(ks), (N_SSM_LAYERS, 2, G), F32, math.log(1e-3), math.log(1e-1)),
        "ssm_b_re": nrm((N_SSM_LAYERS, 2, G, N, C), (2 * C) ** -0.5),
        "ssm_b_im": nrm((N_SSM_LAYERS, 2, G, N, C), (2 * C) ** -0.5),
        "ssm_c_re": nrm((N_SSM_LAYERS, 2, G, C, N), (2 * N) ** -0.5),
        "ssm_c_im": nrm((N_SSM_LAYERS, 2, G, C, N), (2 * N) ** -0.5),
        "ssm_d": nrm((N_SSM_LAYERS, D), 1.0),
        "ssm_glu_w": nrm((N_SSM_LAYERS, D, D), D ** -0.5),
        "ssm_w_out": nrm((N_SSM_LAYERS, D, D), D ** -0.5),
    }


def reference(x_prompt, x_sample, c, cache_a_k, cache_a_v, cache_b_k, cache_b_v, state_ssm, c_ctx,
              ada_w, ada_b, norm_g, mlp_w1, mlp_w2, attn_w_in, attn_w_out, attn_qk_norm, diff_lambda,
              diff_subln, ssm_w_in, ssm_a_re, ssm_a_im, ssm_log_dt, ssm_b_re, ssm_b_im, ssm_c_re,
              ssm_c_im, ssm_d, ssm_glu_w, ssm_w_out):
    rope = _axial_rope(x_sample.shape[1])
    xp, xs = x_prompt, x_sample
    new_ak, new_av, new_bk, new_bv, new_ssm = [], [], [], [], []
    cat = lambda lat, ctx: jnp.concatenate([lat, ctx.astype(lat.dtype)], axis=1)
    for l in range(DEPTH):
        g = norm_g[l]
        mp = _modulation(c_ctx[None, :], ada_w[l], ada_b[l])
        ms = _modulation(c, ada_w[l], ada_b[l])
        n_p = _modulate(xp, g[0], mp[0], mp[1])
        n_s = _modulate(xs, g[0], ms[0], ms[1])
        i = l // 2
        if l % 2 == 0:
            lam_init = 0.8 - 0.6 * math.exp(-0.3 * l)
            mix = functools.partial(_attn_mix, lam_p=diff_lambda[i], lam_init=lam_init,
                                    subln_g=diff_subln[i], w_out=attn_w_out[i])
            qa, ka, va, qb, kb, vb = _attn_qkv(n_p, attn_w_in[i], attn_qk_norm[i], None)
            o_p = mix(qa, ka, va, qb, kb, vb)
            new_ak.append(ka)
            new_av.append(va)
            new_bk.append(kb)
            new_bv.append(vb)
            qa, ka, va, qb, kb, vb = _attn_qkv(n_s, attn_w_in[i], attn_qk_norm[i], rope)
            o_s = mix(qa, cat(ka, cache_a_k[:, i]), cat(va, cache_a_v[:, i]),
                      qb, cat(kb, cache_b_k[:, i]), cat(vb, cache_b_v[:, i]))
        else:
            sp = (ssm_w_in[i], ssm_a_re[i], ssm_a_im[i], ssm_log_dt[i], ssm_b_re[i], ssm_b_im[i],
                  ssm_c_re[i], ssm_c_im[i], ssm_d[i], ssm_glu_w[i], ssm_w_out[i])
            o_p, h_ctx = _ssm_mix(n_p, sp, None)
            new_ssm.append(jnp.stack([h_ctx.real, h_ctx.imag], axis=-1))
            st = state_ssm[:, i].astype(F32)
            o_s, _ = _ssm_mix(n_s, sp, lax.complex(st[..., 0], st[..., 1]))
        xp = xp + mp[2] * _rms(o_p, g[1])
        xs = xs + ms[2] * _rms(o_s, g[1])
        xp = xp + mp[5] * _rms(_mlp(_modulate(xp, g[2], mp[3], mp[4]), mlp_w1[l], mlp_w2[l]), g[3])
        xs = xs + ms[5] * _rms(_mlp(_modulate(xs, g[2], ms[3], ms[4]), mlp_w1[l], mlp_w2[l]), g[3])
    new_cache_a_k = jnp.stack(new_ak, axis=1)
    new_cache_a_v = jnp.stack(new_av, axis=1)
    new_cache_b_k = jnp.stack(new_bk, axis=1)
    new_cache_b_v = jnp.stack(new_bv, axis=1)
    new_state_ssm = jnp.stack(new_ssm, axis=1)
    return (xp, xs, new_cache_a_k, new_cache_a_v, new_cache_b_k, new_cache_b_v, new_state_ssm)
```

```cpp
#include <hip/hip_runtime.h>
#include <hip/hip_bf16.h>
#include <cstdio>
#include <cstdint>

typedef unsigned short bf16_t;
typedef float f32x4 __attribute__((ext_vector_type(4)));
typedef float f32x2 __attribute__((ext_vector_type(2)));
typedef unsigned u32x4 __attribute__((ext_vector_type(4)));
typedef unsigned u32x2 __attribute__((ext_vector_type(2)));

constexpr int D = 2048, MP = 8192, MS = 8192, M = MP + MS, NQKV = 4608, DFF = 8192;
constexpr int LQ = 4096, LKV = 4352, NMOD = 12288;
constexpr int KB_ROWS = MP + 2 * LKV;
constexpr int KVW = 1280;
constexpr int OW = 3072;
constexpr float EPS = 1e-6f;
constexpr int KCH = 16;

constexpr size_t OUT_Y = 0, OUT_AK = 33554432, OUT_AV = 35651584, OUT_BK = 37748736, OUT_BV = 46137344, OUT_ST = 54525952, OUT_END = 55574528;

constexpr size_t MiB = 1u << 20;
constexpr size_t WS_CTL = 0, WS_MODP = 1 * MiB, WS_MOD = 6 * MiB, WS_ABAR = 7 * MiB, WS_A256 = 7 * MiB + 512 * 1024, WS_BBAR = 8 * MiB, WS_CMAT = 9 * MiB,
                 WS_ROPE = 10 * MiB, WS_SST = 12 * MiB, WS_HIN = 16 * MiB, WS_W = 20 * MiB, WS_A1 = 200 * MiB, WS_A2 = 264 * MiB, WS_BIG = 328 * MiB,
                 WS_QH = 584 * MiB, WS_KB = 648 * MiB, WS_VB = 690 * MiB, WS_END = 732 * MiB;
constexpr size_t WS_BB4 = 16 * MiB, WS_A4 = 7 * MiB + 768 * 1024;
constexpr size_t WS_O = WS_BIG + 144 * MiB;

struct Params {
    const float *x_prompt, *x_sample, *c, *cache_a_k, *cache_a_v, *cache_b_k, *cache_b_v, *state_ssm, *c_ctx, *ada_w, *ada_b, *norm_g, *mlp_w1, *mlp_w2,
        *attn_w_in, *attn_w_out, *qk_norm, *diff_lambda, *diff_subln, *ssm_w_in, *ssm_a_re, *ssm_a_im, *ssm_log_dt, *ssm_b_re, *ssm_b_im, *ssm_c_re, *ssm_c_im,
        *ssm_d, *ssm_glu_w, *ssm_w_out;
    float* out; unsigned char* ws;
};

__device__ __forceinline__ float bf2f(bf16_t v) { return __uint_as_float((unsigned)v << 16); }
__device__ __forceinline__ unsigned f2bf(float f) { unsigned u = __float_as_uint(f); return (u + 0x7fffu + ((u >> 16) & 1u)) >> 16; }
__device__ __forceinline__ unsigned pk2(float lo, float hi) { unsigned r; asm("v_cvt_pk_bf16_f32 %0, %1, %2" : "=v"(r) : "v"(lo), "v"(hi)); return r; }
__device__ __forceinline__ float wave_sum(float v) {
#pragma unroll
    for (int o = 1; o < 64; o <<= 1) v += __shfl_xor(v, o);
    return v;
}
__device__ __forceinline__ int row_class(int m) { return m < MP ? 0 : 1 + ((m - MP) >> 12); }
template <class P> __device__ __forceinline__ const float* x_row(const P& p, int m) { return m < MP ? p.x_prompt + (size_t)m * D : p.x_sample + (size_t)(m - MP) * D; }

typedef const __attribute__((address_space(4))) Params CP;

namespace pg8 {
#define PG8_LAS __attribute__((address_space(3)))
typedef unsigned short bf16_t;
typedef short bf16x8 __attribute__((ext_vector_type(8)));
typedef float f32x4 __attribute__((ext_vector_type(4)));
typedef unsigned u32x4 __attribute__((ext_vector_type(4)));
constexpr int BM = 256, BK = 64, HALF = 128, HTB = HALF * BK * 2  , STAGE_BYTES = 8 * HTB, NXCD = 8, WGM = 4;

__host__ __device__ __forceinline__ int lds_byte(int r, int c) { const int st = (r >> 4) * 2 + (c >> 5), rr = r & 15, cc = c & 31, ob = rr * 64 + cc * 2; return st * 1024 + (ob ^ (((ob >> 9) & 1) << 5)); }
__host__ __device__ __forceinline__ void stage_rc(int b, int& R, int& C) { const int st = b / 1024, sb = b % 1024, swz = sb ^ (((sb >> 9) & 1) << 5); R = (st >> 1) * 16 + swz / 64; C = (st & 1) * 32 + (swz % 64) / 2; }
__host__ __device__ __forceinline__ int perm32(int rho) { const int n = rho >> 4, i = rho & 15; return 8 * (i >> 2) + 4 * n + (i & 3); }

struct Unit { int pm, pn; };
struct Gemm { const bf16_t* A; const bf16_t* Bt; int M, N, K; };

struct StaticOrder {
    int nM, nN, nwg, G, c, wgm;
    __host__ __device__ void init(int M, int N, int G_, int c_, int wgm_ = WGM) { nM = M / BM; nN = N / BM; nwg = nM * nN; G = G_; c = c_; wgm = wgm_; }
    __host__ __device__ bool next(int i, Unit& u) const {
        const long L = (long)i * G + c; if (L >= nwg) return false;
        int wgid = (int)L; { const int q = nwg / NXCD, r = nwg % NXCD, xcd = wgid % NXCD, off = wgid / NXCD; wgid = (xcd < r ? xcd * (q + 1) : r * (q + 1) + (xcd - r) * q) + off; }
        const int nig = wgm * nN, gid = wgid / nig, fm = gid * wgm, gsz = (nM - fm) < wgm ? (nM - fm) : wgm;
        u.pm = fm + ((wgid % nig) % gsz); u.pn = (wgid % nig) / gsz; return true;
    }
    __device__ __forceinline__ void a_ready(const Unit&) const {}
    __device__ __forceinline__ void done(const Unit&) const {}
};

__device__ __forceinline__ unsigned cvt_pk_bf16(float lo, float hi) { unsigned r; asm volatile("v_cvt_pk_bf16_f32 %0, %1, %2" : "=v"(r) : "v"(lo), "v"(hi)); return r; }
typedef float f32x2 __attribute__((ext_vector_type(2)));
template <class Epi, class Sched, bool ALIGN_EPI = false, bool SP2 = false>
__device__ __forceinline__ void gemm_phase(PG8_LAS unsigned char* lds, const Gemm g, const Sched& S, const Epi& E) {
    const int tid = threadIdx.x, wid = __builtin_amdgcn_readfirstlane(tid >> 6), lane = tid & 63, wr = wid >> 2, wc = wid & 3, fr = lane & 15, fq = lane >> 4;
    const int K = g.K, nt = K / BK;
    unsigned voffA[2], voffB[2];
#pragma unroll
    for (int i = 0; i < 2; ++i) { int R, C; stage_rc(tid * 16 + i * 8192, R, C); const int Rb = Epi::PERM ? ((R & ~31) + perm32(R & 31)) : R;
        voffA[i] = (unsigned)(R * K + C) * 2u; voffB[i] = (unsigned)(Rb * K + C) * 2u; }
    const size_t kstep = (size_t)(BK * 2);
    const size_t hstep = (size_t)HALF * K * 2;
    const size_t tstep = 2 * hstep;
    const unsigned ldsw = (unsigned)wid * 1024u;
    const int aoff = lds_byte(wr * 64 + fr, fq * 8), boff = lds_byte(wc * 32 + fr, fq * 8);
#define PG8_SA(b, h) (((b) * 2 + (h)) * HTB)
#define PG8_SB(b, h) ((4 + (b) * 2 + (h)) * HTB)
#define PG8_STAGE(bufoff, gbase, voff) do { _Pragma("unroll") for (int _i = 0; _i < 2; ++_i) \
        __builtin_amdgcn_global_load_lds((const unsigned*)((const char*)(gbase) + (voff)[_i]), (PG8_LAS unsigned*)(lds + (bufoff) + ldsw + _i * 8192), 16, 0, 0); } while (0)
#define PG8_LDA(dst, b, h) do { _Pragma("unroll") for (int m = 0; m < 4; ++m) _Pragma("unroll") for (int k = 0; k < 2; ++k) dst[m][k] = *(const PG8_LAS bf16x8*)(lds + PG8_SA(b, h) + aoff + m * 2048 + k * 1024); } while (0)
#define PG8_LDB(dst, b, h) do { _Pragma("unroll") for (int n = 0; n < 2; ++n) _Pragma("unroll") for (int k = 0; k < 2; ++k) dst[n][k] = *(const PG8_LAS bf16x8*)(lds + PG8_SB(b, h) + boff + n * 2048 + k * 1024); } while (0)
#define PG8_MMA(ai, bj, At, Bt) do { __builtin_amdgcn_s_setprio(1); _Pragma("unroll") for (int m = 0; m < 4; ++m) _Pragma("unroll") for (int n = 0; n < 2; ++n) _Pragma("unroll") for (int k = 0; k < 2; ++k) \
        acc[ai][bj][m][n] = __builtin_amdgcn_mfma_f32_16x16x32_bf16(Bt[n][k], At[m][k], acc[ai][bj][m][n], 0, 0, 0); __builtin_amdgcn_s_setprio(0); } while (0)
#define PG8_WAIT_V(n) asm volatile("s_waitcnt vmcnt(" #n ")" ::: "memory")
#define PG8_WAIT_L(n) asm volatile("s_waitcnt lgkmcnt(" #n ")" ::: "memory")
#define PG8_BAR __builtin_amdgcn_s_barrier()
#define PG8_SCHED __builtin_amdgcn_sched_barrier(0)
    Unit cur, nxt; int ui = 0;
    if (!S.next(0, cur)) return;
    f32x4 acc[2][2][4][2];
#pragma unroll
    for (int a = 0; a < 2; ++a)
#pragma unroll
        for (int b = 0; b < 2; ++b)
#pragma unroll
            for (int m = 0; m < 4; ++m)
#pragma unroll
                for (int n = 0; n < 2; ++n) acc[a][b][m][n] = (f32x4){0.f, 0.f, 0.f, 0.f};
    bf16x8 At[4][2], B0[2][2], B1[2][2];
    const char* cA = (const char*)g.A + (size_t)cur.pm * tstep; const char* cB = (const char*)g.Bt + (size_t)cur.pn * tstep;
    S.a_ready(cur);
    if constexpr (SP2) {
        PG8_STAGE(PG8_SB(0, 0), cB, voffB); PG8_STAGE(PG8_SB(0, 1), cB + hstep, voffB); PG8_STAGE(PG8_SA(0, 0), cA, voffA); PG8_STAGE(PG8_SA(0, 1), cA + hstep, voffA);
        if (wr == 1) PG8_BAR;
        PG8_WAIT_V(2); PG8_BAR;
        PG8_STAGE(PG8_SB(1, 0), cB + kstep, voffB); PG8_STAGE(PG8_SA(1, 0), cA + kstep, voffA); PG8_STAGE(PG8_SB(1, 1), cB + hstep + kstep, voffB);
        PG8_WAIT_V(6); PG8_BAR;
    } else {
        PG8_STAGE(PG8_SB(0, 0), cB, voffB); PG8_STAGE(PG8_SA(0, 0), cA, voffA); PG8_STAGE(PG8_SB(0, 1), cB + hstep, voffB); PG8_STAGE(PG8_SA(0, 1), cA + hstep, voffA);
        if (wr == 1) PG8_BAR;
        PG8_WAIT_V(4); PG8_BAR;
        PG8_STAGE(PG8_SB(1, 0), cB + kstep, voffB); PG8_STAGE(PG8_SA(1, 0), cA + kstep, voffA); PG8_STAGE(PG8_SB(1, 1), cB + hstep + kstep, voffB);
        PG8_WAIT_V(6); PG8_BAR;
    }
    for (;;) {
        const bool has_next = S.next(ui + 1, nxt);
        const char* nA = has_next ? (const char*)g.A + (size_t)nxt.pm * tstep : cA; const char* nB = has_next ? (const char*)g.Bt + (size_t)nxt.pn * tstep : cB;
        for (int t = 0; t < nt; t += 2) {
            const bool last = (t == nt - 2);
            const char* a1 = cA + (size_t)(t + 1) * kstep;
            const char* a2 = last ? nA : cA + (size_t)(t + 2) * kstep; const char* b2 = last ? nB : cB + (size_t)(t + 2) * kstep;
            const char* a3 = a2 + kstep; const char* b3 = b2 + kstep;
            if (last && has_next) S.a_ready(nxt);
            if constexpr (SP2) {
            PG8_LDB(B0, 0, 0); PG8_LDB(B1, 0, 1); PG8_SCHED; PG8_LDA(At, 0, 0); PG8_STAGE(PG8_SA(1, 1), a1 + hstep, voffA);
            PG8_WAIT_V(8); PG8_WAIT_L(0); PG8_BAR; PG8_MMA(0, 0, At, B0); PG8_MMA(0, 1, At, B1); PG8_BAR; PG8_SCHED;
            PG8_LDA(At, 0, 1); PG8_STAGE(PG8_SB(0, 0), b2, voffB); PG8_STAGE(PG8_SB(0, 1), b2 + hstep, voffB); PG8_STAGE(PG8_SA(0, 0), a2, voffA);
            PG8_WAIT_V(8); PG8_WAIT_L(0); PG8_BAR; PG8_MMA(1, 0, At, B0); PG8_MMA(1, 1, At, B1); PG8_BAR; PG8_SCHED;
            PG8_LDB(B0, 1, 0); PG8_LDB(B1, 1, 1); PG8_SCHED; PG8_LDA(At, 1, 0); PG8_STAGE(PG8_SA(0, 1), a2 + hstep, voffA);
            PG8_WAIT_V(8); PG8_WAIT_L(0); PG8_BAR; PG8_MMA(0, 0, At, B0); PG8_MMA(0, 1, At, B1); PG8_BAR; PG8_SCHED;
            PG8_LDA(At, 1, 1); PG8_STAGE(PG8_SB(1, 0), b3, voffB); PG8_STAGE(PG8_SB(1, 1), b3 + hstep, voffB); PG8_STAGE(PG8_SA(1, 0), a3, voffA);
            PG8_WAIT_V(8); PG8_WAIT_L(0); PG8_BAR; PG8_MMA(1, 0, At, B0); PG8_MMA(1, 1, At, B1); PG8_BAR; PG8_SCHED;
            } else {
            PG8_LDB(B0, 0, 0); PG8_SCHED; PG8_LDA(At, 0, 0); PG8_STAGE(PG8_SA(1, 1), a1 + hstep, voffA);
            PG8_WAIT_L(8); PG8_BAR; PG8_WAIT_L(0); PG8_MMA(0, 0, At, B0); PG8_BAR; PG8_SCHED;
            PG8_LDB(B1, 0, 1); PG8_STAGE(PG8_SB(0, 0), b2, voffB);
            PG8_BAR; PG8_WAIT_L(0); PG8_MMA(0, 1, At, B1); PG8_BAR;
            PG8_LDA(At, 0, 1); PG8_STAGE(PG8_SA(0, 0), a2, voffA);
            PG8_BAR; PG8_WAIT_L(0); PG8_MMA(1, 0, At, B0); PG8_BAR; PG8_SCHED;
            PG8_STAGE(PG8_SB(0, 1), b2 + hstep, voffB);
            PG8_WAIT_V(6); PG8_BAR; PG8_MMA(1, 1, At, B1); PG8_BAR;
            PG8_LDB(B0, 1, 0); PG8_SCHED; PG8_LDA(At, 1, 0); PG8_STAGE(PG8_SA(0, 1), a2 + hstep, voffA);
            PG8_WAIT_L(8); PG8_BAR; PG8_WAIT_L(0); PG8_MMA(0, 0, At, B0); PG8_BAR; PG8_SCHED;
            PG8_LDB(B1, 1, 1); PG8_STAGE(PG8_SB(1, 0), b3, voffB);
            PG8_BAR; PG8_WAIT_L(0); PG8_MMA(0, 1, At, B1); PG8_BAR;
            PG8_LDA(At, 1, 1); PG8_STAGE(PG8_SA(1, 0), a3, voffA);
            PG8_BAR; PG8_WAIT_L(0); PG8_MMA(1, 0, At, B0); PG8_BAR; PG8_SCHED;
            PG8_STAGE(PG8_SB(1, 1), b3 + hstep, voffB);
            PG8_WAIT_V(6); PG8_BAR; PG8_MMA(1, 1, At, B1); PG8_BAR;
            }
        }
        if constexpr (ALIGN_EPI) { if (wr == 0) PG8_BAR; }
        if constexpr (!Epi::AFTER_DRAIN) { E(acc, cur, wr, wc, fr, fq); S.done(cur); }
        if (!has_next) break;
#pragma unroll
        for (int a = 0; a < 2; ++a)
#pragma unroll
            for (int b = 0; b < 2; ++b)
#pragma unroll
                for (int m = 0; m < 4; ++m)
#pragma unroll
                    for (int n = 0; n < 2; ++n) acc[a][b][m][n] = (f32x4){0.f, 0.f, 0.f, 0.f};
        cur = nxt; cA = nA; cB = nB; ++ui;
        if constexpr (ALIGN_EPI) { if (wr == 1) PG8_BAR; }
    }
    PG8_WAIT_V(0);
    if constexpr (!ALIGN_EPI) { if (wr == 0) PG8_BAR; }
    PG8_BAR;
    if constexpr (Epi::AFTER_DRAIN) { E.fused(acc, cur, wr, wc, fr, fq, lds, wid, lane); S.done(cur); }
#undef PG8_SA
#undef PG8_SB
#undef PG8_STAGE
#undef PG8_LDA
#undef PG8_LDB
#undef PG8_MMA
#undef PG8_WAIT_V
#undef PG8_WAIT_L
#undef PG8_BAR
#undef PG8_SCHED
}
}
namespace att {
using bf16 = __hip_bfloat16;
constexpr int D = 128, NW = 8, QBLK = 32, KVBLK = 64; constexpr float SCALE = 0.088388347648318440f; constexpr float THR = 8.f; constexpr int SDEPTH = 2;
constexpr int LDQ = 2048, LDK = 1280, LDO = 3072;
constexpr size_t SHM_V = KVBLK * D * 2, SHM_K = KVBLK * D * 2, SHM_ATTN = 2 * SHM_V + 2 * SHM_K + NW * 64 * 4;
using bf16x8 = __attribute__((ext_vector_type(8))) short;
using s16x4  = __attribute__((ext_vector_type(4))) short;
using f32x16 = __attribute__((ext_vector_type(16))) float;
using f32x8  = __attribute__((ext_vector_type(8))) float;
using u32x4  = __attribute__((ext_vector_type(4))) unsigned;
#define KSWZ(row, colB) ((row) * 256 + ((colB) ^ (((row) & 7) << 4)))
#define SBAR() __builtin_amdgcn_sched_barrier(0)
__device__ __forceinline__ int crow(int r, int hi) { return (r & 3) + 8 * (r >> 2) + 4 * hi; }
__device__ __forceinline__ unsigned cvtpk(float lo, float hi) {
  unsigned r; asm volatile("v_cvt_pk_bf16_f32 %0, %1, %2" : "=v"(r) : "v"(lo), "v"(hi)); return r;
}
template <typename TIn> struct Stage;
template <> struct Stage<bf16>  { using T = bf16x8;
  __device__ static __forceinline__ T ld8(const bf16* p) { return *reinterpret_cast<const bf16x8*>(p); }
  __device__ static __forceinline__ bf16x8 tobf(T x) { return x; } };
template <> struct Stage<float> { using T = f32x8;
  __device__ static __forceinline__ T ld8(const float* p) { return *reinterpret_cast<const f32x8*>(p); }
  __device__ static __forceinline__ bf16x8 tobf(T x) {
    u32x4 w = {cvtpk(x[0], x[1]), cvtpk(x[2], x[3]), cvtpk(x[4], x[5]), cvtpk(x[6], x[7])}; return *reinterpret_cast<bf16x8*>(&w); } };

__device__ __forceinline__ void partialSM(f32x16& p0, f32x16& p1, float& m_reg, float& mn, float& alpha) {
  constexpr float C = SCALE * 1.4426950408889634f;
  float pmax = p0[0]; for (int r = 1; r < 16; ++r) pmax = fmaxf(pmax, p0[r]); for (int r = 0; r < 16; ++r) pmax = fmaxf(pmax, p1[r]);
  { auto rr = __builtin_amdgcn_permlane32_swap(__float_as_uint(pmax), __float_as_uint(pmax), false, false);
    pmax = fmaxf(__uint_as_float(rr[0]), __uint_as_float(rr[1])); }
  if (__builtin_expect(__all(pmax - m_reg <= THR / SCALE), 1)) { mn = m_reg; alpha = 1.f; }
  else { mn = fmaxf(m_reg, pmax); alpha = __builtin_amdgcn_exp2f((m_reg - mn) * C); m_reg = mn; }
  float mnC = -mn * C;
  for (int r = 0; r < 16; ++r) p0[r] = fmaf(p0[r], C, mnC); for (int r = 0; r < 16; ++r) p1[r] = fmaf(p1[r], C, mnC);
  for (int r = 0; r < 16; ++r) p0[r] = __builtin_amdgcn_exp2f(p0[r]);
}
__device__ __forceinline__ void finishSM(f32x16& p0, f32x16& p1, float alpha, float& l_reg, bf16x8& pa0, bf16x8& pa1, bf16x8& pa2, bf16x8& pa3) {
  for (int r = 0; r < 16; ++r) p1[r] = __builtin_amdgcn_exp2f(p1[r]);
  float ps = 0; for (int r = 0; r < 16; ++r) ps += p0[r]; for (int r = 0; r < 16; ++r) ps += p1[r];
  { auto rr = __builtin_amdgcn_permlane32_swap(__float_as_uint(ps), __float_as_uint(ps), false, false);
    ps = __uint_as_float(rr[0]) + __uint_as_float(rr[1]); }
  l_reg = l_reg * alpha + ps;
#define PK4(P, BASE, OUT) do { unsigned a0 = cvtpk(P[BASE + 0], P[BASE + 1]), a1 = cvtpk(P[BASE + 2], P[BASE + 3]);   \
    unsigned b0 = cvtpk(P[BASE + 4], P[BASE + 5]), b1 = cvtpk(P[BASE + 6], P[BASE + 7]);                              \
    auto r0 = __builtin_amdgcn_permlane32_swap(a0, b0, false, false); auto r1 = __builtin_amdgcn_permlane32_swap(a1, b1, false, false); \
    u32x4 w = {r0[0], r1[0], r0[1], r1[1]}; OUT = *reinterpret_cast<bf16x8*>(&w); } while (0)
  PK4(p0, 0, pa0); PK4(p0, 8, pa1); PK4(p1, 0, pa2); PK4(p1, 8, pa3);
#undef PK4
}
__device__ __forceinline__ void qkt(f32x16& p0, f32x16& p1, const bf16* Ks, const bf16x8* qr, int r32, int hi) {
  p0 = f32x16{}; p1 = f32x16{};
  for (int d0 = 0; d0 < 8; ++d0) { int cb = (d0 * 16 + hi * 8) * 2;
    bf16x8 b0 = *reinterpret_cast<const bf16x8*>((const char*)Ks + KSWZ(r32, cb));
    bf16x8 b1 = *reinterpret_cast<const bf16x8*>((const char*)Ks + KSWZ(32 + r32, cb));
    p0 = __builtin_amdgcn_mfma_f32_32x32x16_bf16(b0, qr[d0], p0, 0, 0, 0);
    p1 = __builtin_amdgcn_mfma_f32_32x32x16_bf16(b1, qr[d0], p1, 0, 0, 0); }
}
__device__ __forceinline__ int v_st(int k, int c) { const int kk = (k & ~0xC) | ((k & 4) << 1) | ((k & 8) >> 1); return ((kk >> 3) * 4 + (c >> 5)) * 512 + ((kk & 7) * 32 + (c & 31)) * 2; }
__device__ __forceinline__ int v_rd_base(int lane) { return ((lane & 3) << 3) | (((lane >> 2) & 3) << 6) | (((lane >> 4) & 1) << 5) | (((lane >> 5) & 1) << 8); }
constexpr int v_rd_off(int d0, int ks, int half) { return d0 * 512 + ks * 4096 + half * 2048; }
template <int OFF> __device__ __forceinline__ s16x4 tr_read(int vb) {
  s16x4 r; asm volatile("ds_read_b64_tr_b16 %0, %1 offset:%2" : "=&v"(r) : "v"(vb), "i"(OFF) : "memory"); return r;
}
template <int D0> __device__ __forceinline__ void pv_one(f32x16& od, int vb, bf16x8 pa0, bf16x8 pa1, bf16x8 pa2, bf16x8 pa3) {
  const s16x4 l0 = tr_read<v_rd_off(D0, 0, 0)>(vb), h0 = tr_read<v_rd_off(D0, 0, 1)>(vb), l1 = tr_read<v_rd_off(D0, 1, 0)>(vb), h1 = tr_read<v_rd_off(D0, 1, 1)>(vb);
  const s16x4 l2 = tr_read<v_rd_off(D0, 2, 0)>(vb), h2 = tr_read<v_rd_off(D0, 2, 1)>(vb), l3 = tr_read<v_rd_off(D0, 3, 0)>(vb), h3 = tr_read<v_rd_off(D0, 3, 1)>(vb);
  asm volatile("s_waitcnt lgkmcnt(0)" ::: "memory"); SBAR();
#define PK(L, H) (bf16x8){L[0], L[1], L[2], L[3], H[0], H[1], H[2], H[3]}
  od = __builtin_amdgcn_mfma_f32_32x32x16_bf16(pa0, PK(l0, h0), od, 0, 0, 0);
  od = __builtin_amdgcn_mfma_f32_32x32x16_bf16(pa1, PK(l1, h1), od, 0, 0, 0);
  od = __builtin_amdgcn_mfma_f32_32x32x16_bf16(pa2, PK(l2, h2), od, 0, 0, 0);
  od = __builtin_amdgcn_mfma_f32_32x32x16_bf16(pa3, PK(l3, h3), od, 0, 0, 0);
#undef PK
}
__device__ __forceinline__ void pv_d0(f32x16* o, int vb, bf16x8 pa0, bf16x8 pa1, bf16x8 pa2, bf16x8 pa3) {
  pv_one<0>(o[0], vb, pa0, pa1, pa2, pa3); pv_one<1>(o[1], vb, pa0, pa1, pa2, pa3); pv_one<2>(o[2], vb, pa0, pa1, pa2, pa3); pv_one<3>(o[3], vb, pa0, pa1, pa2, pa3);
}

template <typename TQ>
__device__ __forceinline__ void attn_dense_body(const TQ* __restrict__ Qb, const bf16* __restrict__ Kh, const bf16* __restrict__ Vh,
                                                unsigned short* __restrict__ Ob, int ldo, int seq, char* lds) {
  using St = Stage<bf16>; using SQ = Stage<TQ>;
  const int tid = threadIdx.x, wid = tid >> 6, lane = tid & 63, r32 = lane & 31, hi = lane >> 5;
  bf16* V_lds = (bf16*)lds; bf16* K_lds = (bf16*)(lds + 2 * SHM_V);
  float* ws = (float*)(lds + 2 * SHM_V + 2 * SHM_K) + wid * 64; float* li_l = ws; float* al_l = ws + 32;
  float m_reg = -1e30f, l_reg = 0; f32x16 o[4] = {}; bf16x8 qr[8];
  const TQ* Qw = Qb + (long)(wid * QBLK + r32) * LDQ + hi * 8;
#pragma unroll
  for (int d0 = 0; d0 < 8; ++d0) qr[d0] = SQ::tobf(SQ::ld8(Qw + d0 * 16));
  const int sr = tid >> 4, sc = (tid & 15) * 8, vst0 = v_st(sr, sc), vst1 = v_st(32 + sr, sc);
  const int vb0 = (int)(uintptr_t)V_lds + v_rd_base(lane);
  struct { typename St::T vs0, vs1, ks0, ks1; } sr_[SDEPTH];
#define SLOAD(i, k0) do { sr_[i].vs0 = St::ld8(&Vh[(long)((k0) + sr) * LDK + sc]); sr_[i].vs1 = St::ld8(&Vh[(long)((k0) + 32 + sr) * LDK + sc]); \
    sr_[i].ks0 = St::ld8(&Kh[(long)((k0) + sr) * LDK + sc]); sr_[i].ks1 = St::ld8(&Kh[(long)((k0) + 32 + sr) * LDK + sc]); } while (0)
#define SWRITE(b, i) do { *(bf16x8*)((char*)V_lds + (b) * SHM_V + vst0) = St::tobf(sr_[i].vs0);          \
    *(bf16x8*)((char*)V_lds + (b) * SHM_V + vst1) = St::tobf(sr_[i].vs1); int kc = sc * 2;               \
    *(bf16x8*)((char*)K_lds + (b) * SHM_K + KSWZ(sr, kc)) = St::tobf(sr_[i].ks0);                       \
    *(bf16x8*)((char*)K_lds + (b) * SHM_K + KSWZ(32 + sr, kc)) = St::tobf(sr_[i].ks1); } while (0)
#define SWAIT() do { if constexpr (SDEPTH == 2) asm volatile("s_waitcnt vmcnt(4)" ::: "memory"); else asm volatile("s_waitcnt vmcnt(0)" ::: "memory"); } while (0)
#define RESC(a) do { if (__any((a) < 1.f)) { if (hi == 0) al_l[r32] = (a); asm volatile("s_waitcnt lgkmcnt(0)" ::: "memory"); \
    for (int d = 0; d < 4; ++d) for (int r = 0; r < 16; ++r) o[d][r] *= al_l[crow(r, hi)]; } } while (0)
  f32x16 pA0, pA1, pB0, pB1; float mnA, mnB, alA, alB; bf16x8 pa0, pa1, pa2, pa3; const int NT = seq / KVBLK;
  constexpr int SE = 0, SO = SDEPTH - 1;
  SLOAD(SE, 0); asm volatile("s_waitcnt vmcnt(0)" ::: "memory"); SWRITE(0, SE); __syncthreads();
  qkt(pA0, pA1, K_lds, qr, r32, hi); partialSM(pA0, pA1, m_reg, mnA, alA);
  SLOAD(SO, KVBLK); if constexpr (SDEPTH == 2) { if (2 < NT) SLOAD(SE, 2 * KVBLK); }
  SWAIT(); SWRITE(1, SO); __syncthreads();
  for (int j = 1; j + 1 < NT; j += 2) {
    SBAR(); qkt(pB0, pB1, (bf16*)((char*)K_lds + SHM_K), qr, r32, hi);
    finishSM(pA0, pA1, alA, l_reg, pa0, pa1, pa2, pa3); SBAR();
    SLOAD(SO, (j + SDEPTH) * KVBLK); SBAR();
    pv_d0(o, vb0, pa0, pa1, pa2, pa3); partialSM(pB0, pB1, m_reg, mnB, alB);
    __syncthreads(); SWAIT(); SWRITE(0, SE);
    RESC(alB); __syncthreads();
    SBAR(); qkt(pA0, pA1, K_lds, qr, r32, hi);
    finishSM(pB0, pB1, alB, l_reg, pa0, pa1, pa2, pa3); SBAR();
    if (SDEPTH == 1 || j + 3 < NT) SLOAD(SE, (j + 1 + SDEPTH) * KVBLK); SBAR();
    pv_d0(o, vb0 + (int)SHM_V, pa0, pa1, pa2, pa3); partialSM(pA0, pA1, m_reg, mnA, alA);
    __syncthreads(); SWAIT(); SWRITE(1, SO);
    RESC(alA); __syncthreads();
  }
  SBAR(); qkt(pB0, pB1, (bf16*)((char*)K_lds + SHM_K), qr, r32, hi);
  finishSM(pA0, pA1, alA, l_reg, pa0, pa1, pa2, pa3); SBAR();
  pv_d0(o, vb0, pa0, pa1, pa2, pa3); partialSM(pB0, pB1, m_reg, mnB, alB);
  __syncthreads(); RESC(alB);
  finishSM(pB0, pB1, alB, l_reg, pa0, pa1, pa2, pa3); SBAR();
  pv_d0(o, vb0 + (int)SHM_V, pa0, pa1, pa2, pa3);
  if (hi == 0) li_l[r32] = l_reg; asm volatile("s_waitcnt lgkmcnt(0)" ::: "memory");
  float rli[16];
#pragma unroll
  for (int r = 0; r < 16; ++r) rli[r] = __builtin_amdgcn_rcpf(li_l[crow(r, hi)]);
  unsigned short* Ow = Ob + (long)(wid * QBLK) * ldo;
#pragma unroll
  for (int r = 0; r < 16; ++r) { int orow = crow(r, hi);
    for (int d0 = 0; d0 < 4; ++d0) Ow[(long)orow * ldo + d0 * 32 + r32] = (unsigned short)f2bf(o[d0][r] * rli[r]); }
#undef SLOAD
#undef SWRITE
#undef SWAIT
#undef RESC
}

template <int NB>
__device__ __forceinline__ void store_o_rows(const f32x16* o, const float* li_l, unsigned short* __restrict__ Ow, int ldo, char* lds, int wid, int lane, int r32, int hi) {
  constexpr int RS = NB * 64, LPR = RS / 16, RPI = 64 / LPR;
  char* st = lds + wid * (32 * RS);
#pragma unroll
  for (int r = 0; r < 16; ++r) { const int orow = crow(r, hi); const float rl = __builtin_amdgcn_rcpf(li_l[orow]);
#pragma unroll
    for (int d0 = 0; d0 < NB; ++d0) { const float v = o[d0][r] * rl; *reinterpret_cast<unsigned short*>(st + orow * RS + (d0 * 32 + r32) * 2) = (unsigned short)cvtpk(v, v); } }
  asm volatile("s_waitcnt lgkmcnt(0)" ::: "memory");
  const int rr = lane / LPR, cb = (lane % LPR) * 16;
#pragma unroll
  for (int i = 0; i < 32 / RPI; ++i) { const int row = i * RPI + rr;
    const u32x4 v = *reinterpret_cast<const u32x4*>(st + row * RS + cb);
    *reinterpret_cast<u32x4*>(reinterpret_cast<char*>(Ow + (long)row * ldo) + cb) = v; }
}
__device__ __forceinline__ void attn_small_body(const bf16* __restrict__ Qb, const bf16* __restrict__ Kh, const bf16* __restrict__ Vh, unsigned short* __restrict__ Ob, int ldo, char* lds) {
  int tid_ = threadIdx.x; asm volatile("" : "+v"(tid_));
  const int tid = tid_, wid = __builtin_amdgcn_readfirstlane(tid >> 6), lane = tid & 63, r32 = lane & 31, hi = lane >> 5;
  char* V_lds = lds; char* K_lds = lds + 4 * SHM_V;
  float* ws = (float*)(lds + 4 * SHM_V + 4 * SHM_K) + wid * 64; float* li_l = ws; float* al_l = ws + 32;
  const int sr = tid >> 4, sc = (tid & 15) * 8, vst0 = v_st(sr, sc), vst1 = v_st(32 + sr, sc);
  bf16x8 kv[4][4];
#pragma unroll
  for (int t = 0; t < 4; ++t) {
    kv[t][0] = *reinterpret_cast<const bf16x8*>(&Kh[(long)(64 * t + sr) * LDK + sc]); kv[t][1] = *reinterpret_cast<const bf16x8*>(&Kh[(long)(64 * t + 32 + sr) * LDK + sc]);
    kv[t][2] = *reinterpret_cast<const bf16x8*>(&Vh[(long)(64 * t + sr) * LDK + sc]); kv[t][3] = *reinterpret_cast<const bf16x8*>(&Vh[(long)(64 * t + 32 + sr) * LDK + sc]); }
  bf16x8 qr[8];
  const bf16* Qw = Qb + (long)(wid * QBLK + r32) * LDQ + hi * 8;
#pragma unroll
  for (int d0 = 0; d0 < 8; ++d0) qr[d0] = *reinterpret_cast<const bf16x8*>(Qw + d0 * 16);
  asm volatile("s_waitcnt vmcnt(0)" ::: "memory");
#pragma unroll
  for (int t = 0; t < 4; ++t) {
    *(bf16x8*)(K_lds + t * SHM_K + KSWZ(sr, sc * 2)) = kv[t][0]; *(bf16x8*)(K_lds + t * SHM_K + KSWZ(32 + sr, sc * 2)) = kv[t][1];
    *(bf16x8*)(V_lds + t * SHM_V + vst0) = kv[t][2]; *(bf16x8*)(V_lds + t * SHM_V + vst1) = kv[t][3]; }
  __syncthreads();
  float m_reg = -1e30f, l_reg = 0; f32x16 o[4] = {};
  const int vb0 = (int)(uintptr_t)V_lds + v_rd_base(lane);
#pragma unroll 1
  for (int t = 0; t < 4; ++t) {
    f32x16 p0, p1; float mn, al; bf16x8 pa0, pa1, pa2, pa3;
    qkt(p0, p1, (const bf16*)(K_lds + t * SHM_K), qr, r32, hi);
    partialSM(p0, p1, m_reg, mn, al);
    if (__any(al < 1.f)) { if (hi == 0) al_l[r32] = al; asm volatile("s_waitcnt lgkmcnt(0)" ::: "memory");
      for (int d = 0; d < 4; ++d) for (int r = 0; r < 16; ++r) o[d][r] *= al_l[crow(r, hi)]; }
    finishSM(p0, p1, al, l_reg, pa0, pa1, pa2, pa3); SBAR();
    pv_d0(o, vb0 + t * (int)SHM_V, pa0, pa1, pa2, pa3);
  }
  if (hi == 0) li_l[r32] = l_reg; asm volatile("s_waitcnt lgkmcnt(0)" ::: "memory");
  __syncthreads();
  store_o_rows<4>(o, li_l, Ob + (long)(wid * QBLK) * ldo, ldo, lds, wid, lane, r32, hi);
  __syncthreads();
}

template <int OFF> __device__ __forceinline__ bf16x8 rd128(int a) { bf16x8 r; asm volatile("ds_read_b128 %0, %1 offset:%2" : "=v"(r) : "v"(a), "i"(OFF) : "memory"); return r; }
#define LGKM(n) asm volatile("s_waitcnt lgkmcnt(" #n ")" ::: "memory")
#define MF(a, b, c) c = __builtin_amdgcn_mfma_f32_32x32x16_bf16(a, b, c, 0, 0, 0)
__device__ __forceinline__ void qkt_p(f32x16& p0, f32x16& p1, int ka0, int ka1, int ka2, int ka3, const bf16x8* qr) {
  p0 = f32x16{}; p1 = f32x16{};
  bf16x8 a0, b0, a1, b1, a2, b2;
  a0 = rd128<0>(ka0); b0 = rd128<8192>(ka0); a1 = rd128<0>(ka1); b1 = rd128<8192>(ka1); a2 = rd128<0>(ka2); b2 = rd128<8192>(ka2);
  LGKM(4); SBAR(); MF(a0, qr[0], p0); MF(b0, qr[0], p1); SBAR(); a0 = rd128<0>(ka3);   b0 = rd128<8192>(ka3);
  LGKM(4); SBAR(); MF(a1, qr[1], p0); MF(b1, qr[1], p1); SBAR(); a1 = rd128<128>(ka0); b1 = rd128<8320>(ka0);
  LGKM(4); SBAR(); MF(a2, qr[2], p0); MF(b2, qr[2], p1); SBAR(); a2 = rd128<128>(ka1); b2 = rd128<8320>(ka1);
  LGKM(4); SBAR(); MF(a0, qr[3], p0); MF(b0, qr[3], p1); SBAR(); a0 = rd128<128>(ka2); b0 = rd128<8320>(ka2);
  LGKM(4); SBAR(); MF(a1, qr[4], p0); MF(b1, qr[4], p1); SBAR(); a1 = rd128<128>(ka3); b1 = rd128<8320>(ka3);
  LGKM(4); SBAR(); MF(a2, qr[5], p0); MF(b2, qr[5], p1); SBAR();
  LGKM(2); SBAR(); MF(a0, qr[6], p0); MF(b0, qr[6], p1); SBAR();
  LGKM(0); SBAR(); MF(a1, qr[7], p0); MF(b1, qr[7], p1); SBAR();
}
struct VFrag { s16x4 l0, h0, l1, h1, l2, h2, l3, h3; };
template <int D> __device__ __forceinline__ void pv_rd(VFrag& f, int vb) { constexpr int B = (D >> 2) * 16384;
  f.l0 = tr_read<B + v_rd_off(D & 3, 0, 0)>(vb); f.h0 = tr_read<B + v_rd_off(D & 3, 0, 1)>(vb); f.l1 = tr_read<B + v_rd_off(D & 3, 1, 0)>(vb); f.h1 = tr_read<B + v_rd_off(D & 3, 1, 1)>(vb);
  f.l2 = tr_read<B + v_rd_off(D & 3, 2, 0)>(vb); f.h2 = tr_read<B + v_rd_off(D & 3, 2, 1)>(vb); f.l3 = tr_read<B + v_rd_off(D & 3, 3, 0)>(vb); f.h3 = tr_read<B + v_rd_off(D & 3, 3, 1)>(vb); }
__device__ __forceinline__ void pv_mm(f32x16& od, const VFrag& f, bf16x8 pa0, bf16x8 pa1, bf16x8 pa2, bf16x8 pa3) {
#define PK(L, H) (bf16x8){L[0], L[1], L[2], L[3], H[0], H[1], H[2], H[3]}
  MF(pa0, PK(f.l0, f.h0), od); MF(pa1, PK(f.l1, f.h1), od); MF(pa2, PK(f.l2, f.h2), od); MF(pa3, PK(f.l3, f.h3), od);
#undef PK
}
template <int D, int NB> __device__ __forceinline__ void pv_step(f32x16* o, VFrag& cur, VFrag& nxt, int vb, bf16x8 pa0, bf16x8 pa1, bf16x8 pa2, bf16x8 pa3) {
  if constexpr (D + 1 < NB) { pv_rd<D + 1>(nxt, vb); LGKM(8); } else { LGKM(0); }
  SBAR(); pv_mm(o[D], cur, pa0, pa1, pa2, pa3); SBAR();
  if constexpr (D + 1 < NB) pv_step<D + 1, NB>(o, nxt, cur, vb, pa0, pa1, pa2, pa3);
}
template <int NB> __device__ __forceinline__ void pv_p(f32x16* o, int vb, bf16x8 pa0, bf16x8 pa1, bf16x8 pa2, bf16x8 pa3) {
  VFrag x, y; pv_rd<0>(x, vb); pv_step<0, NB>(o, x, y, vb, pa0, pa1, pa2, pa3);
}
template <int NH>
__device__ __forceinline__ void attn_wide_body(const bf16* __restrict__ Qb, const bf16* __restrict__ Kh, const bf16* __restrict__ Vh, unsigned short* __restrict__ Ob, int ldo, int seq, char* lds) {
  int tid_ = threadIdx.x; asm volatile("" : "+v"(tid_));
  const int tid = tid_, wid = __builtin_amdgcn_readfirstlane(tid >> 6), lane = tid & 63, r32 = lane & 31, hi = lane >> 5;
  constexpr int KB = 16384, VB = NH * 16384, VOFF = 2 * KB;
  float* ws = (float*)(lds + 2 * KB + 3 * VB) + wid * 64; float* li_l = ws; float* al_l = ws + 32;
  bf16x8 qr[8];
  const bf16* Qw = Qb + (long)(wid * QBLK + r32) * LDQ + hi * 8;
#pragma unroll
  for (int d0 = 0; d0 < 8; ++d0) qr[d0] = *reinterpret_cast<const bf16x8*>(Qw + d0 * 16);
  unsigned kof[2], vof[2];
#pragma unroll
  for (int i = 0; i < 2; ++i) { const int ch = 2 * wid + i;
    const int row = ch * 4 + (lane >> 4); kof[i] = (unsigned)(row * LDK * 2 + (((lane & 15) ^ (row & 7)) << 4));
    const int s = 2 * ch + (lane >> 5), kk = (s >> 2) * 8 + ((lane & 31) >> 2), k = (kk & ~0xC) | ((kk & 4) << 1) | ((kk & 8) >> 1);
    vof[i] = (unsigned)(k * LDK * 2 + ((s & 3) * 32 + (lane & 3) * 8) * 2); }
  PG8_LAS unsigned char* L3 = (PG8_LAS unsigned char*)lds;
  const unsigned pw = (unsigned)wid * 2048u;
#define WDMA_K(t, b) do { const char* kg = (const char*)Kh + (size_t)(t) * (KVBLK * LDK * 2); _Pragma("unroll") for (int _i = 0; _i < 2; ++_i)  \
      __builtin_amdgcn_global_load_lds((const unsigned*)(kg + kof[_i]), (PG8_LAS unsigned*)(L3 + (b) * KB + pw + _i * 1024), 16, 0, 0); } while (0)
#define WDMA_V(t, b) do { const char* vg = (const char*)Vh + (size_t)(t) * (KVBLK * LDK * 2); _Pragma("unroll") for (int _h = 0; _h < NH; ++_h) _Pragma("unroll") for (int _i = 0; _i < 2; ++_i)  \
      __builtin_amdgcn_global_load_lds((const unsigned*)(vg + _h * 256 + vof[_i]), (PG8_LAS unsigned*)(L3 + VOFF + (b) * VB + _h * 16384 + pw + _i * 1024), 16, 0, 0); } while (0)
#define WQS(kb) do { f32x16 p0, p1; float mn, al; SBAR(); __builtin_amdgcn_s_setprio(1); { const int ko = (kb) * KB; qkt_p(p0, p1, ka0 + ko, ka1 + ko, ka2 + ko, ka3 + ko, qr); } __builtin_amdgcn_s_setprio(0); partialSM(p0, p1, m_reg, mn, al);                       \
    if (__any(al < 1.f)) { if (hi == 0) al_l[r32] = al; asm volatile("s_waitcnt lgkmcnt(0)" ::: "memory");                                                            \
      for (int d = 0; d < 4 * NH; ++d) for (int r = 0; r < 16; ++r) o[d][r] *= al_l[crow(r, hi)]; }                                                                     \
    finishSM(p0, p1, al, l_reg, pa0, pa1, pa2, pa3); SBAR(); } while (0)
#define WPV(vb_) do { SBAR(); __builtin_amdgcn_s_setprio(1); pv_p<4 * NH>(o, vb0 + (vb_) * VB, pa0, pa1, pa2, pa3); __builtin_amdgcn_s_setprio(0); SBAR(); } while (0)
  float m_reg = -1e30f, l_reg = 0; f32x16 o[4 * NH] = {};
  const int vb0 = (int)(uintptr_t)lds + VOFF + v_rd_base(lane);
  const int NT = seq / KVBLK; const bool lead = wid < 4;
  const int kx = (hi * 16) ^ ((r32 & 7) << 4), kl = (int)(uintptr_t)lds + r32 * 256;
  const int ka0 = kl + kx, ka1 = kl + (32 ^ kx), ka2 = kl + (64 ^ kx), ka3 = kl + (96 ^ kx);
  bf16x8 pa0, pa1, pa2, pa3;
  WDMA_K(0, 0); WDMA_V(0, 0); asm volatile("s_waitcnt vmcnt(0)" ::: "memory"); __syncthreads();
#define WEND() do { asm volatile("s_waitcnt vmcnt(0)" ::: "memory"); __syncthreads(); } while (0)
#define WROT() do { vj = vj1; vj1 = vj2; vj2 = (vj2 == 2) ? 0 : vj2 + 1; } while (0)
  int vj = 2, vj1 = 0, vj2 = 1;
  if (lead) {
#pragma unroll 1
    for (int j = -1; j + 1 < NT; ++j) { const int k1 = (j + 1) & 1;
      if (j + 2 < NT) { WDMA_K(j + 2, k1 ^ 1); WDMA_V(j + 2, vj2); }
      WQS(k1); WPV(vj1); WEND(); WROT(); }
    WEND();
  } else {
    if (1 < NT) { WDMA_K(1, 1); WDMA_V(1, 1); }
    WQS(0); WEND(); WROT();
#pragma unroll 1
    for (int j = 0; j + 1 < NT; ++j) { const int k1 = (j + 1) & 1;
      if (j + 2 < NT) { WDMA_K(j + 2, k1 ^ 1); WDMA_V(j + 2, vj2); }
      WPV(vj); WQS(k1); WEND(); WROT(); }
    WPV(vj); WEND();
  }
#undef WEND
#undef WROT
#undef WDMA_K
#undef WDMA_V
#undef WQS
#undef WPV
  if (hi == 0) li_l[r32] = l_reg; asm volatile("s_waitcnt lgkmcnt(0)" ::: "memory");
  store_o_rows<4 * NH>(o, li_l, Ob + (long)(wid * QBLK) * ldo, ldo, lds, wid, lane, r32, hi);
  __syncthreads();
}
}
#define ONE_PER_PHASE 0

namespace pg8 {
template <int ACT  > struct EpiStore {
    static constexpr bool PERM = true, AFTER_DRAIN = false;
    bf16_t* O; int ldc; const bf16_t* aux;
    __device__ __forceinline__ void operator()(const f32x4 (&acc)[2][2][4][2], const Unit& u, int wr, int wc, int fr, int fq) const {
        const int row0 = u.pm * BM + wr * 64 + fr, col0 = u.pn * BM + wc * 32 + 8 * fq;
#pragma unroll
        for (int ai = 0; ai < 2; ++ai)
#pragma unroll
            for (int m = 0; m < 4; ++m) { const size_t ro = (size_t)(row0 + ai * HALF + m * 16) * ldc + col0;
#pragma unroll
                for (int bj = 0; bj < 2; ++bj) { f32x4 v0 = acc[ai][bj][m][0], v1 = acc[ai][bj][m][1];
                    if (ACT == 1) { v0 = __builtin_elementwise_max(v0, (f32x4){0.f, 0.f, 0.f, 0.f}); v1 = __builtin_elementwise_max(v1, (f32x4){0.f, 0.f, 0.f, 0.f}); v0 = v0 * v0; v1 = v1 * v1; }
                    if (ACT == 2) { const u32x4 z = *(const u32x4*)(aux + ro + bj * HALF);
                        const f32x4 z0 = {__uint_as_float(z.x << 16), __uint_as_float(z.x & 0xffff0000u), __uint_as_float(z.y << 16), __uint_as_float(z.y & 0xffff0000u)};
                        const f32x4 z1 = {__uint_as_float(z.z << 16), __uint_as_float(z.z & 0xffff0000u), __uint_as_float(z.w << 16), __uint_as_float(z.w & 0xffff0000u)};
#pragma unroll
                        for (int e = 0; e < 4; ++e) { v0[e] = z0[e] * __builtin_amdgcn_rcpf(1.f + __builtin_amdgcn_exp2f(-1.4426950408889634f * v0[e])); v1[e] = z1[e] * __builtin_amdgcn_rcpf(1.f + __builtin_amdgcn_exp2f(-1.4426950408889634f * v1[e])); } }
                    u32x4 w; w.x = cvt_pk_bf16(v0[0], v0[1]); w.y = cvt_pk_bf16(v0[2], v0[3]); w.z = cvt_pk_bf16(v1[0], v1[1]); w.w = cvt_pk_bf16(v1[2], v1[3]);
                    if (ACT == 3) { const int row = row0 + ai * HALF + m * 16, col = col0 + bj * HALF;
                        *(u32x4*)(O + ((size_t)((row >> 8) * 128 + (col >> 4)) * 256 + (row & 255)) * 16 + (col & 15)) = w; }
                    else *(u32x4*)(O + ro + bj * HALF) = w; } }
    }
};
}


namespace pg8 {
struct EpiQKV {
    static constexpr bool PERM = true, AFTER_DRAIN = false;
    bf16_t* QH; bf16_t* KBf; bf16_t* VBf; float* out; const float* qkn; const float* rope; PG8_LAS float* P;
    __device__ __forceinline__ void operator()(const f32x4 (&acc)[2][2][4][2], const Unit& u, int wr, int wc, int fr, int fq) const {
        const int pn = u.pn, pm = u.pm;
        const bool samp = pm >= 32; const int b = samp ? ((pm - 32) >> 4) : 0, tb = samp ? ((pm - 32) & 15) * 256 : 0;
        const int kind = pn < 4 ? 0 : pn == 4 ? 1 : pn == 5 ? 2 : pn < 10 ? 3 : pn < 14 ? 4 : 5;
        const bool nrm = kind <= 1, rp = samp && kind != 2 && kind != 5;
        const int j0 = wc * 32 + 8 * fq, t4 = 4 * (4 * wc + fq);
        if (nrm) {
#pragma unroll
            for (int ai = 0; ai < 2; ++ai)
#pragma unroll
                for (int m = 0; m < 4; ++m)
#pragma unroll
                    for (int bj = 0; bj < 2; ++bj) { const f32x4 a = acc[ai][bj][m][0], c = acc[ai][bj][m][1];
                        float ss = (a[0] * a[0] + a[1] * a[1]) + (a[2] * a[2] + a[3] * a[3]) + (c[0] * c[0] + c[1] * c[1]) + (c[2] * c[2] + c[3] * c[3]);
                        ss += __shfl_xor(ss, 16); ss += __shfl_xor(ss, 32);
                        if (fq == 0) P[((ai * HALF + wr * 64 + m * 16 + fr) * 2 + bj) * 4 + wc] = ss; }
            asm volatile("s_waitcnt lgkmcnt(0)" ::: "memory"); __builtin_amdgcn_s_barrier(); asm volatile("" ::: "memory");
        }
        f32x4 glo = {1.f, 1.f, 1.f, 1.f}, ghi = glo;
        if (nrm) { glo = *(const f32x4*)(qkn + kind * 128 + t4); ghi = *(const f32x4*)(qkn + kind * 128 + 64 + t4); }
#pragma unroll
        for (int ai = 0; ai < 2; ++ai)
#pragma unroll
            for (int m = 0; m < 4; ++m) {
                const int rl = ai * HALF + wr * 64 + m * 16 + fr, row = pm * BM + rl, tok = tb + rl;
                const size_t kvrow = samp ? (size_t)(8192 + b * 4352 + tok) : (size_t)row;
                f32x4 cs0 = {1.f, 0.f, 1.f, 0.f}, cs1 = cs0;
                if (rp) { cs0 = *(const f32x4*)(rope + ((size_t)tok * 64 + t4) * 2); cs1 = *(const f32x4*)(rope + ((size_t)tok * 64 + t4) * 2 + 4); }
#pragma unroll
                for (int bj = 0; bj < 2; ++bj) {
                    f32x4 v0 = acc[ai][bj][m][0], v1 = acc[ai][bj][m][1];
                    if (nrm) { const f32x4 q = *(const PG8_LAS f32x4*)(P + (rl * 2 + bj) * 4); const float r = 1.0f / sqrtf(((q[0] + q[1]) + (q[2] + q[3])) * (1.f / 128.f) + 1e-6f);
                        v0 = (f32x4){v0[0] * r * glo[0], v0[1] * r * ghi[0], v0[2] * r * glo[1], v0[3] * r * ghi[1]};
                        v1 = (f32x4){v1[0] * r * glo[2], v1[1] * r * ghi[2], v1[2] * r * glo[3], v1[3] * r * ghi[3]}; }
                    if (rp) {
                        v0 = (f32x4){v0[0] * cs0[0] - v0[1] * cs0[1], v0[0] * cs0[1] + v0[1] * cs0[0], v0[2] * cs0[2] - v0[3] * cs0[3], v0[2] * cs0[3] + v0[3] * cs0[2]};
                        v1 = (f32x4){v1[0] * cs1[0] - v1[1] * cs1[1], v1[0] * cs1[1] + v1[1] * cs1[0], v1[2] * cs1[2] - v1[3] * cs1[3], v1[2] * cs1[3] + v1[3] * cs1[2]}; }
                    u32x4 w; w.x = cvt_pk_bf16(v0[0], v0[1]); w.y = cvt_pk_bf16(v0[2], v0[3]); w.z = cvt_pk_bf16(v1[0], v1[1]); w.w = cvt_pk_bf16(v1[2], v1[3]);
                    if (kind == 0) *(u32x4*)(QH + (size_t)row * 2048 + (2 * pn + bj) * 128 + j0) = w;
                    else if (kind == 3) *(u32x4*)(QH + (size_t)row * 2048 + 1024 + (2 * (pn - 6) + bj) * 128 + j0) = w;
                    else if (kind == 1 || kind == 4) {
                        const int hb = (kind == 1) ? bj * 128 : 256 + (2 * (pn - 10) + bj) * 128;
                        *(u32x4*)(KBf + kvrow * 1280 + hb + j0) = w;
                        if (!samp) { float* o = (kind == 1) ? out + 35651584 - 2097152 + (size_t)row * 256 + bj * 128 : out + 37748736 + (size_t)row * 1024 + (2 * (pn - 10) + bj) * 128;
                            *(f32x4*)(o + t4) = (f32x4){v0[0], v0[2], v1[0], v1[2]}; *(f32x4*)(o + 64 + t4) = (f32x4){v0[1], v0[3], v1[1], v1[3]}; }
                    } else {
                        const int hb = (kind == 2) ? bj * 128 : 256 + (pn - 14) * 256 + bj * 128;
                        *(u32x4*)(VBf + kvrow * 1280 + hb + j0) = w;
                        if (!samp) { float* o = (kind == 2) ? out + 35651584 + (size_t)row * 256 + bj * 128 : out + 46137344 + (size_t)row * 1024 + (pn - 14) * 256 + bj * 128;
                            *(f32x4*)(o + j0) = v0; *(f32x4*)(o + j0 + 4) = v1; }
                    }
                }
            }
    }
};
}

#define LAS __attribute__((address_space(3)))
#define GAS __attribute__((address_space(1)))
constexpr int NWAVES = 8;
constexpr int RING_OFF = 0, RING_BYTES = 139264, LDSCTL_OFF = RING_BYTES, MISC_OFF = LDSCTL_OFF + 320, LDS_BYTES = 147456;
constexpr size_t WO_QKV = 0, WO_AO = 18 * MiB, WO_W1 = 26 * MiB, WO_W2 = 90 * MiB, WO_SI = 154 * MiB, WO_GL = 162 * MiB, WO_SO = 170 * MiB;
constexpr int CW_BAR = 4096, CW_ATTQ = 2048;

#define XB_TMO      128
#define XB_XCNT(j)  (256  + 64 * (j))
#define XB_XSUB(j)  (1280 + 64 * (j))
#define XB_XGEN(j)  (2304 + 64 * (j))
#define XB_TOP      3328
#define XB_TOPGEN   3392
#define XCD_BAR_WORDS 3456
#define XB_SPIN_CAP (1u << 18)
__device__ __forceinline__ unsigned xb_ld(unsigned* p)              { return __hip_atomic_load(p, __ATOMIC_RELAXED, __HIP_MEMORY_SCOPE_AGENT); }
__device__ __forceinline__ unsigned xb_add(unsigned* p, unsigned v) { return __hip_atomic_fetch_add(p, v, __ATOMIC_RELAXED, __HIP_MEMORY_SCOPE_AGENT); }
__device__ __forceinline__ unsigned xb_xcc_id() { return (unsigned)__builtin_amdgcn_s_getreg((3 << 11) | 20) & 0xFu; }
#define XB_SPIN(cond, bar) do { unsigned _sp = 0; while (cond) { __builtin_amdgcn_s_sleep(1); \
    if ((++_sp & 255u) == 0u) { if (xb_ld(&(bar)[XB_TMO])) break; if (_sp > XB_SPIN_CAP) { atomicAdd(&(bar)[XB_TMO], 1u); break; } } } } while (0)
struct XcdBarrier { unsigned* bar; unsigned x; volatile LAS unsigned* st; };
__device__ __forceinline__ XcdBarrier xcd_barrier_post(unsigned* bar, volatile LAS unsigned* st) {
    XcdBarrier b; b.bar = bar; b.x = xb_xcc_id(); b.st = st;
    if (threadIdx.x == 0) (void)xb_add(&bar[XB_XCNT(b.x)], 1u);
    return b;
}
__device__ __forceinline__ void xcd_barrier_complete(unsigned* bar, unsigned x, unsigned& nloc, unsigned& nx) {
    const unsigned G = gridDim.x * gridDim.y * gridDim.z;
    unsigned sum, cnt, mine, sp = 0u;
    for (;;) {
        sum = 0u; cnt = 0u; mine = 0u;
#pragma unroll
        for (unsigned j = 0; j < 16; ++j) { const unsigned c = xb_ld(&bar[XB_XCNT(j)]); sum += c; cnt += (c > 0u) ? 1u : 0u; mine = (j == x) ? c : mine; }
        if (sum == G) break;
        __builtin_amdgcn_s_sleep(1);
        if ((++sp & 255u) == 0u) { if (xb_ld(&bar[XB_TMO])) break; if (sp > XB_SPIN_CAP) { atomicAdd(&bar[XB_TMO], 1u); break; } }
    }
    nloc = mine > 0u ? mine : 1u; nx = cnt > 0u ? cnt : 1u;
}
__device__ __forceinline__ void xcd_barrier(const XcdBarrier& b) {
    asm volatile("s_waitcnt vmcnt(0)" ::: "memory");
    __syncthreads();
    if (threadIdx.x == 0) {
        unsigned* bar = b.bar;
        __builtin_amdgcn_s_waitcnt(0);
        unsigned nloc = b.st[0], nx = b.st[1];
        if (nloc == 0u) { xcd_barrier_complete(bar, b.x, nloc, nx); b.st[0] = nloc; b.st[1] = nx; }
        const unsigned old = xb_add(&bar[XB_XSUB(b.x)], 1u);
        const unsigned gen = old / nloc;
        if (old + 1u == (gen + 1u) * nloc) {
            __builtin_amdgcn_fence(__ATOMIC_RELEASE, "agent");
            asm volatile("s_waitcnt vmcnt(0)" ::: "memory");
            const unsigned og = xb_add(&bar[XB_TOP], 1u);
            const unsigned tg = og / nx;
            if (og + 1u == (tg + 1u) * nx) xb_add(&bar[XB_TOPGEN], 1u);
            else XB_SPIN(xb_ld(&bar[XB_TOPGEN]) == tg, bar);
            __builtin_amdgcn_fence(__ATOMIC_ACQUIRE, "agent");
            xb_add(&bar[XB_XGEN(b.x)], 1u);
            asm volatile("s_waitcnt vmcnt(0)" ::: "memory");
        } else {
            XB_SPIN(xb_ld(&bar[XB_XGEN(b.x)]) == gen, bar);
            __builtin_amdgcn_fence(__ATOMIC_ACQUIRE, "agent");
            asm volatile("s_waitcnt vmcnt(0)" ::: "memory");
        }
    }
    __syncthreads();
}

struct TItem { const float* src; bf16_t* dst; int N, K, n0, k0, qperm; };
__device__ __forceinline__ TItem titem_decode(const CP& p, int first, int it) {
    constexpr int I_QKV = (D / 64) * (NQKV / 32), I_SQ = (D / 64) * (D / 32), I_W1 = (D / 64) * (DFF / 32), I_W2 = (DFF / 64) * (D / 32);
    unsigned char* wb = p.ws + WS_W; TItem t; int r = it; t.qperm = 0;
    if (first == 0) {
        if (r < I_QKV) { t.src = p.attn_w_in; t.dst = (bf16_t*)(wb + WO_QKV); t.N = NQKV; t.K = D; t.qperm = 1; }
        else if ((r -= I_QKV) < I_SQ) { t.src = p.attn_w_out; t.dst = (bf16_t*)(wb + WO_AO); t.N = D; t.K = D; }
        else if ((r -= I_SQ) < I_W1) { t.src = p.mlp_w1; t.dst = (bf16_t*)(wb + WO_W1); t.N = DFF; t.K = D; }
        else { r -= I_W1; t.src = p.mlp_w2; t.dst = (bf16_t*)(wb + WO_W2); t.N = D; t.K = DFF; }
    } else {
        if (r < I_SQ) { t.src = p.ssm_w_in; t.dst = (bf16_t*)(wb + WO_SI); t.N = D; t.K = D; }
        else if ((r -= I_SQ) < I_SQ) { t.src = p.ssm_glu_w; t.dst = (bf16_t*)(wb + WO_GL); t.N = D; t.K = D; }
        else if ((r -= I_SQ) < I_SQ) { t.src = p.ssm_w_out; t.dst = (bf16_t*)(wb + WO_SO); t.N = D; t.K = D; }
        else if ((r -= I_SQ) < I_W1) { t.src = p.mlp_w1 + (size_t)D * DFF; t.dst = (bf16_t*)(wb + WO_W1 + 32 * MiB); t.N = DFF; t.K = D; }
        else { r -= I_W1; t.src = p.mlp_w2 + (size_t)DFF * D; t.dst = (bf16_t*)(wb + WO_W2 + 32 * MiB); t.N = D; t.K = DFF; }
    }
    const int nblk = t.N / 32, kb = r / nblk, nb = r % nblk; t.k0 = 64 * kb; t.n0 = 32 * nb;
    return t;
}
__device__ __forceinline__ int qkv_pos(int c) {
    const bool isv = (c >= 1280 && c < 1536) || c >= 3584; if (isv) return c;
    const int cl = c & 127, i = cl & 63, s = cl >> 6; return (c & ~127) + 8 * (i >> 2) + 2 * (i & 3) + s;
}
__device__ __forceinline__ void titem_load(float (&wv)[32], const TItem& t, int lane) {
    const float* s = t.src + (size_t)(t.k0 + (lane >> 3)) * t.N + t.n0 + (lane & 7) * 4;
#pragma unroll
    for (int i = 0; i < 8; ++i) { const f32x4 v = *(const f32x4*)(s + (size_t)(8 * i) * t.N); wv[4 * i] = v[0]; wv[4 * i + 1] = v[1]; wv[4 * i + 2] = v[2]; wv[4 * i + 3] = v[3]; }
}
__device__ __forceinline__ void titem_store(const float (&wv)[32], const TItem& t, LAS float* scr, int lane) {
#pragma unroll
    for (int i = 0; i < 8; ++i) { LAS float* d = scr + ((lane >> 3) + 8 * i) * 33 + (lane & 7) * 4; d[0] = wv[4 * i]; d[1] = wv[4 * i + 1]; d[2] = wv[4 * i + 2]; d[3] = wv[4 * i + 3]; }
    asm volatile("s_waitcnt lgkmcnt(0)" ::: "memory");
    const int c = lane & 7;
#pragma unroll
    for (int j = 0; j < 4; ++j) { const int n = (lane >> 3) + 8 * j; const LAS float* s = scr + (8 * c) * 33 + n;
        u32x4 o; o.x = pk2(s[0 * 33], s[1 * 33]); o.y = pk2(s[2 * 33], s[3 * 33]); o.z = pk2(s[4 * 33], s[5 * 33]); o.w = pk2(s[6 * 33], s[7 * 33]);
        const int row = t.qperm ? qkv_pos(t.n0 + n) : t.n0 + n;
        *(u32x4*)(t.dst + (size_t)row * t.K + t.k0 + 8 * c) = o; }
    asm volatile("s_waitcnt lgkmcnt(0)" ::: "memory");
}
__device__ __forceinline__ void transpose_run(const CP& p, LAS float* scr, int lane, int first, int start, int stride, int end) {
    if (start >= end) return;
    float wa[32], wb[32]; TItem ta = titem_decode(p, first, start), tb = ta;
    titem_load(wa, ta, lane);
    int it = start;
    for (;;) {
        const int i1 = it + stride; const bool h1 = i1 < end;
        if (h1) { tb = titem_decode(p, first, i1); titem_load(wb, tb, lane); }
        asm volatile("" ::: "memory");
        titem_store(wa, ta, scr, lane);
        if (!h1) break;
        const int i2 = i1 + stride; const bool h2 = i2 < end;
        if (h2) { ta = titem_decode(p, first, i2); titem_load(wa, ta, lane); }
        asm volatile("" ::: "memory");
        titem_store(wb, tb, scr, lane);
        if (!h2) break;
        it = i2;
    }
}
__device__ __forceinline__ void ph_prologue(const CP& p, LAS unsigned char* L, int lane, int wave) {
    const int gw = blockIdx.x * NWAVES + wave, NGW = gridDim.x * NWAVES;
    LAS float* sl = (LAS float*)(L + RING_OFF + 8 * 8704);
    for (int j = threadIdx.x; j < 3 * D; j += NWAVES * 64) { const int cls = j / D, k = j - cls * D; const float c0 = (cls == 0) ? p.c_ctx[k] : p.c[(cls - 1) * D + k]; sl[j] = c0 / (1.f + expf(-c0)); }
    __syncthreads();
    for (int it = gw; it < 2 * KCH * 48; it += NGW) {
        const int cb = it % 48, kc = (it / 48) % KCH, l = it / (48 * KCH);
        const float* w = p.ada_w + ((size_t)l * D + kc * 128) * NMOD + cb * 256 + lane * 4;
        f32x4 a0 = {0, 0, 0, 0}, a1 = a0, a2 = a0;
#pragma unroll 16
        for (int kk = 0; kk < 128; ++kk) {
            const int k = kc * 128 + kk;
            const float s0 = sl[k], s1 = sl[D + k], s2 = sl[2 * D + k];
            const f32x4 wv = *(const f32x4*)(w + (size_t)kk * NMOD);
            a0 += wv * s0; a1 += wv * s1; a2 += wv * s2;
        }
        float* o = (float*)(p.ws + WS_MODP) + ((size_t)(l * KCH + kc) * 3) * NMOD + cb * 256 + lane * 4;
        *(f32x4*)(o) = a0; *(f32x4*)(o + NMOD) = a1; *(f32x4*)(o + 2 * NMOD) = a2;
    }
    {
        LAS float* scr = (LAS float*)(L + RING_OFF + wave * 8704);
        constexpr int I_QKV = (D / 64) * (NQKV / 32), I_SQ = (D / 64) * (D / 32), I_W1 = (D / 64) * (DFF / 32), I_W2 = (DFF / 64) * (D / 32);
        constexpr int NITEMS0 = I_QKV + I_SQ + I_W1 + I_W2, NGEMV = 2 * KCH * 48;
        const int ng = NGW < NGEMV ? NGW : NGEMV;
        const int split = (NGW > ng) ? 8 * ng : NITEMS0;
        if (gw < ng) transpose_run(p, scr, lane, 0, gw, ng, split);
        else transpose_run(p, scr, lane, 0, split + (gw - ng), NGW - ng, NITEMS0);
    }
    for (int i = gw * 64 + lane; i < LQ * 64; i += NGW * 64) {
        const int t = i >> 6, j = i & 63;
        const float inv = powf(10000.f, -(float)(j & 31) / 32.f);
        const float pos = (j < 32) ? (float)(t >> 6) : (float)(t & 63);
        const float ang = pos * inv;
        ((f32x2*)(p.ws + WS_ROPE))[i] = (f32x2){cosf(ang), sinf(ang)};
    }
    for (int i2 = gw * 64 + lane; i2 < 2 * 128 * 64 * 16; i2 += NGW * 64) {
        const int c = i2 & 15, i = i2 >> 4, n = i & 63, kg = i >> 6;
        const float are = p.ssm_a_re[i], aim = p.ssm_a_im[i], dt = expf(p.ssm_log_dt[kg]);
        const float er = expf(are * dt), abr = er * cosf(aim * dt), abi = er * sinf(aim * dt);
        const float nr = abr - 1.f, ni = abi, den = are * are + aim * aim; const float cr = (nr * are + ni * aim) / den, ci = (ni * are - nr * aim) / den;
        if (c == 0) {
            ((f32x2*)(p.ws + WS_ABAR))[i] = (f32x2){abr, abi};
            float pr = abr, pi_ = abi;
#pragma unroll
            for (int s = 0; s < 8; ++s) { const float t = pr * pr - pi_ * pi_; pi_ = 2.f * pr * pi_; pr = t; }
            ((f32x2*)(p.ws + WS_A256))[i] = (f32x2){pr, pi_};
        }
        bf16_t* bbar = (bf16_t*)(p.ws + WS_BBAR) + (size_t)kg * 4 * 512; bf16_t* cmat = (bf16_t*)(p.ws + WS_CMAT) + (size_t)kg * 4 * 512;
        const int nn = n & 31, nh = n >> 5;
        const float br = p.ssm_b_re[(size_t)i * 16 + c], bi = p.ssm_b_im[(size_t)i * 16 + c];
        const int ln = (c >> 3) * 32 + nn, j = c & 7;
        bbar[(nh) * 512 + ln * 8 + j] = (bf16_t)f2bf(cr * br - ci * bi);
        bbar[(2 + nh) * 512 + ln * 8 + j] = (bf16_t)f2bf(cr * bi + ci * br);
        {
          const float vr = cr * br - ci * bi, vi = cr * bi + ci * br; float pr = 1.f, pi_ = 0.f;
#pragma unroll
          for (int e = 0; e < 4; ++e) {
              bf16_t* b4 = (bf16_t*)(p.ws + WS_BB4) + ((size_t)(3 - e) * 256 + kg) * 4 * 512;
              b4[(nh) * 512 + ln * 8 + j] = (bf16_t)f2bf(pr * vr - pi_ * vi); b4[(2 + nh) * 512 + ln * 8 + j] = (bf16_t)f2bf(pr * vi + pi_ * vr);
              const float t = pr * abr - pi_ * abi; pi_ = pr * abi + pi_ * abr; pr = t; }
          if (c == 0) ((f32x2*)(p.ws + WS_A4))[i] = (f32x2){pr, pi_}; }
        const float c_re = p.ssm_c_re[((size_t)kg * 16 + c) * 64 + n], c_im = p.ssm_c_im[((size_t)kg * 16 + c) * 64 + n];
        const int K0 = 4 * nn + 2 * nh;
        { const int K = K0, s = K >> 5, l2 = c + 16 * ((K & 31) >> 3), jj = K & 7; cmat[s * 512 + l2 * 8 + jj] = (bf16_t)f2bf(c_re); }
        { const int K = K0 + 1, s = K >> 5, l2 = c + 16 * ((K & 31) >> 3), jj = K & 7; cmat[s * 512 + l2 * 8 + jj] = (bf16_t)f2bf(-c_im); }
    }
    bf16_t* KBf = (bf16_t*)(p.ws + WS_KB); bf16_t* VBf = (bf16_t*)(p.ws + WS_VB);
    for (int r = gw; r < 512; r += NGW) {
        const int b = r >> 8, t = r & 255; const size_t kr = (size_t)(MP + b * LKV + LQ + t) * KVW;
        for (int c = lane * 2; c < 256; c += 128) { const size_t s = ((size_t)(b * 256 + t)) * 256 + c;
            KBf[kr + qkv_pos(c)] = (bf16_t)f2bf(p.cache_a_k[s]); KBf[kr + qkv_pos(c + 1)] = (bf16_t)f2bf(p.cache_a_k[s + 1]); *(unsigned*)(VBf + kr + c) = pk2(p.cache_a_v[s], p.cache_a_v[s + 1]); }
        for (int c = lane * 2; c < 1024; c += 128) { const size_t s = ((size_t)(b * 256 + t)) * 1024 + c;
            KBf[kr + 256 + qkv_pos(c)] = (bf16_t)f2bf(p.cache_b_k[s]); KBf[kr + 256 + qkv_pos(c + 1)] = (bf16_t)f2bf(p.cache_b_k[s + 1]); *(unsigned*)(VBf + kr + 256 + c) = pk2(p.cache_b_v[s], p.cache_b_v[s + 1]); }
    }
}


__device__ __forceinline__ void ph_late_weights(const CP& p, LAS unsigned char* L, int lane, int wave, int widx, int nw) {
    LAS float* scr = (LAS float*)(L + RING_OFF + wave * 8704);
    constexpr int I_SQ = (D / 64) * (D / 32), I_W1 = (D / 64) * (DFF / 32), I_W2 = (DFF / 64) * (D / 32);
    transpose_run(p, scr, lane, 1, widx, nw, 3 * I_SQ + I_W1 + I_W2);
}

template <bool FINAL>
__device__ __forceinline__ void ld_mod(const CP& p, LAS float* dst, int l, int cls, int idx, int tid) {
    for (int j = tid; j < D; j += NWAVES * 64) {
        if (FINAL) { dst[j] = ((const float*)(p.ws + WS_MOD))[((size_t)(l * 3 + cls) * 6 + idx) * D + j]; }
        else {
            float s = p.ada_b[l * NMOD + idx * D + j];
            const float* mp = (const float*)(p.ws + WS_MODP) + ((size_t)(l * KCH) * 3 + cls) * NMOD + idx * D + j;
#pragma unroll
            for (int kc = 0; kc < KCH; ++kc) s += mp[(size_t)kc * 3 * NMOD];
            dst[j] = s;
        }
    }
}
__device__ __forceinline__ void mod_finish(const CP& p, int tid) {
    const int per = (2 * 3 * NMOD + (int)gridDim.x - 1) / (int)gridDim.x;
    for (int i = (int)blockIdx.x * per + tid; i < ((int)blockIdx.x + 1) * per && i < 2 * 3 * NMOD; i += NWAVES * 64) {
        const int j = i % NMOD, cls = (i / NMOD) % 3, l = i / (3 * NMOD);
        float s = p.ada_b[l * NMOD + j];
        const float* mp = (const float*)(p.ws + WS_MODP) + ((size_t)(l * KCH) * 3 + cls) * NMOD + j;
#pragma unroll
        for (int kc = 0; kc < KCH; ++kc) s += mp[(size_t)kc * 3 * NMOD];
        ((float*)(p.ws + WS_MOD))[i] = s;
    }
}
struct RowIn { f32x4 xf[8]; u32x2 xh[8]; u32x2 ow[8]; };
template <bool BR, bool XIN16>
__device__ __forceinline__ void row_load(RowIn& in, int m, int lane, const float* xin_row, const bf16_t* xin16, const bf16_t* o) {
    if (XIN16) {
#pragma unroll
        for (int j = 0; j < 8; ++j) in.xh[j] = *(const u32x2*)(xin16 + (size_t)m * D + j * 256 + lane * 4);
    } else {
#pragma unroll
        for (int j = 0; j < 8; ++j) in.xf[j] = *(const f32x4*)(xin_row + j * 256 + lane * 4);
    }
    if (BR) {
#pragma unroll
        for (int j = 0; j < 8; ++j) in.ow[j] = *(const u32x2*)(o + (size_t)m * D + j * 256 + lane * 4);
    }
}
template <bool BR, bool NX, bool XIN16, bool XOUT16>
__device__ __forceinline__ void row_compute(const CP& p, const RowIn& in, int m, int lane, bf16_t* xout16, bf16_t* xn,
                                            const LAS float* gate, const float* gp, const LAS float* sh, const LAS float* sc, const float* gn) {
    f32x4 x[8];
#pragma unroll
    for (int j = 0; j < 8; ++j) {
        if (XIN16) { const u32x2 w = in.xh[j]; x[j] = (f32x4){__uint_as_float(w.x << 16), __uint_as_float(w.x & 0xffff0000u), __uint_as_float(w.y << 16), __uint_as_float(w.y & 0xffff0000u)}; }
        else x[j] = in.xf[j];
    }
    if (BR) {
        f32x4 ov[8]; float ss = 0.f;
#pragma unroll
        for (int j = 0; j < 8; ++j) { const u32x2 w = in.ow[j];
            ov[j] = (f32x4){__uint_as_float(w.x << 16), __uint_as_float(w.x & 0xffff0000u), __uint_as_float(w.y << 16), __uint_as_float(w.y & 0xffff0000u)};
            ss += ov[j].x * ov[j].x + ov[j].y * ov[j].y + ov[j].z * ov[j].z + ov[j].w * ov[j].w; }
        const float r = 1.0f / sqrtf(wave_sum(ss) * (1.f / D) + EPS);
        float* xo = p.out + OUT_Y + (size_t)m * D;
#pragma unroll
        for (int j = 0; j < 8; ++j) { const f32x4 g4 = *(const LAS f32x4*)(gate + j * 256 + lane * 4);
            x[j] = x[j] + g4 * (ov[j] * r);
            if (XOUT16) { u32x2 w; w.x = pk2(x[j].x, x[j].y); w.y = pk2(x[j].z, x[j].w); *(u32x2*)(xout16 + (size_t)m * D + j * 256 + lane * 4) = w; }
            else *(f32x4*)(xo + j * 256 + lane * 4) = x[j]; }
    }
    if (NX) {
        float ss = 0.f;
#pragma unroll
        for (int j = 0; j < 8; ++j) ss += x[j].x * x[j].x + x[j].y * x[j].y + x[j].z * x[j].z + x[j].w * x[j].w;
        const float r = 1.0f / sqrtf(wave_sum(ss) * (1.f / D) + EPS);
#pragma unroll
        for (int j = 0; j < 8; ++j) { const f32x4 s4 = *(const LAS f32x4*)(sh + j * 256 + lane * 4), c4 = *(const LAS f32x4*)(sc + j * 256 + lane * 4);
            const f32x4 v = (x[j] * r) * c4 + s4;
            u32x2 w; w.x = pk2(v.x, v.y); w.y = pk2(v.z, v.w); *(u32x2*)(xn + (size_t)m * D + j * 256 + lane * 4) = w; }
    }
}
template <bool BR, bool NX, bool XIN16, bool XOUT16>
__device__ __forceinline__ void rows8(const CP& p, int mbase, int lane, const bf16_t* xin16, bf16_t* xout16, const bf16_t* o, bf16_t* xn,
                                      const LAS float* gate, const float* gp, const LAS float* sh, const LAS float* sc, const float* gn) {
#define ROW_LD(R, mm) row_load<BR, XIN16>(R, (mm), lane, XIN16 ? nullptr : x_row(p, (mm)), xin16, o); asm volatile("" ::: "memory")
#define ROW_DO(R, mm) row_compute<BR, NX, XIN16, XOUT16>(p, R, (mm), lane, xout16, xn, gate, gp, sh, sc, gn)
    RowIn A, B; ROW_LD(A, mbase);
#pragma unroll 1
    for (int i = 0; i < 6; i += 2) {
        ROW_LD(B, mbase + i + 1); ROW_DO(A, mbase + i);
        ROW_LD(A, mbase + i + 2); ROW_DO(B, mbase + i + 1);
    }
    ROW_LD(B, mbase + 7); ROW_DO(A, mbase + 6); ROW_DO(B, mbase + 7);
#undef ROW_LD
#undef ROW_DO
}
template <int MODE>
__device__ __forceinline__ void ph_rowop(const CP& p, LAS unsigned char* L, int tid, int lane, int wave, int l, const bf16_t* o, bf16_t* xn) {
    LAS float* vg = (LAS float*)(L + RING_OFF); LAS float* vs = vg + D; LAS float* vc = vs + D;
    constexpr bool BR = MODE != 0, NX = MODE != 3;
    const int lb = l, ib = (MODE == 1) ? 0 : 3, ln = (MODE == 2) ? l + 1 : l, in_ = (MODE == 1) ? 3 : 0;
    int cur = -1;
    const bool own = gridDim.x == 256;
    for (int mb_ = blockIdx.x * 64; mb_ < M; mb_ += gridDim.x * 64) {
        const int c_ = (int)blockIdx.x, m0 = own ? (8 * (c_ % 8) + (c_ / 8) % 8) * 256 + 64 * (c_ / 64) : mb_;
        const int cls = row_class(m0);
        if (cls != cur) {
            __syncthreads();
            const float* gp = p.norm_g + (size_t)(lb * 4 + (ib == 0 ? 1 : 3)) * D; const float* gn = p.norm_g + (size_t)(ln * 4 + (in_ == 0 ? 0 : 2)) * D;
            if (BR) ld_mod<MODE != 0>(p, vg, lb, cls, ib + 2, tid);
            if (NX) { ld_mod<MODE != 0>(p, vs, ln, cls, in_, tid); ld_mod<MODE != 0>(p, vc, ln, cls, in_ + 1, tid); }
            for (int j = tid; j < D; j += NWAVES * 64) {
                if (BR) vg[j] = vg[j] * gp[j];
                if (NX) vc[j] = (vc[j] + 1.0f) * gn[j]; }
            __syncthreads(); cur = cls;
        }
        const float* gp = nullptr; const float* gn = nullptr;
        { const int mb = m0 + wave * 8;
            bf16_t* XR = (bf16_t*)(p.ws + WS_QH);
            if (MODE == 0) rows8<BR, NX, false, true>(p, mb, lane, nullptr, nullptr, o, xn, vg, gp, vs, vc, gn);
            else if (MODE == 1 && l == 0) rows8<BR, NX, false, true>(p, mb, lane, nullptr, XR, o, xn, vg, gp, vs, vc, gn);
            else if (MODE == 3) rows8<BR, NX, true, false>(p, mb, lane, XR, nullptr, o, xn, vg, gp, vs, vc, gn);
            else rows8<BR, NX, true, true>(p, mb, lane, XR, XR, o, xn, vg, gp, vs, vc, gn); }
    }
    if (MODE == 0) mod_finish(p, tid);
    __syncthreads();
}

__device__ __forceinline__ void ph_combine(const CP& p, int lane, int wave, bf16_t* OC) {
    const int gw = blockIdx.x * NWAVES + wave, NGW = gridDim.x * NWAVES;
    const bf16_t* O = (const bf16_t*)(p.ws + WS_O);
    const float* lp = p.diff_lambda;
    const float s1 = wave_sum(lp[2 * lane] * lp[128 + 2 * lane] + lp[2 * lane + 1] * lp[128 + 2 * lane + 1]);
    const float s2 = wave_sum(lp[256 + 2 * lane] * lp[384 + 2 * lane] + lp[256 + 2 * lane + 1] * lp[384 + 2 * lane + 1]);
    const float lam_init = 0.2f, lam = expf(s1) - expf(s2) + lam_init;
    for (int m = gw; m < M; m += NGW) {
        const bf16_t* orow = O + (size_t)m * D - 1024; bf16_t* oc = OC + (size_t)m * D;
#pragma unroll
        for (int h = 0; h < 4; ++h) {
            float v[2][2]; float ss = 0.f;
#pragma unroll
            for (int vh = 0; vh < 2; ++vh) {
                const unsigned w0 = *(const unsigned*)(orow + 1024 + (4 * h + vh) * 128 + 2 * lane), w1 = *(const unsigned*)(orow + 1024 + (4 * h + 2 + vh) * 128 + 2 * lane);
                v[vh][0] = __uint_as_float(w0 << 16) - lam * __uint_as_float(w1 << 16); v[vh][1] = __uint_as_float(w0 & 0xffff0000u) - lam * __uint_as_float(w1 & 0xffff0000u);
                ss += v[vh][0] * v[vh][0] + v[vh][1] * v[vh][1];
            }
            const float r = (1.0f / sqrtf(wave_sum(ss) * (1.f / 256.f) + EPS)) * (1.f - lam_init);
#pragma unroll
            for (int vh = 0; vh < 2; ++vh) { const float* g = p.diff_subln + vh * 128 + 2 * lane;
                *(unsigned*)(oc + 1024 + h * 256 + vh * 128 + 2 * lane) = pk2(v[vh][0] * r * g[0], v[vh][1] * r * g[1]); }
        }
    }
}

template <int ACT>
__device__ __forceinline__ void ph_gemm(LAS unsigned char* L, const bf16_t* A, const bf16_t* Bt, int N, int K, bf16_t* C, const bf16_t* aux, int wgm = pg8::WGM) {
    pg8::Gemm g{A, Bt, M, N, K}; pg8::StaticOrder S; S.init(M, N, (int)gridDim.x, (int)blockIdx.x, wgm);
    pg8::EpiStore<ACT> E{C, N, aux};
    pg8::gemm_phase<pg8::EpiStore<ACT>, pg8::StaticOrder, true, true>(L + RING_OFF, g, S, E);
}


__device__ __forceinline__ void ph_gemm_qkv(const CP& p, LAS unsigned char* L, const bf16_t* A, const bf16_t* Bt, int lane, int wave) {
    pg8::Gemm g{A, Bt, M, NQKV, D}; pg8::StaticOrder S; S.init(M, NQKV, (int)gridDim.x, (int)blockIdx.x);
    pg8::EpiQKV E{(bf16_t*)(p.ws + WS_QH), (bf16_t*)(p.ws + WS_KB), (bf16_t*)(p.ws + WS_VB), p.out, p.qk_norm, (const float*)(p.ws + WS_ROPE), (LAS float*)(L + 131072)};
    pg8::gemm_phase<pg8::EpiQKV, pg8::StaticOrder, true, true>(L + RING_OFF, g, S, E);
    const int G = (int)gridDim.x, nfull = 1152 / G, first_idle = 1152 - nfull * G;
    if ((int)blockIdx.x >= first_idle) ph_late_weights(p, L, lane, wave, ((int)blockIdx.x - first_idle) * NWAVES + wave, (G - first_idle) * NWAVES);
}

__device__ __forceinline__ void ph_attn(const CP& p, unsigned char* lds, bf16_t* OC) {
    const int G = gridDim.x, bx = blockIdx.x;
    const int vcu = (G % 8 == 0) ? (bx % 8) * (G / 8) + bx / 8 : bx;
    const bf16_t* QH = (const bf16_t*)(p.ws + WS_QH); const bf16_t* KBf = (const bf16_t*)(p.ws + WS_KB); const bf16_t* VBf = (const bf16_t*)(p.ws + WS_VB);
    bf16_t* O = (bf16_t*)(p.ws + WS_O);
    for (int U = vcu; U < 256; U += G) {
        const int b = U >> 7, hm = (U >> 4) & 7, qb = U & 15, qrow0 = MP + b * LQ + qb * 256, krow0 = MP + b * LKV;
        int seq = LKV; asm volatile("" : "+s"(seq));
        att::attn_wide_body<2>((const att::bf16*)(QH + (size_t)qrow0 * D + 1024 + hm * 128), (const att::bf16*)(KBf + (size_t)krow0 * KVW + 256 + hm * 128),
                            (const att::bf16*)(VBf + (size_t)krow0 * KVW + 256 + (hm >> 1) * 256), O + (size_t)qrow0 * D + hm * 256, D, seq, (char*)lds);
    }
    for (int U = vcu; U < 256; U += G) {
        const int b = U >> 7, inst = (U >> 4) & 7, qb = U & 15, qrow0 = MP + b * LQ + qb * 256, krow0 = MP + b * LKV;
        int seq = LKV; asm volatile("" : "+s"(seq));
        const int koff = (inst >> 2) * 128;
        att::attn_wide_body<1>((const att::bf16*)(QH + (size_t)qrow0 * D + inst * 128), (const att::bf16*)(KBf + (size_t)krow0 * KVW + koff),
                               (const att::bf16*)(VBf + (size_t)krow0 * KVW + koff), OC + (size_t)qrow0 * D + inst * 128, D, seq, (char*)lds);
    }
    __syncthreads();
    for (int t = vcu; t < 768; t += G) {
        const int b = (int)t / 24, inst = (int)t % 24, qrow0 = b * 256, krow0 = b * 256;
        int qoff, koff, voff, ooff;
        if (inst < 8) { qoff = inst * 128; koff = (inst >> 2) * 128; voff = koff; ooff = inst * 128; }
        else { const int i2 = inst - 8, hm = i2 >> 1, vh = i2 & 1; qoff = 1024 + hm * 128; koff = 256 + hm * 128; voff = 256 + (hm >> 1) * 256 + vh * 128; ooff = 1024 + i2 * 128; }
        bf16_t* op = (inst < 8) ? OC + (size_t)qrow0 * D + ooff : O + (size_t)qrow0 * D + (ooff - 1024);
        att::attn_small_body((const att::bf16*)(QH + (size_t)qrow0 * D + qoff), (const att::bf16*)(KBf + (size_t)krow0 * KVW + koff),
                             (const att::bf16*)(VBf + (size_t)krow0 * KVW + voff), op, D, (char*)lds);
    }
}


typedef short s16x8 __attribute__((ext_vector_type(8)));
typedef float f32x16 __attribute__((ext_vector_type(16)));
constexpr int SSM_IMG_ROW = 272, SSM_IMG = 16 * SSM_IMG_ROW, SSM_YBUF = 8192, SSM_WAVE_LDS = 2 * SSM_IMG + SSM_YBUF;
__device__ __forceinline__ float gelu_fast(float v) { const float u = 0.7978845608028654f * (v + 0.044715f * v * v * v); return v * __builtin_amdgcn_rcpf(1.f + __builtin_amdgcn_exp2f(-2.8853900817779268f * u)); }
struct SsmItem {
    f32x2 alo, ahi; const s16x8* BB; const s16x8* CM; unsigned fo; f32x4 dd4; unsigned uo; int ustep; const bf16_t* U; bf16_t* Z; int t0, g, hh;
    LAS unsigned char* img; LAS unsigned char* ybuf; int nn, half, ti, cq;
};
template <int MODE>
__device__ __forceinline__ void ssm_tile(const SsmItem& S, int tau, f32x16 (&acur)[4], f32x16 (&anxt)[4], const s16x8& ux, s16x8& uy, f32x2& hlo, f32x2& hhi, u32x2& uf4n, u32x2& ub4n, s16x8 (&bfw)[4], s16x8 (&bbw)[4]) {
    const u32x2 uf4 = uf4n, ub4 = ub4n;
    if (tau + 2 < 16) uy = *(const s16x8*)(S.U + (unsigned)((int)S.uo + (tau + 2) * S.ustep));
    if (MODE == 1 && tau >= 7 && tau < 15) {
        uf4n = *(const u32x2*)(S.U + (unsigned)((S.t0 + 16 * (tau + 1) + S.ti) * D + 16 * S.g + 4 * S.cq));
        ub4n = *(const u32x2*)(S.U + (unsigned)((S.t0 + 255 - 16 * (tau + 1) - S.ti) * D + 16 * S.g + 4 * S.cq)); }
    if (tau + 1 < 16) {
        const s16x8 z8 = {0, 0, 0, 0, 0, 0, 0, 0};
        const s16x8 uf = S.hh ? z8 : ux, ub = S.hh ? ux : z8;
#pragma unroll
        for (int q = 0; q < 4; ++q) { anxt[q] = __builtin_amdgcn_mfma_f32_32x32x16_bf16(uf, bfw[q], (f32x16){0.f}, 0, 0, 0); anxt[q] = __builtin_amdgcn_mfma_f32_32x32x16_bf16(ub, bbw[q], anxt[q], 0, 0, 0); }
    }
    const f32x2 alo = S.alo, ahi = S.ahi;
    s16x8 cfw[4], cbw[4];
#pragma unroll
    for (int i = 0; i < 16; ++i) {
        float lr = __builtin_fmaf(alo.x, hlo.x, __builtin_fmaf(-alo.y, hlo.y, acur[0][i])); asm volatile("" : "+v"(lr));
        float li = __builtin_fmaf(alo.x, hlo.y, __builtin_fmaf(alo.y, hlo.x, acur[2][i])); asm volatile("" : "+v"(li));
        float hr = __builtin_fmaf(ahi.x, hhi.x, __builtin_fmaf(-ahi.y, hhi.y, acur[1][i])); asm volatile("" : "+v"(hr));
        float hi2 = __builtin_fmaf(ahi.x, hhi.y, __builtin_fmaf(ahi.y, hhi.x, acur[3][i])); asm volatile("" : "+v"(hi2));
        hlo = (f32x2){lr, li}; hhi = (f32x2){hr, hi2};
        if (MODE == 1) { u32x2 w; w.x = pk2(lr, li); w.y = pk2(hr, hi2); *(LAS u32x2*)(S.img + S.half * SSM_IMG + i * SSM_IMG_ROW + S.nn * 8) = w; }
        if (MODE == 1 && i == 11 && tau + 2 < 16) {
            asm volatile("" ::: "memory");
#pragma unroll
            for (int q = 0; q < 4; ++q) { bfw[q] = S.BB[S.fo + q * 64]; bbw[q] = S.BB[S.fo + 32768u + q * 64]; }
        }
        if (MODE == 1 && i == 7) {
            asm volatile("" ::: "memory");
#pragma unroll
            for (int q = 0; q < 4; ++q) { cfw[q] = S.CM[S.fo + q * 64]; cbw[q] = S.CM[S.fo + 32768u + q * 64]; }
        }
    }
    if (MODE == 1) {
        const int ti = S.ti, cq = S.cq, g = S.g, t0 = S.t0;
        asm volatile("" ::: "memory");
        f32x4 y0 = {0.f, 0.f, 0.f, 0.f}, y1 = {0.f, 0.f, 0.f, 0.f};
#pragma unroll
        for (int s = 0; s < 4; ++s) {
            const s16x8 b0 = *(const LAS s16x8*)(S.img + ti * SSM_IMG_ROW + 64 * s + 16 * cq), b1 = *(const LAS s16x8*)(S.img + SSM_IMG + ti * SSM_IMG_ROW + 64 * s + 16 * cq);
            y0 = __builtin_amdgcn_mfma_f32_16x16x32_bf16(cfw[s], b0, y0, 0, 0, 0); y1 = __builtin_amdgcn_mfma_f32_16x16x32_bf16(cbw[s], b1, y1, 0, 0, 0);
        }
        asm volatile("s_nop 15\n\ts_nop 7" : "+v"(y0), "+v"(y1) :: "memory");
        LAS unsigned char* af = S.ybuf + tau * 512 + ti * 32 + 8 * cq; LAS unsigned char* ab = S.ybuf + (15 - tau) * 512 + (15 - ti) * 32 + 8 * cq;
        if (tau < 8) {
            u32x2 w; w.x = pk2(y0[0], y0[1]); w.y = pk2(y0[2], y0[3]); *(LAS u32x2*)af = w;
            w.x = pk2(y1[0], y1[1]); w.y = pk2(y1[2], y1[3]); *(LAS u32x2*)ab = w;
        } else {
            const u32x2 sf = *(const LAS u32x2*)af, sb = *(const LAS u32x2*)ab;
            const unsigned tokf = (unsigned)(t0 + 16 * tau + ti), tokb = (unsigned)(t0 + 255 - 16 * tau - ti);
            f32x4 tf = y0 + (f32x4){__uint_as_float(sf.x << 16), __uint_as_float(sf.x & 0xffff0000u), __uint_as_float(sf.y << 16), __uint_as_float(sf.y & 0xffff0000u)};
            f32x4 tb = y1 + (f32x4){__uint_as_float(sb.x << 16), __uint_as_float(sb.x & 0xffff0000u), __uint_as_float(sb.y << 16), __uint_as_float(sb.y & 0xffff0000u)};
            tf = tf + S.dd4 * (f32x4){__uint_as_float(uf4.x << 16), __uint_as_float(uf4.x & 0xffff0000u), __uint_as_float(uf4.y << 16), __uint_as_float(uf4.y & 0xffff0000u)};
            tb = tb + S.dd4 * (f32x4){__uint_as_float(ub4.x << 16), __uint_as_float(ub4.x & 0xffff0000u), __uint_as_float(ub4.y << 16), __uint_as_float(ub4.y & 0xffff0000u)};
            u32x2 w; w.x = pk2(gelu_fast(tf[0]), gelu_fast(tf[1])); w.y = pk2(gelu_fast(tf[2]), gelu_fast(tf[3])); *(u32x2*)(S.Z + (tokf * D + 16 * g + 4 * cq)) = w;
            w.x = pk2(gelu_fast(tb[0]), gelu_fast(tb[1])); w.y = pk2(gelu_fast(tb[2]), gelu_fast(tb[3])); *(u32x2*)(S.Z + (tokb * D + 16 * g + 4 * cq)) = w;
        }
        asm volatile("" ::: "memory");
    }
}
template <int MODE  >
__device__ __forceinline__ void ph_ssm_scan(const CP& p, LAS unsigned char* L, int lane, int wave, const bf16_t* U, bf16_t* Z) {
    const int gw = blockIdx.x * NWAVES + wave, NGW = gridDim.x * NWAVES;
    const f32x2* ABAR = (const f32x2*)(p.ws + WS_ABAR); const f32x2* SST = (const f32x2*)(p.ws + WS_SST);
    const s16x8* BBAR = (const s16x8*)(p.ws + WS_BBAR); const s16x8* CMAT = (const s16x8*)(p.ws + WS_CMAT);
    constexpr int NITEMS = (MODE == 0 ? 32 : 64) * 128;
    SsmItem S;
    S.img = L + RING_OFF + wave * SSM_WAVE_LDS; S.ybuf = S.img + 2 * SSM_IMG;
    S.nn = lane & 31; S.half = lane >> 5; S.ti = lane & 15; S.cq = lane >> 4; S.U = U; S.Z = Z;
    const int nn = S.nn, half = S.half;
#pragma unroll 1
    for (int it = gw; it < NITEMS; it += NGW) {
        const int g = it & 127, ci = it >> 7;
        const bool samp = (MODE == 0) || ci >= 32; const int sc = (MODE == 0) ? ci : ci - 32;
        const int t0 = samp ? MP + sc * 256 : ci * 256;
        const int pidx = (half * 128 + g) * 64;
        S.g = g; S.t0 = t0;
        S.alo = ABAR[pidx + nn]; S.ahi = ABAR[pidx + nn + 32];
        S.BB = BBAR; S.CM = CMAT; S.fo = (unsigned)(g * 256 + lane);
        s16x8 bfw[4], bbw[4];
#pragma unroll
        for (int q = 0; q < 4; ++q) { bfw[q] = BBAR[S.fo + q * 64]; bbw[q] = BBAR[S.fo + 32768u + q * 64]; }
        f32x2 hlo = {0.f, 0.f}, hhi = {0.f, 0.f};
        if (MODE == 1 && samp) {
            const int bq = sc >> 4, cq2 = sc & 15; const f32x2* A256 = (const f32x2*)(p.ws + WS_A256);
            const f32x2 qlo = A256[pidx + nn], qhi = A256[pidx + nn + 32];
            const float* st = p.state_ssm + ((size_t)(bq * 2 + half) * 128 + g) * 128;
            hlo = (f32x2){st[2 * nn], st[2 * nn + 1]}; hhi = (f32x2){st[2 * nn + 64], st[2 * nn + 65]};
            const int nst = half ? 15 - cq2 : cq2;
            f32x2 s0[15], s1[15];
#pragma unroll
            for (int k = 0; k < 15; ++k) { const int j = half ? 15 - k : k; const size_t o = ((size_t)((bq * 16 + j) * 2 + half) * 128 + g) * 64; s0[k] = SST[o + nn]; s1[k] = SST[o + nn + 32]; }
#pragma unroll
            for (int k = 0; k < 15; ++k) {
                const f32x2 nl = {qlo.x * hlo.x - qlo.y * hlo.y + s0[k].x, qlo.x * hlo.y + qlo.y * hlo.x + s0[k].y};
                const f32x2 nh = {qhi.x * hhi.x - qhi.y * hhi.y + s1[k].x, qhi.x * hhi.y + qhi.y * hhi.x + s1[k].y};
                hlo = (k < nst) ? nl : hlo; hhi = (k < nst) ? nh : hhi;
            }
        }
        const int r = lane & 31, hh = (r >> 2) & 1, si = 4 * (r >> 3) + (r & 3);
        S.hh = hh;
        S.uo = (unsigned)((hh ? t0 + 255 - si : t0 + si) * D + 16 * g + 8 * (lane >> 5));
        S.ustep = hh ? -16 * D : 16 * D;
        S.dd4 = *(const f32x4*)(p.ssm_d + 16 * g + 4 * S.cq);
        const s16x8 u0 = *(const s16x8*)(U + S.uo); s16x8 uX = *(const s16x8*)(U + (unsigned)((int)S.uo + S.ustep)), uY = uX;
        u32x2 uf4n = {0u, 0u}, ub4n = {0u, 0u};
        f32x16 accA[4], accB[4];
        { const s16x8 z8 = {0, 0, 0, 0, 0, 0, 0, 0}; const s16x8 uf = hh ? z8 : u0, ub = hh ? u0 : z8;
#pragma unroll
          for (int q = 0; q < 4; ++q) { accA[q] = __builtin_amdgcn_mfma_f32_32x32x16_bf16(uf, bfw[q], (f32x16){0.f}, 0, 0, 0); accA[q] = __builtin_amdgcn_mfma_f32_32x32x16_bf16(ub, bbw[q], accA[q], 0, 0, 0); } }
#pragma unroll 1
        for (int tau = 0; tau < 16; tau += 2) {
            ssm_tile<MODE>(S, tau, accA, accB, uX, uY, hlo, hhi, uf4n, ub4n, bfw, bbw);
            ssm_tile<MODE>(S, tau + 1, accB, accA, uY, uX, hlo, hhi, uf4n, ub4n, bfw, bbw);
        }
        if (MODE == 0) { f32x2* o = (f32x2*)(p.ws + WS_SST) + ((size_t)(sc * 2 + half) * 128 + g) * 64; o[nn] = hlo; o[nn + 32] = hhi; }
        else if (!samp) { f32x2* o = (f32x2*)(p.out + OUT_ST) + ((size_t)(ci * 2 + half) * 128 + g) * 64; o[nn] = hlo; o[nn + 32] = hhi; }
    }
}
__device__ __forceinline__ void ph_ssm_state4(const CP& p, int lane, int wave, const bf16_t* U) {
    const int gw = blockIdx.x * NWAVES + wave, NGW = gridDim.x * NWAVES;
    const int nn = lane & 31, half = lane >> 5;
    const f32x2* A4 = (const f32x2*)(p.ws + WS_A4); const s16x8* BB4 = (const s16x8*)(p.ws + WS_BB4);
    const int r = lane & 31, hh = (r >> 2) & 1, sg = 4 * (r >> 3) + (r & 3);
    int gcur = -1; s16x8 bf4[4][4], bb4[4][4]; f32x2 alo = {0.f, 0.f}, ahi = {0.f, 0.f};
#pragma unroll 1
    for (int it = gw; it < 32 * 128; it += NGW) {
        const int g = it & 127, sc = it >> 7, t0 = MP + sc * 256;
        if (g != gcur) {
#pragma unroll
            for (int j = 0; j < 4; ++j)
#pragma unroll
                for (int q = 0; q < 4; ++q) { bf4[j][q] = BB4[((size_t)(j * 256 + g) * 4 + q) * 64 + lane]; bb4[j][q] = BB4[((size_t)(j * 256 + 128 + g) * 4 + q) * 64 + lane]; }
            const int pidx = (half * 128 + g) * 64; alo = A4[pidx + nn]; ahi = A4[pidx + nn + 32]; gcur = g;
        }
        const bf16_t* ua = U + ((size_t)(t0 >> 8) * 128 + g) * 4096 + (hh ? 255 - 4 * sg : 4 * sg) * 16 + 8 * (lane >> 5);
        const long js = hh ? -16L : 16L;
        s16x8 u[4];
#pragma unroll
        for (int j = 0; j < 4; ++j) u[j] = *(const s16x8*)(ua + j * js);
        f32x2 hlo = {0.f, 0.f}, hhi = {0.f, 0.f};
#pragma unroll 1
        for (int m = 0; m < 4; ++m) {
            f32x16 acc[4]; const s16x8 z8 = {0, 0, 0, 0, 0, 0, 0, 0};
#pragma unroll
            for (int j = 0; j < 4; ++j) { const s16x8 uf = hh ? z8 : u[j], ub = hh ? u[j] : z8;
#pragma unroll
                for (int q = 0; q < 4; ++q) {
                    if (j == 0) acc[q] = __builtin_amdgcn_mfma_f32_32x32x16_bf16(uf, bf4[j][q], (f32x16){0.f}, 0, 0, 0); else acc[q] = __builtin_amdgcn_mfma_f32_32x32x16_bf16(uf, bf4[j][q], acc[q], 0, 0, 0);
                    acc[q] = __builtin_amdgcn_mfma_f32_32x32x16_bf16(ub, bb4[j][q], acc[q], 0, 0, 0); } }
            const long mo = (long)(m + 1 < 4 ? m + 1 : 3) * 64 * js;
#pragma unroll
            for (int j = 0; j < 4; ++j) u[j] = *(const s16x8*)(ua + mo + j * js);
#pragma unroll
            for (int i = 0; i < 16; ++i) {
                float lr = __builtin_fmaf(alo.x, hlo.x, __builtin_fmaf(-alo.y, hlo.y, acc[0][i])); asm volatile("" : "+v"(lr));
                float li = __builtin_fmaf(alo.x, hlo.y, __builtin_fmaf(alo.y, hlo.x, acc[2][i])); asm volatile("" : "+v"(li));
                float hr = __builtin_fmaf(ahi.x, hhi.x, __builtin_fmaf(-ahi.y, hhi.y, acc[1][i])); asm volatile("" : "+v"(hr));
                float hi2 = __builtin_fmaf(ahi.x, hhi.y, __builtin_fmaf(ahi.y, hhi.x, acc[3][i])); asm volatile("" : "+v"(hi2));
                hlo = (f32x2){lr, li}; hhi = (f32x2){hr, hi2};
            }
        }
        f32x2* o = (f32x2*)(p.ws + WS_SST) + ((size_t)(sc * 2 + half) * 128 + g) * 64; o[nn] = hlo; o[nn + 32] = hhi;
    }
}
template <int MODE  , int HW = 0  >
__device__ __forceinline__ void ph_ssm_scan_np(const CP& p, LAS unsigned char* L, int lane, int wave, const bf16_t* U, bf16_t* Z) {
    if (HW && wave >= 4) return;
    const int gw = HW ? blockIdx.x * 4 + wave : blockIdx.x * NWAVES + wave, NGW = HW ? gridDim.x * 4 : gridDim.x * NWAVES;
    LAS unsigned char* img = L + RING_OFF + wave * SSM_WAVE_LDS;
    LAS unsigned char* ybuf = img + 2 * SSM_IMG;
    const int nn = lane & 31, half = lane >> 5, ti = lane & 15, cq = lane >> 4;
    const f32x2* ABAR = (const f32x2*)(p.ws + WS_ABAR); const f32x2* SST = (const f32x2*)(p.ws + WS_SST);
    const s16x8* BBAR = (const s16x8*)(p.ws + WS_BBAR); const s16x8* CMAT = (const s16x8*)(p.ws + WS_CMAT);
    constexpr int NITEMS = (MODE == 0 ? 32 : 64) * 128;
#pragma unroll 1
    for (int it = gw; it < NITEMS; it += NGW) {
        const int g = it & 127, ci = it >> 7;
        const bool samp = (MODE == 0) || ci >= 32; const int sc = (MODE == 0) ? ci : ci - 32;
        const int t0 = samp ? MP + sc * 256 : ci * 256;
        const int pidx = (half * 128 + g) * 64;
        const f32x2 alo = ABAR[pidx + nn], ahi = ABAR[pidx + nn + 32];
        s16x8 bfw[4], bbw[4], cfw[4], cbw[4];
#pragma unroll
        for (int q = 0; q < 4; ++q) { bfw[q] = BBAR[((size_t)(0 * 128 + g) * 4 + q) * 64 + lane]; bbw[q] = BBAR[((size_t)(1 * 128 + g) * 4 + q) * 64 + lane]; }
        if (MODE == 1) {
#pragma unroll
            for (int q = 0; q < 4; ++q) { cfw[q] = CMAT[((size_t)(0 * 128 + g) * 4 + q) * 64 + lane]; cbw[q] = CMAT[((size_t)(1 * 128 + g) * 4 + q) * 64 + lane]; }
        }
        f32x2 hlo = {0.f, 0.f}, hhi = {0.f, 0.f};
        if (MODE == 1 && samp) {
            const int bq = sc >> 4, cq2 = sc & 15; const f32x2* A256 = (const f32x2*)(p.ws + WS_A256);
            const f32x2 qlo = A256[pidx + nn], qhi = A256[pidx + nn + 32];
            const float* st = p.state_ssm + ((size_t)(bq * 2 + half) * 128 + g) * 128;
            hlo = (f32x2){st[2 * nn], st[2 * nn + 1]}; hhi = (f32x2){st[2 * nn + 64], st[2 * nn + 65]};
            const int nst = half ? 15 - cq2 : cq2;
            f32x2 s0[15], s1[15];
#pragma unroll
            for (int k = 0; k < 15; ++k) { const int j = half ? 15 - k : k; const size_t o = ((size_t)((bq * 16 + j) * 2 + half) * 128 + g) * 64; s0[k] = SST[o + nn]; s1[k] = SST[o + nn + 32]; }
#pragma unroll
            for (int k = 0; k < 15; ++k) {
                const f32x2 nl = {qlo.x * hlo.x - qlo.y * hlo.y + s0[k].x, qlo.x * hlo.y + qlo.y * hlo.x + s0[k].y};
                const f32x2 nh = {qhi.x * hhi.x - qhi.y * hhi.y + s1[k].x, qhi.x * hhi.y + qhi.y * hhi.x + s1[k].y};
                hlo = (k < nst) ? nl : hlo; hhi = (k < nst) ? nh : hhi;
            }
        }
        const int r = lane & 31, hh = (r >> 2) & 1, si = 4 * (r >> 3) + (r & 3);
        const bf16_t* ug = U + ((size_t)(t0 >> 8) * 128 + g) * 4096;
        const bf16_t* ua = ug + (hh ? 255 - si : si) * 16 + 8 * (lane >> 5);
        const long ustep = hh ? -256L : 256L;
        const f32x4 dd4 = *(const f32x4*)(p.ssm_d + 16 * g + 4 * cq);
        const s16x8 z8 = {0, 0, 0, 0, 0, 0, 0, 0};
        s16x8 un = *(const s16x8*)(ua + ustep);
        u32x2 uf4n = {0u, 0u}, ub4n = {0u, 0u};
        f32x16 acc[4];
        { const s16x8 u0 = *(const s16x8*)ua; const s16x8 uf = hh ? z8 : u0, ub = hh ? u0 : z8;
#pragma unroll
          for (int q = 0; q < 4; ++q) { acc[q] = __builtin_amdgcn_mfma_f32_32x32x16_bf16(uf, bfw[q], (f32x16){0.f}, 0, 0, 0); acc[q] = __builtin_amdgcn_mfma_f32_32x32x16_bf16(ub, bbw[q], acc[q], 0, 0, 0); } }
#define SSM_NP_TILE(FIN_) do { \
            const s16x8 uc = un; const u32x2 uf4 = uf4n, ub4 = ub4n; \
            un = *(const s16x8*)(ua + (long)(tau + 2 < 16 ? tau + 2 : 15) * ustep); \
            if (MODE == 1) { const int tn_ = FIN_ ? (tau + 1 < 16 ? tau + 1 : 15) : 8; \
                uf4n = *(const u32x2*)(ug + (16 * tn_ + ti) * 16 + 4 * cq); \
                ub4n = *(const u32x2*)(ug + (255 - 16 * tn_ - ti) * 16 + 4 * cq); } \
_Pragma("unroll") \
            for (int i = 0; i < 16; ++i) { \
                float lr = __builtin_fmaf(alo.x, hlo.x, __builtin_fmaf(-alo.y, hlo.y, acc[0][i])); asm volatile("" : "+v"(lr)); \
                float li = __builtin_fmaf(alo.x, hlo.y, __builtin_fmaf(alo.y, hlo.x, acc[2][i])); asm volatile("" : "+v"(li)); \
                float hr = __builtin_fmaf(ahi.x, hhi.x, __builtin_fmaf(-ahi.y, hhi.y, acc[1][i])); asm volatile("" : "+v"(hr)); \
                float hi2 = __builtin_fmaf(ahi.x, hhi.y, __builtin_fmaf(ahi.y, hhi.x, acc[3][i])); asm volatile("" : "+v"(hi2)); \
                hlo = (f32x2){lr, li}; hhi = (f32x2){hr, hi2}; \
                if (MODE == 1) { u32x2 w; w.x = pk2(lr, li); w.y = pk2(hr, hi2); *(LAS u32x2*)(img + half * SSM_IMG + i * SSM_IMG_ROW + nn * 8) = w; } \
            } \
            if (!FIN_ || tau < 15) { \
                const s16x8 uf = hh ? z8 : uc, ub = hh ? uc : z8; \
_Pragma("unroll") \
                for (int q = 0; q < 4; ++q) { acc[q] = __builtin_amdgcn_mfma_f32_32x32x16_bf16(uf, bfw[q], (f32x16){0.f}, 0, 0, 0); acc[q] = __builtin_amdgcn_mfma_f32_32x32x16_bf16(ub, bbw[q], acc[q], 0, 0, 0); } \
            } \
            if (MODE == 1) { \
                asm volatile("" ::: "memory"); \
                f32x4 y0 = {0.f, 0.f, 0.f, 0.f}, y1 = {0.f, 0.f, 0.f, 0.f}; \
_Pragma("unroll") \
                for (int s = 0; s < 4; ++s) { \
                    const s16x8 b0 = *(const LAS s16x8*)(img + ti * SSM_IMG_ROW + 64 * s + 16 * cq), b1 = *(const LAS s16x8*)(img + SSM_IMG + ti * SSM_IMG_ROW + 64 * s + 16 * cq); \
                    y0 = __builtin_amdgcn_mfma_f32_16x16x32_bf16(cfw[s], b0, y0, 0, 0, 0); y1 = __builtin_amdgcn_mfma_f32_16x16x32_bf16(cbw[s], b1, y1, 0, 0, 0); \
                } \
                asm volatile("s_nop 15\n\ts_nop 7" : "+v"(y0), "+v"(y1) :: "memory"); \
                LAS unsigned char* af = ybuf + tau * 512 + ti * 32 + 8 * cq; LAS unsigned char* ab = ybuf + (15 - tau) * 512 + (15 - ti) * 32 + 8 * cq; \
                if (!FIN_) { \
                    u32x2 w; w.x = pk2(y0[0], y0[1]); w.y = pk2(y0[2], y0[3]); *(LAS u32x2*)af = w; \
                    w.x = pk2(y1[0], y1[1]); w.y = pk2(y1[2], y1[3]); *(LAS u32x2*)ab = w; \
                } else { \
                    const u32x2 sf = *(const LAS u32x2*)af, sb = *(const LAS u32x2*)ab; \
                    const size_t tokf = (size_t)(t0 + 16 * tau + ti), tokb = (size_t)(t0 + 255 - 16 * tau - ti); \
                    f32x4 tf = y0 + (f32x4){__uint_as_float(sf.x << 16), __uint_as_float(sf.x & 0xffff0000u), __uint_as_float(sf.y << 16), __uint_as_float(sf.y & 0xffff0000u)}; \
                    f32x4 tb = y1 + (f32x4){__uint_as_float(sb.x << 16), __uint_as_float(sb.x & 0xffff0000u), __uint_as_float(sb.y << 16), __uint_as_float(sb.y & 0xffff0000u)}; \
                    tf = tf + dd4 * (f32x4){__uint_as_float(uf4.x << 16), __uint_as_float(uf4.x & 0xffff0000u), __uint_as_float(uf4.y << 16), __uint_as_float(uf4.y & 0xffff0000u)}; \
                    tb = tb + dd4 * (f32x4){__uint_as_float(ub4.x << 16), __uint_as_float(ub4.x & 0xffff0000u), __uint_as_float(ub4.y << 16), __uint_as_float(ub4.y & 0xffff0000u)}; \
                    u32x2 w; w.x = pk2(gelu_fast(tf[0]), gelu_fast(tf[1])); w.y = pk2(gelu_fast(tf[2]), gelu_fast(tf[3])); *(u32x2*)(Z + tokf * D + 16 * g + 4 * cq) = w; \
                    w.x = pk2(gelu_fast(tb[0]), gelu_fast(tb[1])); w.y = pk2(gelu_fast(tb[2]), gelu_fast(tb[3])); *(u32x2*)(Z + tokb * D + 16 * g + 4 * cq) = w; \
                } \
                asm volatile("" ::: "memory"); \
            } \
        } while (0)
#pragma unroll 1
        for (int tau = 0; tau < 8; ++tau) SSM_NP_TILE(false);
#pragma unroll 1
        for (int tau = 8; tau < 16; ++tau) SSM_NP_TILE(true);
#undef SSM_NP_TILE
        if (MODE == 0) { f32x2* o = (f32x2*)(p.ws + WS_SST) + ((size_t)(sc * 2 + half) * 128 + g) * 64; o[nn] = hlo; o[nn + 32] = hhi; }
        else if (!samp) { f32x2* o = (f32x2*)(p.out + OUT_ST) + ((size_t)(ci * 2 + half) * 128 + g) * 64; o[nn] = hlo; o[nn + 32] = hhi; }
    }
}

#ifndef UP_WGM
#define UP_WGM 4
#endif
enum Phase { PH_PRO = 0, PH_XN0, PH_QKV, PH_ATTN, PH_COMBINE, PH_AO, PH_ROW1_0, PH_UP0, PH_DOWN0, PH_ROW2_0, PH_SSMIN, PH_SSMA, PH_SSM, PH_GLU, PH_SO, PH_ROW1_1, PH_UP1, PH_DOWN1, PH_ROW3, PH_N };
__global__ void __launch_bounds__(NWAVES * 64, 2) mk_fwd(Params p_, int ph_lo, int ph_hi, int li) {
    const CP& p = *(const CP*)__builtin_amdgcn_kernarg_segment_ptr();
    extern __shared__ __attribute__((aligned(16))) unsigned char lds[];
    LAS unsigned char* L = (LAS unsigned char*)lds;
    volatile LAS unsigned* MISC = (volatile LAS unsigned*)(L + MISC_OFF);
    const int tid = threadIdx.x, lane = tid & 63, wave = __builtin_amdgcn_readfirstlane(tid >> 6);
    for (int u = tid; u < (LDS_BYTES - LDSCTL_OFF) / 4; u += NWAVES * 64) ((LAS unsigned*)(L + LDSCTL_OFF))[u] = 0u;
    __syncthreads();
    XcdBarrier bar = xcd_barrier_post((unsigned*)(p.ws + WS_CTL) + CW_BAR + li * XCD_BAR_WORDS, MISC + 8);
    unsigned char* ws = p.ws; unsigned char* wb = ws + WS_W;
    bf16_t* A1 = (bf16_t*)(ws + WS_A1); bf16_t* A2 = (bf16_t*)(ws + WS_A2); bf16_t* BIG = (bf16_t*)(ws + WS_BIG);
#define IN(k) (ph_lo <= (k) && (k) < ph_hi)
#define SEAM(k) do { if (IN(k) && IN((k) + 1)) xcd_barrier(bar); } while (0)
    if (IN(PH_PRO)) { ph_prologue(p, L, lane, wave); } SEAM(PH_PRO);
    if (IN(PH_XN0)) { ph_rowop<0>(p, L, tid, lane, wave, 0, nullptr, A1); } SEAM(PH_XN0);
    if (IN(PH_QKV)) { ph_gemm_qkv(p, L, A1, (const bf16_t*)(wb + WO_QKV), lane, wave); } SEAM(PH_QKV);
    if (IN(PH_ATTN)) { ph_attn(p, lds, A1); }
    SEAM(PH_ATTN);
    if (IN(PH_COMBINE)) { ph_combine(p, lane, wave, A1); } SEAM(PH_COMBINE);
    if (IN(PH_AO)) { ph_gemm<0>(L, A1, (const bf16_t*)(wb + WO_AO), D, D, A2, nullptr); } SEAM(PH_AO);
    if (IN(PH_ROW1_0)) { ph_rowop<1>(p, L, tid, lane, wave, 0, A2, A1); } SEAM(PH_ROW1_0);
    if (IN(PH_UP0)) { ph_gemm<1>(L, A1, (const bf16_t*)(wb + WO_W1), DFF, D, BIG, nullptr, UP_WGM); } SEAM(PH_UP0);
    if (IN(PH_DOWN0)) { ph_gemm<0>(L, BIG, (const bf16_t*)(wb + WO_W2), D, DFF, A2, nullptr); } SEAM(PH_DOWN0);
    if (IN(PH_ROW2_0)) { ph_rowop<2>(p, L, tid, lane, wave, 0, A2, A1); } SEAM(PH_ROW2_0);
    if (IN(PH_SSMIN)) { ph_gemm<3>(L, A1, (const bf16_t*)(wb + WO_SI), D, D, A2, nullptr); } SEAM(PH_SSMIN);
    if (IN(PH_SSMA)) { ph_ssm_state4(p, lane, wave, A2); } SEAM(PH_SSMA);
    if (IN(PH_SSM)) { ph_ssm_scan_np<1, 1>(p, L, lane, wave, A2, A1); }
    SEAM(PH_SSM);
    if (IN(PH_GLU)) { ph_gemm<2>(L, A1, (const bf16_t*)(wb + WO_GL), D, D, A2, A1); } SEAM(PH_GLU);
    if (IN(PH_SO)) { ph_gemm<0>(L, A2, (const bf16_t*)(wb + WO_SO), D, D, A1, nullptr); } SEAM(PH_SO);
    if (IN(PH_ROW1_1)) { ph_rowop<1>(p, L, tid, lane, wave, 1, A1, A2); } SEAM(PH_ROW1_1);
    if (IN(PH_UP1)) { ph_gemm<1>(L, A2, (const bf16_t*)(wb + WO_W1 + 32 * MiB), DFF, D, BIG, nullptr, UP_WGM); } SEAM(PH_UP1);
    if (IN(PH_DOWN1)) { ph_gemm<0>(L, BIG, (const bf16_t*)(wb + WO_W2 + 32 * MiB), D, DFF, A1, nullptr); } SEAM(PH_DOWN1);
    if (IN(PH_ROW3)) { ph_rowop<3>(p, L, tid, lane, wave, 1, A1, nullptr); }
#undef IN
#undef SEAM
}

extern "C" void kernel_launch(void* const* d_in, const int* in_sizes, int n_in, void* d_out, int out_size, void* d_ws, size_t ws_size, hipStream_t stream) {
    static int grid = 0;
    if (grid == 0) {
        if (n_in != 30 || out_size != (int)OUT_END || ws_size < WS_END) { fprintf(stderr, "kernel_launch: unexpected shapes: n_in %d out %d ws %zu (need %zu)\n", n_in, out_size, ws_size, (size_t)WS_END); grid = -1; return; }
        int dev = 0, cus = 0;
        if (hipGetDevice(&dev) != hipSuccess || hipDeviceGetAttribute(&cus, hipDeviceAttributeMultiprocessorCount, dev) != hipSuccess) { grid = -1; return; }
        if (hipFuncSetAttribute((const void*)mk_fwd, hipFuncAttributeMaxDynamicSharedMemorySize, LDS_BYTES) != hipSuccess) { fprintf(stderr, "kernel_launch: hipFuncSetAttribute failed\n"); grid = -1; return; }
        int per_cu = 0;
        if (hipOccupancyMaxActiveBlocksPerMultiprocessor(&per_cu, (const void*)mk_fwd, NWAVES * 64, LDS_BYTES) != hipSuccess || per_cu < 1) fprintf(stderr, "kernel_launch: occupancy query reports %d\n", per_cu);
        (void)hipGetLastError();
        grid = cus;
    }
    if (grid < 0) return;
    Params p{};
    const float** pp = (const float**)&p;
    for (int i = 0; i < 30; ++i) pp[i] = (const float*)d_in[i];
    p.out = (float*)d_out; p.ws = (unsigned char*)d_ws;
    unsigned char* ws = p.ws;
    bf16_t* A1 = (bf16_t*)(ws + WS_A1); bf16_t* A2 = (bf16_t*)(ws + WS_A2); bf16_t* BIG = (bf16_t*)(ws + WS_BIG);
    (void)hipMemsetAsync(ws + WS_CTL, 0, 1 * MiB, stream);
    int li = 0;
#if ONE_PER_PHASE
    for (int ph = PH_PRO; ph < PH_N; ++ph) hipLaunchKernelGGL(mk_fwd, dim3(grid), dim3(NWAVES * 64), LDS_BYTES, stream, p, ph, ph + 1, li++);
#else
    hipLaunchKernelGGL(mk_fwd, dim3(grid), dim3(NWAVES * 64), LDS_BYTES, stream, p, (int)PH_PRO, (int)PH_N, li++);
#endif
    const hipError_t le = hipPeekAtLastError();
    if (le != hipSuccess) fprintf(stderr, "kernel_launch: launch failed: %s\n", hipGetErrorName(le));
}
```

```cpp
#include <hip/hip_runtime.h>
#include <hip/hip_bf16.h>
#include <cstdio>
#include <cstdint>

typedef unsigned short bf16_t;
typedef float f32x4 __attribute__((ext_vector_type(4)));
typedef float f32x2 __attribute__((ext_vector_type(2)));
typedef unsigned u32x4 __attribute__((ext_vector_type(4)));
typedef unsigned u32x2 __attribute__((ext_vector_type(2)));

constexpr int D = 2048, MP = 8192, MS = 8192, M = MP + MS, NQKV = 4608, DFF = 8192;
constexpr int LQ = 4096, LKV = 4352, NMOD = 12288;
constexpr int KB_ROWS = MP + 2 * LKV;
constexpr int KVW = 1280;
constexpr int OW = 3072;
constexpr float EPS = 1e-6f;
constexpr int KCH = 16;

constexpr size_t OUT_Y = 0, OUT_AK = 33554432, OUT_AV = 35651584, OUT_BK = 37748736, OUT_BV = 46137344, OUT_ST = 54525952, OUT_END = 55574528;

constexpr size_t MiB = 1u << 20;
constexpr size_t WS_CTL = 0, WS_MODP = 1 * MiB, WS_MOD = 6 * MiB, WS_ABAR = 7 * MiB, WS_A256 = 7 * MiB + 512 * 1024, WS_BBAR = 8 * MiB, WS_CMAT = 9 * MiB,
                 WS_ROPE = 10 * MiB, WS_SST = 12 * MiB, WS_HIN = 16 * MiB, WS_W = 20 * MiB, WS_A1 = 200 * MiB, WS_A2 = 264 * MiB, WS_BIG = 328 * MiB,
                 WS_QH = 584 * MiB, WS_KB = 648 * MiB, WS_VB = 690 * MiB, WS_END = 732 * MiB;
constexpr size_t WS_BB4 = 16 * MiB, WS_A4 = 7 * MiB + 768 * 1024;
constexpr size_t WS_O = WS_BIG + 144 * MiB;

struct Params {
    const float *x_prompt, *x_sample, *c, *cache_a_k, *cache_a_v, *cache_b_k, *cache_b_v, *state_ssm, *c_ctx, *ada_w, *ada_b, *norm_g, *mlp_w1, *mlp_w2,
        *attn_w_in, *attn_w_out, *qk_norm, *diff_lambda, *diff_subln, *ssm_w_in, *ssm_a_re, *ssm_a_im, *ssm_log_dt, *ssm_b_re, *ssm_b_im, *ssm_c_re, *ssm_c_im,
        *ssm_d, *ssm_glu_w, *ssm_w_out;
    float* out; unsigned char* ws;
};

__device__ __forceinline__ float bf2f(bf16_t v) { return __uint_as_float((unsigned)v << 16); }
__device__ __forceinline__ unsigned f2bf(float f) { unsigned u = __float_as_uint(f); return (u + 0x7fffu + ((u >> 16) & 1u)) >> 16; }
__device__ __forceinline__ unsigned pk2(float lo, float hi) { unsigned r; asm("v_cvt_pk_bf16_f32 %0, %1, %2" : "=v"(r) : "v"(lo), "v"(hi)); return r; }
__device__ __forceinline__ float wave_sum(float v) {
#pragma unroll
    for (int o = 1; o < 64; o <<= 1) v += __shfl_xor(v, o);
    return v;
}
__device__ __forceinline__ int row_class(int m) { return m < MP ? 0 : 1 + ((m - MP) >> 12); }
template <class P> __device__ __forceinline__ const float* x_row(const P& p, int m) { return m < MP ? p.x_prompt + (size_t)m * D : p.x_sample + (size_t)(m - MP) * D; }

typedef const __attribute__((address_space(4))) Params CP;

namespace pg8 {
#define PG8_LAS __attribute__((address_space(3)))
typedef unsigned short bf16_t;
typedef short bf16x8 __attribute__((ext_vector_type(8)));
typedef float f32x4 __attribute__((ext_vector_type(4)));
typedef unsigned u32x4 __attribute__((ext_vector_type(4)));
constexpr int BM = 256, BK = 64, HALF = 128, HTB = HALF * BK * 2  , STAGE_BYTES = 8 * HTB, NXCD = 8, WGM = 4;

__host__ __device__ __forceinline__ int lds_byte(int r, int c) { const int st = (r >> 4) * 2 + (c >> 5), rr = r & 15, cc = c & 31, ob = rr * 64 + cc * 2; return st * 1024 + (ob ^ (((ob >> 9) & 1) << 5)); }
__host__ __device__ __forceinline__ void stage_rc(int b, int& R, int& C) { const int st = b / 1024, sb = b % 1024, swz = sb ^ (((sb >> 9) & 1) << 5); R = (st >> 1) * 16 + swz / 64; C = (st & 1) * 32 + (swz % 64) / 2; }
__host__ __device__ __forceinline__ int perm32(int rho) { const int n = rho >> 4, i = rho & 15; return 8 * (i >> 2) + 4 * n + (i & 3); }

struct Unit { int pm, pn; };
struct Gemm { const bf16_t* A; const bf16_t* Bt; int M, N, K; };

struct StaticOrder {
    int nM, nN, nwg, G, c, wgm;
    __host__ __device__ void init(int M, int N, int G_, int c_, int wgm_ = WGM) { nM = M / BM; nN = N / BM; nwg = nM * nN; G = G_; c = c_; wgm = wgm_; }
    __host__ __device__ bool next(int i, Unit& u) const {
        const long L = (long)i * G + c; if (L >= nwg) return false;
        int wgid = (int)L; { const int q = nwg / NXCD, r = nwg % NXCD, xcd = wgid % NXCD, off = wgid / NXCD; wgid = (xcd < r ? xcd * (q + 1) : r * (q + 1) + (xcd - r) * q) + off; }
        const int nig = wgm * nN, gid = wgid / nig, fm = gid * wgm, gsz = (nM - fm) < wgm ? (nM - fm) : wgm;
        u.pm = fm + ((wgid % nig) % gsz); u.pn = (wgid % nig) / gsz; return true;
    }
    __device__ __forceinline__ void a_ready(const Unit&) const {}
    __device__ __forceinline__ void done(const Unit&) const {}
};

__device__ __forceinline__ unsigned cvt_pk_bf16(float lo, float hi) { unsigned r; asm volatile("v_cvt_pk_bf16_f32 %0, %1, %2" : "=v"(r) : "v"(lo), "v"(hi)); return r; }
typedef float f32x2 __attribute__((ext_vector_type(2)));
template <class Epi, class Sched, bool ALIGN_EPI = false, bool SP2 = false>
__device__ __forceinline__ void gemm_phase(PG8_LAS unsigned char* lds, const Gemm g, const Sched& S, const Epi& E) {
    const int tid = threadIdx.x, wid = __builtin_amdgcn_readfirstlane(tid >> 6), lane = tid & 63, wr = wid >> 2, wc = wid & 3, fr = lane & 15, fq = lane >> 4;
    const int K = g.K, nt = K / BK;
    unsigned voffA[2], voffB[2];
#pragma unroll
    for (int i = 0; i < 2; ++i) { int R, C; stage_rc(tid * 16 + i * 8192, R, C); const int Rb = Epi::PERM ? ((R & ~31) + perm32(R & 31)) : R;
        voffA[i] = Epi::ASCAN ? (unsigned)(((C >> 4) * 256 + R) * 16 + (C & 15)) * 2u : (unsigned)(R * K + C) * 2u; voffB[i] = (unsigned)(Rb * K + C) * 2u; }
    const size_t kstep = (size_t)(BK * 2);
    const size_t hstep = (size_t)HALF * K * 2;
    const size_t tstep = 2 * hstep;
    const size_t kstepA = Epi::ASCAN ? (size_t)32768 : kstep, hstepA = Epi::ASCAN ? (size_t)4096 : hstep;
    const unsigned ldsw = (unsigned)wid * 1024u;
    const int aoff = lds_byte(wr * 64 + fr, fq * 8), boff = lds_byte(wc * 32 + fr, fq * 8);
#define PG8_SA(b, h) (((b) * 2 + (h)) * HTB)
#define PG8_SB(b, h) ((4 + (b) * 2 + (h)) * HTB)
#define PG8_STAGE(bufoff, gbase, voff) do { _Pragma("unroll") for (int _i = 0; _i < 2; ++_i) \
        __builtin_amdgcn_global_load_lds((const unsigned*)((const char*)(gbase) + (voff)[_i]), (PG8_LAS unsigned*)(lds + (bufoff) + ldsw + _i * 8192), 16, 0, 0); } while (0)
#define PG8_LDA(dst, b, h) do { _Pragma("unroll") for (int m = 0; m < 4; ++m) _Pragma("unroll") for (int k = 0; k < 2; ++k) dst[m][k] = *(const PG8_LAS bf16x8*)(lds + PG8_SA(b, h) + aoff + m * 2048 + k * 1024); } while (0)
#define PG8_LDB(dst, b, h) do { _Pragma("unroll") for (int n = 0; n < 2; ++n) _Pragma("unroll") for (int k = 0; k < 2; ++k) dst[n][k] = *(const PG8_LAS bf16x8*)(lds + PG8_SB(b, h) + boff + n * 2048 + k * 1024); } while (0)
#define PG8_MMA(ai, bj, At, Bt) do { __builtin_amdgcn_s_setprio(1); _Pragma("unroll") for (int m = 0; m < 4; ++m) _Pragma("unroll") for (int n = 0; n < 2; ++n) _Pragma("unroll") for (int k = 0; k < 2; ++k) \
        acc[ai][bj][m][n] = __builtin_amdgcn_mfma_f32_16x16x32_bf16(Bt[n][k], At[m][k], acc[ai][bj][m][n], 0, 0, 0); __builtin_amdgcn_s_setprio(0); } while (0)
#define PG8_WAIT_V(n) asm volatile("s_waitcnt vmcnt(" #n ")" ::: "memory")
#define PG8_WAIT_L(n) asm volatile("s_waitcnt lgkmcnt(" #n ")" ::: "memory")
#define PG8_BAR __builtin_amdgcn_s_barrier()
#define PG8_SCHED __builtin_amdgcn_sched_barrier(0)
    Unit cur, nxt; int ui = 0;
    if (!S.next(0, cur)) return;
    f32x4 acc[2][2][4][2];
#pragma unroll
    for (int a = 0; a < 2; ++a)
#pragma unroll
        for (int b = 0; b < 2; ++b)
#pragma unroll
            for (int m = 0; m < 4; ++m)
#pragma unroll
                for (int n = 0; n < 2; ++n) acc[a][b][m][n] = (f32x4){0.f, 0.f, 0.f, 0.f};
    bf16x8 At[4][2], B0[2][2], B1[2][2];
    const char* cA = (const char*)g.A + (size_t)cur.pm * tstep; const char* cB = (const char*)g.Bt + (size_t)cur.pn * tstep;
    S.a_ready(cur);
    if constexpr (SP2) {
        PG8_STAGE(PG8_SB(0, 0), cB, voffB); PG8_STAGE(PG8_SB(0, 1), cB + hstep, voffB); PG8_STAGE(PG8_SA(0, 0), cA, voffA); PG8_STAGE(PG8_SA(0, 1), cA + hstepA, voffA);
        if (wr == 1) PG8_BAR;
        PG8_WAIT_V(2); PG8_BAR;
        PG8_STAGE(PG8_SB(1, 0), cB + kstep, voffB); PG8_STAGE(PG8_SA(1, 0), cA + kstepA, voffA); PG8_STAGE(PG8_SB(1, 1), cB + hstep + kstep, voffB);
        PG8_WAIT_V(6); PG8_BAR;
    } else {
        PG8_STAGE(PG8_SB(0, 0), cB, voffB); PG8_STAGE(PG8_SA(0, 0), cA, voffA); PG8_STAGE(PG8_SB(0, 1), cB + hstep, voffB); PG8_STAGE(PG8_SA(0, 1), cA + hstepA, voffA);
        if (wr == 1) PG8_BAR;
        PG8_WAIT_V(4); PG8_BAR;
        PG8_STAGE(PG8_SB(1, 0), cB + kstep, voffB); PG8_STAGE(PG8_SA(1, 0), cA + kstepA, voffA); PG8_STAGE(PG8_SB(1, 1), cB + hstep + kstep, voffB);
        PG8_WAIT_V(6); PG8_BAR;
    }
    for (;;) {
        const bool has_next = S.next(ui + 1, nxt);
        const char* nA = has_next ? (const char*)g.A + (size_t)nxt.pm * tstep : cA; const char* nB = has_next ? (const char*)g.Bt + (size_t)nxt.pn * tstep : cB;
        for (int t = 0; t < nt; t += 2) {
            const bool last = (t == nt - 2);
            const char* a1 = cA + (size_t)(t + 1) * kstepA;
            const char* a2 = last ? nA : cA + (size_t)(t + 2) * kstepA; const char* b2 = last ? nB : cB + (size_t)(t + 2) * kstep;
            const char* a3 = a2 + kstepA; const char* b3 = b2 + kstep;
            if (last && has_next) S.a_ready(nxt);
            if constexpr (SP2) {
            PG8_LDB(B0, 0, 0); PG8_LDB(B1, 0, 1); PG8_SCHED; PG8_LDA(At, 0, 0); PG8_STAGE(PG8_SA(1, 1), a1 + hstepA, voffA);
            PG8_WAIT_V(8); PG8_WAIT_L(0); PG8_BAR; PG8_MMA(0, 0, At, B0); PG8_MMA(0, 1, At, B1); PG8_BAR; PG8_SCHED;
            PG8_LDA(At, 0, 1); PG8_STAGE(PG8_SB(0, 0), b2, voffB); PG8_STAGE(PG8_SB(0, 1), b2 + hstep, voffB); PG8_STAGE(PG8_SA(0, 0), a2, voffA);
            PG8_WAIT_V(8); PG8_WAIT_L(0); PG8_BAR; PG8_MMA(1, 0, At, B0); PG8_MMA(1, 1, At, B1); PG8_BAR; PG8_SCHED;
            PG8_LDB(B0, 1, 0); PG8_LDB(B1, 1, 1); PG8_SCHED; PG8_LDA(At, 1, 0); PG8_STAGE(PG8_SA(0, 1), a2 + hstepA, voffA);
            PG8_WAIT_V(8); PG8_WAIT_L(0); PG8_BAR; PG8_MMA(0, 0, At, B0); PG8_MMA(0, 1, At, B1); PG8_BAR; PG8_SCHED;
            PG8_LDA(At, 1, 1); PG8_STAGE(PG8_SB(1, 0), b3, voffB); PG8_STAGE(PG8_SB(1, 1), b3 + hstep, voffB); PG8_STAGE(PG8_SA(1, 0), a3, voffA);
            PG8_WAIT_V(8); PG8_WAIT_L(0); PG8_BAR; PG8_MMA(1, 0, At, B0); PG8_MMA(1, 1, At, B1); PG8_BAR; PG8_SCHED;
            } else {
            PG8_LDB(B0, 0, 0); PG8_SCHED; PG8_LDA(At, 0, 0); PG8_STAGE(PG8_SA(1, 1), a1 + hstepA, voffA);
            PG8_WAIT_L(8); PG8_BAR; PG8_WAIT_L(0); PG8_MMA(0, 0, At, B0); PG8_BAR; PG8_SCHED;
            PG8_LDB(B1, 0, 1); PG8_STAGE(PG8_SB(0, 0), b2, voffB);
            PG8_BAR; PG8_WAIT_L(0); PG8_MMA(0, 1, At, B1); PG8_BAR;
            PG8_LDA(At, 0, 1); PG8_STAGE(PG8_SA(0, 0), a2, voffA);
            PG8_BAR; PG8_WAIT_L(0); PG8_MMA(1, 0, At, B0); PG8_BAR; PG8_SCHED;
            PG8_STAGE(PG8_SB(0, 1), b2 + hstep, voffB);
            PG8_WAIT_V(6); PG8_BAR; PG8_MMA(1, 1, At, B1); PG8_BAR;
            PG8_LDB(B0, 1, 0); PG8_SCHED; PG8_LDA(At, 1, 0); PG8_STAGE(PG8_SA(0, 1), a2 + hstepA, voffA);
            PG8_WAIT_L(8); PG8_BAR; PG8_WAIT_L(0); PG8_MMA(0, 0, At, B0); PG8_BAR; PG8_SCHED;
            PG8_LDB(B1, 1, 1); PG8_STAGE(PG8_SB(1, 0), b3, voffB);
            PG8_BAR; PG8_WAIT_L(0); PG8_MMA(0, 1, At, B1); PG8_BAR;
            PG8_LDA(At, 1, 1); PG8_STAGE(PG8_SA(1, 0), a3, voffA);
            PG8_BAR; PG8_WAIT_L(0); PG8_MMA(1, 0, At, B0); PG8_BAR; PG8_SCHED;
            PG8_STAGE(PG8_SB(1, 1), b3 + hstep, voffB);
            PG8_WAIT_V(6); PG8_BAR; PG8_MMA(1, 1, At, B1); PG8_BAR;
            }
        }
        if constexpr (ALIGN_EPI) { if (wr == 0) PG8_BAR; }
        if constexpr (!Epi::AFTER_DRAIN) { E(acc, cur, wr, wc, fr, fq); S.done(cur); }
        if (!has_next) break;
#pragma unroll
        for (int a = 0; a < 2; ++a)
#pragma unroll
            for (int b = 0; b < 2; ++b)
#pragma unroll
                for (int m = 0; m < 4; ++m)
#pragma unroll
                    for (int n = 0; n < 2; ++n) acc[a][b][m][n] = (f32x4){0.f, 0.f, 0.f, 0.f};
        cur = nxt; cA = nA; cB = nB; ++ui;
        if constexpr (ALIGN_EPI) { if (wr == 1) PG8_BAR; }
    }
    PG8_WAIT_V(0);
    if constexpr (!ALIGN_EPI) { if (wr == 0) PG8_BAR; }
    PG8_BAR;
    if constexpr (Epi::AFTER_DRAIN) { E.fused(acc, cur, wr, wc, fr, fq, lds, wid, lane); S.done(cur); }
#undef PG8_SA
#undef PG8_SB
#undef PG8_STAGE
#undef PG8_LDA
#undef PG8_LDB
#undef PG8_MMA
#undef PG8_WAIT_V
#undef PG8_WAIT_L
#undef PG8_BAR
#undef PG8_SCHED
}
}
namespace att {
using bf16 = __hip_bfloat16;
constexpr int D = 128, NW = 8, QBLK = 32, KVBLK = 64; constexpr float SCALE = 0.088388347648318440f; constexpr float THR = 8.f; constexpr int SDEPTH = 2;
constexpr int LDQ = 2048, LDK = 1280, LDO = 3072;
constexpr size_t SHM_V = KVBLK * D * 2, SHM_K = KVBLK * D * 2, SHM_ATTN = 2 * SHM_V + 2 * SHM_K + NW * 64 * 4;
using bf16x8 = __attribute__((ext_vector_type(8))) short;
using s16x4  = __attribute__((ext_vector_type(4))) short;
using f32x16 = __attribute__((ext_vector_type(16))) float;
using f32x8  = __attribute__((ext_vector_type(8))) float;
using u32x4  = __attribute__((ext_vector_type(4))) unsigned;
#define KSWZ(row, colB) ((row) * 256 + ((colB) ^ (((row) & 7) << 4)))
#define SBAR() __builtin_amdgcn_sched_barrier(0)
__device__ __forceinline__ int crow(int r, int hi) { return (r & 3) + 8 * (r >> 2) + 4 * hi; }
__device__ __forceinline__ unsigned cvtpk(float lo, float hi) {
  unsigned r; asm volatile("v_cvt_pk_bf16_f32 %0, %1, %2" : "=v"(r) : "v"(lo), "v"(hi)); return r;
}
template <typename TIn> struct Stage;
template <> struct Stage<bf16>  { using T = bf16x8;
  __device__ static __forceinline__ T ld8(const bf16* p) { return *reinterpret_cast<const bf16x8*>(p); }
  __device__ static __forceinline__ bf16x8 tobf(T x) { return x; } };
template <> struct Stage<float> { using T = f32x8;
  __device__ static __forceinline__ T ld8(const float* p) { return *reinterpret_cast<const f32x8*>(p); }
  __device__ static __forceinline__ bf16x8 tobf(T x) {
    u32x4 w = {cvtpk(x[0], x[1]), cvtpk(x[2], x[3]), cvtpk(x[4], x[5]), cvtpk(x[6], x[7])}; return *reinterpret_cast<bf16x8*>(&w); } };

__device__ __forceinline__ void partialSM(f32x16& p0, f32x16& p1, float& m_reg, float& mn, float& alpha) {
  constexpr float C = SCALE * 1.4426950408889634f;
  float pmax = p0[0]; for (int r = 1; r < 16; ++r) pmax = fmaxf(pmax, p0[r]); for (int r = 0; r < 16; ++r) pmax = fmaxf(pmax, p1[r]);
  { auto rr = __builtin_amdgcn_permlane32_swap(__float_as_uint(pmax), __float_as_uint(pmax), false, false);
    pmax = fmaxf(__uint_as_float(rr[0]), __uint_as_float(rr[1])); }
  if (__builtin_expect(__all(pmax - m_reg <= THR / SCALE), 1)) { mn = m_reg; alpha = 1.f; }
  else { mn = fmaxf(m_reg, pmax); alpha = __builtin_amdgcn_exp2f((m_reg - mn) * C); m_reg = mn; }
  float mnC = -mn * C;
  for (int r = 0; r < 16; ++r) p0[r] = fmaf(p0[r], C, mnC); for (int r = 0; r < 16; ++r) p1[r] = fmaf(p1[r], C, mnC);
  for (int r = 0; r < 16; ++r) p0[r] = __builtin_amdgcn_exp2f(p0[r]);
}
__device__ __forceinline__ void finishSM(f32x16& p0, f32x16& p1, float alpha, float& l_reg, bf16x8& pa0, bf16x8& pa1, bf16x8& pa2, bf16x8& pa3) {
  for (int r = 0; r < 16; ++r) p1[r] = __builtin_amdgcn_exp2f(p1[r]);
  float ps = 0; for (int r = 0; r < 16; ++r) ps += p0[r]; for (int r = 0; r < 16; ++r) ps += p1[r];
  { auto rr = __builtin_amdgcn_permlane32_swap(__float_as_uint(ps), __float_as_uint(ps), false, false);
    ps = __uint_as_float(rr[0]) + __uint_as_float(rr[1]); }
  l_reg = l_reg * alpha + ps;
#define PK4(P, BASE, OUT) do { unsigned a0 = cvtpk(P[BASE + 0], P[BASE + 1]), a1 = cvtpk(P[BASE + 2], P[BASE + 3]);   \
    unsigned b0 = cvtpk(P[BASE + 4], P[BASE + 5]), b1 = cvtpk(P[BASE + 6], P[BASE + 7]);                              \
    auto r0 = __builtin_amdgcn_permlane32_swap(a0, b0, false, false); auto r1 = __builtin_amdgcn_permlane32_swap(a1, b1, false, false); \
    u32x4 w = {r0[0], r1[0], r0[1], r1[1]}; OUT = *reinterpret_cast<bf16x8*>(&w); } while (0)
  PK4(p0, 0, pa0); PK4(p0, 8, pa1); PK4(p1, 0, pa2); PK4(p1, 8, pa3);
#undef PK4
}
__device__ __forceinline__ void qkt(f32x16& p0, f32x16& p1, const bf16* Ks, const bf16x8* qr, int r32, int hi) {
  p0 = f32x16{}; p1 = f32x16{};
  for (int d0 = 0; d0 < 8; ++d0) { int cb = (d0 * 16 + hi * 8) * 2;
    bf16x8 b0 = *reinterpret_cast<const bf16x8*>((const char*)Ks + KSWZ(r32, cb));
    bf16x8 b1 = *reinterpret_cast<const bf16x8*>((const char*)Ks + KSWZ(32 + r32, cb));
    p0 = __builtin_amdgcn_mfma_f32_32x32x16_bf16(b0, qr[d0], p0, 0, 0, 0);
    p1 = __builtin_amdgcn_mfma_f32_32x32x16_bf16(b1, qr[d0], p1, 0, 0, 0); }
}
__device__ __forceinline__ int v_st(int k, int c) { const int kk = (k & ~0xC) | ((k & 4) << 1) | ((k & 8) >> 1); return ((kk >> 3) * 4 + (c >> 5)) * 512 + ((kk & 7) * 32 + (c & 31)) * 2; }
__device__ __forceinline__ int v_rd_base(int lane) { return ((lane & 3) << 3) | (((lane >> 2) & 3) << 6) | (((lane >> 4) & 1) << 5) | (((lane >> 5) & 1) << 8); }
constexpr int v_rd_off(int d0, int ks, int half) { return d0 * 512 + ks * 4096 + half * 2048; }
template <int OFF> __device__ __forceinline__ s16x4 tr_read(int vb) {
  s16x4 r; asm volatile("ds_read_b64_tr_b16 %0, %1 offset:%2" : "=&v"(r) : "v"(vb), "i"(OFF) : "memory"); return r;
}
template <int D0> __device__ __forceinline__ void pv_one(f32x16& od, int vb, bf16x8 pa0, bf16x8 pa1, bf16x8 pa2, bf16x8 pa3) {
  const s16x4 l0 = tr_read<v_rd_off(D0, 0, 0)>(vb), h0 = tr_read<v_rd_off(D0, 0, 1)>(vb), l1 = tr_read<v_rd_off(D0, 1, 0)>(vb), h1 = tr_read<v_rd_off(D0, 1, 1)>(vb);
  const s16x4 l2 = tr_read<v_rd_off(D0, 2, 0)>(vb), h2 = tr_read<v_rd_off(D0, 2, 1)>(vb), l3 = tr_read<v_rd_off(D0, 3, 0)>(vb), h3 = tr_read<v_rd_off(D0, 3, 1)>(vb);
  asm volatile("s_waitcnt lgkmcnt(0)" ::: "memory"); SBAR();
#define PK(L, H) (bf16x8){L[0], L[1], L[2], L[3], H[0], H[1], H[2], H[3]}
  od = __builtin_amdgcn_mfma_f32_32x32x16_bf16(pa0, PK(l0, h0), od, 0, 0, 0);
  od = __builtin_amdgcn_mfma_f32_32x32x16_bf16(pa1, PK(l1, h1), od, 0, 0, 0);
  od = __builtin_amdgcn_mfma_f32_32x32x16_bf16(pa2, PK(l2, h2), od, 0, 0, 0);
  od = __builtin_amdgcn_mfma_f32_32x32x16_bf16(pa3, PK(l3, h3), od, 0, 0, 0);
#undef PK
}
__device__ __forceinline__ void pv_d0(f32x16* o, int vb, bf16x8 pa0, bf16x8 pa1, bf16x8 pa2, bf16x8 pa3) {
  pv_one<0>(o[0], vb, pa0, pa1, pa2, pa3); pv_one<1>(o[1], vb, pa0, pa1, pa2, pa3); pv_one<2>(o[2], vb, pa0, pa1, pa2, pa3); pv_one<3>(o[3], vb, pa0, pa1, pa2, pa3);
}

template <typename TQ>
__device__ __forceinline__ void attn_dense_body(const TQ* __restrict__ Qb, const bf16* __restrict__ Kh, const bf16* __restrict__ Vh,
                                                unsigned short* __restrict__ Ob, int ldo, int seq, char* lds) {
  using St = Stage<bf16>; using SQ = Stage<TQ>;
  const int tid = threadIdx.x, wid = tid >> 6, lane = tid & 63, r32 = lane & 31, hi = lane >> 5;
  bf16* V_lds = (bf16*)lds; bf16* K_lds = (bf16*)(lds + 2 * SHM_V);
  float* ws = (float*)(lds + 2 * SHM_V + 2 * SHM_K) + wid * 64; float* li_l = ws; float* al_l = ws + 32;
  float m_reg = -1e30f, l_reg = 0; f32x16 o[4] = {}; bf16x8 qr[8];
  const TQ* Qw = Qb + (long)(wid * QBLK + r32) * LDQ + hi * 8;
#pragma unroll
  for (int d0 = 0; d0 < 8; ++d0) qr[d0] = SQ::tobf(SQ::ld8(Qw + d0 * 16));
  const int sr = tid >> 4, sc = (tid & 15) * 8, vst0 = v_st(sr, sc), vst1 = v_st(32 + sr, sc);
  const int vb0 = (int)(uintptr_t)V_lds + v_rd_base(lane);
  struct { typename St::T vs0, vs1, ks0, ks1; } sr_[SDEPTH];
#define SLOAD(i, k0) do { sr_[i].vs0 = St::ld8(&Vh[(long)((k0) + sr) * LDK + sc]); sr_[i].vs1 = St::ld8(&Vh[(long)((k0) + 32 + sr) * LDK + sc]); \
    sr_[i].ks0 = St::ld8(&Kh[(long)((k0) + sr) * LDK + sc]); sr_[i].ks1 = St::ld8(&Kh[(long)((k0) + 32 + sr) * LDK + sc]); } while (0)
#define SWRITE(b, i) do { *(bf16x8*)((char*)V_lds + (b) * SHM_V + vst0) = St::tobf(sr_[i].vs0);          \
    *(bf16x8*)((char*)V_lds + (b) * SHM_V + vst1) = St::tobf(sr_[i].vs1); int kc = sc * 2;               \
    *(bf16x8*)((char*)K_lds + (b) * SHM_K + KSWZ(sr, kc)) = St::tobf(sr_[i].ks0);                       \
    *(bf16x8*)((char*)K_lds + (b) * SHM_K + KSWZ(32 + sr, kc)) = St::tobf(sr_[i].ks1); } while (0)
#define SWAIT() do { if constexpr (SDEPTH == 2) asm volatile("s_waitcnt vmcnt(4)" ::: "memory"); else asm volatile("s_waitcnt vmcnt(0)" ::: "memory"); } while (0)
#define RESC(a) do { if (__any((a) < 1.f)) { if (hi == 0) al_l[r32] = (a); asm volatile("s_waitcnt lgkmcnt(0)" ::: "memory"); \
    for (int d = 0; d < 4; ++d) for (int r = 0; r < 16; ++r) o[d][r] *= al_l[crow(r, hi)]; } } while (0)
  f32x16 pA0, pA1, pB0, pB1; float mnA, mnB, alA, alB; bf16x8 pa0, pa1, pa2, pa3; const int NT = seq / KVBLK;
  constexpr int SE = 0, SO = SDEPTH - 1;
  SLOAD(SE, 0); asm volatile("s_waitcnt vmcnt(0)" ::: "memory"); SWRITE(0, SE); __syncthreads();
  qkt(pA0, pA1, K_lds, qr, r32, hi); partialSM(pA0, pA1, m_reg, mnA, alA);
  SLOAD(SO, KVBLK); if constexpr (SDEPTH == 2) { if (2 < NT) SLOAD(SE, 2 * KVBLK); }
  SWAIT(); SWRITE(1, SO); __syncthreads();
  for (int j = 1; j + 1 < NT; j += 2) {
    SBAR(); qkt(pB0, pB1, (bf16*)((char*)K_lds + SHM_K), qr, r32, hi);
    finishSM(pA0, pA1, alA, l_reg, pa0, pa1, pa2, pa3); SBAR();
    SLOAD(SO, (j + SDEPTH) * KVBLK); SBAR();
    pv_d0(o, vb0, pa0, pa1, pa2, pa3); partialSM(pB0, pB1, m_reg, mnB, alB);
    __syncthreads(); SWAIT(); SWRITE(0, SE);
    RESC(alB); __syncthreads();
    SBAR(); qkt(pA0, pA1, K_lds, qr, r32, hi);
    finishSM(pB0, pB1, alB, l_reg, pa0, pa1, pa2, pa3); SBAR();
    if (SDEPTH == 1 || j + 3 < NT) SLOAD(SE, (j + 1 + SDEPTH) * KVBLK); SBAR();
    pv_d0(o, vb0 + (int)SHM_V, pa0, pa1, pa2, pa3); partialSM(pA0, pA1, m_reg, mnA, alA);
    __syncthreads(); SWAIT(); SWRITE(1, SO);
    RESC(alA); __syncthreads();
  }
  SBAR(); qkt(pB0, pB1, (bf16*)((char*)K_lds + SHM_K), qr, r32, hi);
  finishSM(pA0, pA1, alA, l_reg, pa0, pa1, pa2, pa3); SBAR();
  pv_d0(o, vb0, pa0, pa1, pa2, pa3); partialSM(pB0, pB1, m_reg, mnB, alB);
  __syncthreads(); RESC(alB);
  finishSM(pB0, pB1, alB, l_reg, pa0, pa1, pa2, pa3); SBAR();
  pv_d0(o, vb0 + (int)SHM_V, pa0, pa1, pa2, pa3);
  if (hi == 0) li_l[r32] = l_reg; asm volatile("s_waitcnt lgkmcnt(0)" ::: "memory");
  float rli[16];
#pragma unroll
  for (int r = 0; r < 16; ++r) rli[r] = __builtin_amdgcn_rcpf(li_l[crow(r, hi)]);
  unsigned short* Ow = Ob + (long)(wid * QBLK) * ldo;
#pragma unroll
  for (int r = 0; r < 16; ++r) { int orow = crow(r, hi);
    for (int d0 = 0; d0 < 4; ++d0) Ow[(long)orow * ldo + d0 * 32 + r32] = (unsigned short)f2bf(o[d0][r] * rli[r]); }
#undef SLOAD
#undef SWRITE
#undef SWAIT
#undef RESC
}

template <int NB>
__device__ __forceinline__ void store_o_rows(const f32x16* o, const float* li_l, unsigned short* __restrict__ Ow, int ldo, char* lds, int wid, int lane, int r32, int hi) {
  constexpr int RS = NB * 64, LPR = RS / 16, RPI = 64 / LPR;
  char* st = lds + wid * (32 * RS);
#pragma unroll
  for (int r = 0; r < 16; ++r) { const int orow = crow(r, hi); const float rl = __builtin_amdgcn_rcpf(li_l[orow]);
#pragma unroll
    for (int d0 = 0; d0 < NB; ++d0) { const float v = o[d0][r] * rl; *reinterpret_cast<unsigned short*>(st + orow * RS + (d0 * 32 + r32) * 2) = (unsigned short)cvtpk(v, v); } }
  asm volatile("s_waitcnt lgkmcnt(0)" ::: "memory");
  const int rr = lane / LPR, cb = (lane % LPR) * 16;
#pragma unroll
  for (int i = 0; i < 32 / RPI; ++i) { const int row = i * RPI + rr;
    const u32x4 v = *reinterpret_cast<const u32x4*>(st + row * RS + cb);
    *reinterpret_cast<u32x4*>(reinterpret_cast<char*>(Ow + (long)row * ldo) + cb) = v; }
}
__device__ __forceinline__ void attn_small_body(const bf16* __restrict__ Qb, const bf16* __restrict__ Kh, const bf16* __restrict__ Vh, unsigned short* __restrict__ Ob, int ldo, char* lds) {
  int tid_ = threadIdx.x; asm volatile("" : "+v"(tid_));
  const int tid = tid_, wid = __builtin_amdgcn_readfirstlane(tid >> 6), lane = tid & 63, r32 = lane & 31, hi = lane >> 5;
  char* V_lds = lds; char* K_lds = lds + 4 * SHM_V;
  float* ws = (float*)(lds + 4 * SHM_V + 4 * SHM_K) + wid * 64; float* li_l = ws; float* al_l = ws + 32;
  const int sr = tid >> 4, sc = (tid & 15) * 8, vst0 = v_st(sr, sc), vst1 = v_st(32 + sr, sc);
  bf16x8 kv[4][4];
#pragma unroll
  for (int t = 0; t < 4; ++t) {
    kv[t][0] = *reinterpret_cast<const bf16x8*>(&Kh[(long)(64 * t + sr) * LDK + sc]); kv[t][1] = *reinterpret_cast<const bf16x8*>(&Kh[(long)(64 * t + 32 + sr) * LDK + sc]);
    kv[t][2] = *reinterpret_cast<const bf16x8*>(&Vh[(long)(64 * t + sr) * LDK + sc]); kv[t][3] = *reinterpret_cast<const bf16x8*>(&Vh[(long)(64 * t + 32 + sr) * LDK + sc]); }
  bf16x8 qr[8];
  const bf16* Qw = Qb + (long)(wid * QBLK + r32) * LDQ + hi * 8;
#pragma unroll
  for (int d0 = 0; d0 < 8; ++d0) qr[d0] = *reinterpret_cast<const bf16x8*>(Qw + d0 * 16);
  asm volatile("s_waitcnt vmcnt(0)" ::: "memory");
#pragma unroll
  for (int t = 0; t < 4; ++t) {
    *(bf16x8*)(K_lds + t * SHM_K + KSWZ(sr, sc * 2)) = kv[t][0]; *(bf16x8*)(K_lds + t * SHM_K + KSWZ(32 + sr, sc * 2)) = kv[t][1];
    *(bf16x8*)(V_lds + t * SHM_V + vst0) = kv[t][2]; *(bf16x8*)(V_lds + t * SHM_V + vst1) = kv[t][3]; }
  __syncthreads();
  float m_reg = -1e30f, l_reg = 0; f32x16 o[4] = {};
  const int vb0 = (int)(uintptr_t)V_lds + v_rd_base(lane);
#pragma unroll 1
  for (int t = 0; t < 4; ++t) {
    f32x16 p0, p1; float mn, al; bf16x8 pa0, pa1, pa2, pa3;
    qkt(p0, p1, (const bf16*)(K_lds + t * SHM_K), qr, r32, hi);
    partialSM(p0, p1, m_reg, mn, al);
    if (__any(al < 1.f)) { if (hi == 0) al_l[r32] = al; asm volatile("s_waitcnt lgkmcnt(0)" ::: "memory");
      for (int d = 0; d < 4; ++d) for (int r = 0; r < 16; ++r) o[d][r] *= al_l[crow(r, hi)]; }
    finishSM(p0, p1, al, l_reg, pa0, pa1, pa2, pa3); SBAR();
    pv_d0(o, vb0 + t * (int)SHM_V, pa0, pa1, pa2, pa3);
  }
  if (hi == 0) li_l[r32] = l_reg; asm volatile("s_waitcnt lgkmcnt(0)" ::: "memory");
  __syncthreads();
  store_o_rows<4>(o, li_l, Ob + (long)(wid * QBLK) * ldo, ldo, lds, wid, lane, r32, hi);
  __syncthreads();
}

template <int OFF> __device__ __forceinline__ bf16x8 rd128(int a) { bf16x8 r; asm volatile("ds_read_b128 %0, %1 offset:%2" : "=v"(r) : "v"(a), "i"(OFF) : "memory"); return r; }
#define LGKM(n) asm volatile("s_waitcnt lgkmcnt(" #n ")" ::: "memory")
#define MF(a, b, c) c = __builtin_amdgcn_mfma_f32_32x32x16_bf16(a, b, c, 0, 0, 0)
__device__ __forceinline__ void qkt_p(f32x16& p0, f32x16& p1, int ka0, int ka1, int ka2, int ka3, const bf16x8* qr) {
  p0 = f32x16{}; p1 = f32x16{};
  bf16x8 a0, b0, a1, b1, a2, b2;
  a0 = rd128<0>(ka0); b0 = rd128<8192>(ka0); a1 = rd128<0>(ka1); b1 = rd128<8192>(ka1); a2 = rd128<0>(ka2); b2 = rd128<8192>(ka2);
  LGKM(4); SBAR(); MF(a0, qr[0], p0); MF(b0, qr[0], p1); SBAR(); a0 = rd128<0>(ka3);   b0 = rd128<8192>(ka3);
  LGKM(4); SBAR(); MF(a1, qr[1], p0); MF(b1, qr[1], p1); SBAR(); a1 = rd128<128>(ka0); b1 = rd128<8320>(ka0);
  LGKM(4); SBAR(); MF(a2, qr[2], p0); MF(b2, qr[2], p1); SBAR(); a2 = rd128<128>(ka1); b2 = rd128<8320>(ka1);
  LGKM(4); SBAR(); MF(a0, qr[3], p0); MF(b0, qr[3], p1); SBAR(); a0 = rd128<128>(ka2); b0 = rd128<8320>(ka2);
  LGKM(4); SBAR(); MF(a1, qr[4], p0); MF(b1, qr[4], p1); SBAR(); a1 = rd128<128>(ka3); b1 = rd128<8320>(ka3);
  LGKM(4); SBAR(); MF(a2, qr[5], p0); MF(b2, qr[5], p1); SBAR();
  LGKM(2); SBAR(); MF(a0, qr[6], p0); MF(b0, qr[6], p1); SBAR();
  LGKM(0); SBAR(); MF(a1, qr[7], p0); MF(b1, qr[7], p1); SBAR();
}
struct VFrag { s16x4 l0, h0, l1, h1, l2, h2, l3, h3; };
template <int D> __device__ __forceinline__ void pv_rd(VFrag& f, int vb) { constexpr int B = (D >> 2) * 16384;
  f.l0 = tr_read<B + v_rd_off(D & 3, 0, 0)>(vb); f.h0 = tr_read<B + v_rd_off(D & 3, 0, 1)>(vb); f.l1 = tr_read<B + v_rd_off(D & 3, 1, 0)>(vb); f.h1 = tr_read<B + v_rd_off(D & 3, 1, 1)>(vb);
  f.l2 = tr_read<B + v_rd_off(D & 3, 2, 0)>(vb); f.h2 = tr_read<B + v_rd_off(D & 3, 2, 1)>(vb); f.l3 = tr_read<B + v_rd_off(D & 3, 3, 0)>(vb); f.h3 = tr_read<B + v_rd_off(D & 3, 3, 1)>(vb); }
__device__ __forceinline__ void pv_mm(f32x16& od, const VFrag& f, bf16x8 pa0, bf16x8 pa1, bf16x8 pa2, bf16x8 pa3) {
#define PK(L, H) (bf16x8){L[0], L[1], L[2], L[3], H[0], H[1], H[2], H[3]}
  MF(pa0, PK(f.l0, f.h0), od); MF(pa1, PK(f.l1, f.h1), od); MF(pa2, PK(f.l2, f.h2), od); MF(pa3, PK(f.l3, f.h3), od);
#undef PK
}
template <int D, int NB> __device__ __forceinline__ void pv_step(f32x16* o, VFrag& cur, VFrag& nxt, int vb, bf16x8 pa0, bf16x8 pa1, bf16x8 pa2, bf16x8 pa3) {
  if constexpr (D + 1 < NB) { pv_rd<D + 1>(nxt, vb); LGKM(8); } else { LGKM(0); }
  SBAR(); pv_mm(o[D], cur, pa0, pa1, pa2, pa3); SBAR();
  if constexpr (D + 1 < NB) pv_step<D + 1, NB>(o, nxt, cur, vb, pa0, pa1, pa2, pa3);
}
template <int NB> __device__ __forceinline__ void pv_p(f32x16* o, int vb, bf16x8 pa0, bf16x8 pa1, bf16x8 pa2, bf16x8 pa3) {
  VFrag x, y; pv_rd<0>(x, vb); pv_step<0, NB>(o, x, y, vb, pa0, pa1, pa2, pa3);
}
template <int NH>
__device__ __forceinline__ void attn_wide_body(const bf16* __restrict__ Qb, const bf16* __restrict__ Kh, const bf16* __restrict__ Vh, unsigned short* __restrict__ Ob, int ldo, int seq, char* lds) {
  int tid_ = threadIdx.x; asm volatile("" : "+v"(tid_));
  const int tid = tid_, wid = __builtin_amdgcn_readfirstlane(tid >> 6), lane = tid & 63, r32 = lane & 31, hi = lane >> 5;
  constexpr int KB = 16384, VB = NH * 16384, VOFF = 2 * KB;
  float* ws = (float*)(lds + 2 * KB + 3 * VB) + wid * 64; float* li_l = ws; float* al_l = ws + 32;
  bf16x8 qr[8];
  const bf16* Qw = Qb + (long)(wid * QBLK + r32) * LDQ + hi * 8;
#pragma unroll
  for (int d0 = 0; d0 < 8; ++d0) qr[d0] = *reinterpret_cast<const bf16x8*>(Qw + d0 * 16);
  unsigned kof[2], vof[2];
#pragma unroll
  for (int i = 0; i < 2; ++i) { const int ch = 2 * wid + i;
    const int row = ch * 4 + (lane >> 4); kof[i] = (unsigned)(row * LDK * 2 + (((lane & 15) ^ (row & 7)) << 4));
    const int s = 2 * ch + (lane >> 5), kk = (s >> 2) * 8 + ((lane & 31) >> 2), k = (kk & ~0xC) | ((kk & 4) << 1) | ((kk & 8) >> 1);
    vof[i] = (unsigned)(k * LDK * 2 + ((s & 3) * 32 + (lane & 3) * 8) * 2); }
  PG8_LAS unsigned char* L3 = (PG8_LAS unsigned char*)lds;
  const unsigned pw = (unsigned)wid * 2048u;
#define WDMA_K(t, b) do { const char* kg = (const char*)Kh + (size_t)(t) * (KVBLK * LDK * 2); _Pragma("unroll") for (int _i = 0; _i < 2; ++_i)  \
      __builtin_amdgcn_global_load_lds((const unsigned*)(kg + kof[_i]), (PG8_LAS unsigned*)(L3 + (b) * KB + pw + _i * 1024), 16, 0, 0); } while (0)
#define WDMA_V(t, b) do { const char* vg = (const char*)Vh + (size_t)(t) * (KVBLK * LDK * 2); _Pragma("unroll") for (int _h = 0; _h < NH; ++_h) _Pragma("unroll") for (int _i = 0; _i < 2; ++_i)  \
      __builtin_amdgcn_global_load_lds((const unsigned*)(vg + _h * 256 + vof[_i]), (PG8_LAS unsigned*)(L3 + VOFF + (b) * VB + _h * 16384 + pw + _i * 1024), 16, 0, 0); } while (0)
#define WQS(kb) do { f32x16 p0, p1; float mn, al; SBAR(); __builtin_amdgcn_s_setprio(1); { const int ko = (kb) * KB; qkt_p(p0, p1, ka0 + ko, ka1 + ko, ka2 + ko, ka3 + ko, qr); } __builtin_amdgcn_s_setprio(0); partialSM(p0, p1, m_reg, mn, al);                       \
    if (__any(al < 1.f)) { if (hi == 0) al_l[r32] = al; asm volatile("s_waitcnt lgkmcnt(0)" ::: "memory");                                                            \
      for (int d = 0; d < 4 * NH; ++d) for (int r = 0; r < 16; ++r) o[d][r] *= al_l[crow(r, hi)]; }                                                                     \
    finishSM(p0, p1, al, l_reg, pa0, pa1, pa2, pa3); SBAR(); } while (0)
#define WPV(vb_) do { SBAR(); __builtin_amdgcn_s_setprio(1); pv_p<4 * NH>(o, vb0 + (vb_) * VB, pa0, pa1, pa2, pa3); __builtin_amdgcn_s_setprio(0); SBAR(); } while (0)
  float m_reg = -1e30f, l_reg = 0; f32x16 o[4 * NH] = {};
  const int vb0 = (int)(uintptr_t)lds + VOFF + v_rd_base(lane);
  const int NT = seq / KVBLK; const bool lead = wid < 4;
  const int kx = (hi * 16) ^ ((r32 & 7) << 4), kl = (int)(uintptr_t)lds + r32 * 256;
  const int ka0 = kl + kx, ka1 = kl + (32 ^ kx), ka2 = kl + (64 ^ kx), ka3 = kl + (96 ^ kx);
  bf16x8 pa0, pa1, pa2, pa3;
  WDMA_K(0, 0); WDMA_V(0, 0); asm volatile("s_waitcnt vmcnt(0)" ::: "memory"); __syncthreads();
#define WEND() do { asm volatile("s_waitcnt vmcnt(0)" ::: "memory"); __syncthreads(); } while (0)
#define WROT() do { vj = vj1; vj1 = vj2; vj2 = (vj2 == 2) ? 0 : vj2 + 1; } while (0)
  int vj = 2, vj1 = 0, vj2 = 1;
  if (lead) {
#pragma unroll 1
    for (int j = -1; j + 1 < NT; ++j) { const int k1 = (j + 1) & 1;
      if (j + 2 < NT) { WDMA_K(j + 2, k1 ^ 1); WDMA_V(j + 2, vj2); }
      WQS(k1); WPV(vj1); WEND(); WROT(); }
    WEND();
  } else {
    if (1 < NT) { WDMA_K(1, 1); WDMA_V(1, 1); }
    WQS(0); WEND(); WROT();
#pragma unroll 1
    for (int j = 0; j + 1 < NT; ++j) { const int k1 = (j + 1) & 1;
      if (j + 2 < NT) { WDMA_K(j + 2, k1 ^ 1); WDMA_V(j + 2, vj2); }
      WPV(vj); WQS(k1); WEND(); WROT(); }
    WPV(vj); WEND();
  }
#undef WEND
#undef WROT
#undef WDMA_K
#undef WDMA_V
#undef WQS
#undef WPV
  if (hi == 0) li_l[r32] = l_reg; asm volatile("s_waitcnt lgkmcnt(0)" ::: "memory");
  store_o_rows<4 * NH>(o, li_l, Ob + (long)(wid * QBLK) * ldo, ldo, lds, wid, lane, r32, hi);
  __syncthreads();
}
}
#define ONE_PER_PHASE 0

namespace pg8 {
template <int ACT  > struct EpiStore {
    static constexpr bool PERM = true, AFTER_DRAIN = false, ASCAN = (ACT == 2);
    bf16_t* O; int ldc; const bf16_t* aux;
    __device__ __forceinline__ void operator()(const f32x4 (&acc)[2][2][4][2], const Unit& u, int wr, int wc, int fr, int fq) const {
        const int row0 = u.pm * BM + wr * 64 + fr, col0 = u.pn * BM + wc * 32 + 8 * fq;
#pragma unroll
        for (int ai = 0; ai < 2; ++ai)
#pragma unroll
            for (int m = 0; m < 4; ++m) { const size_t ro = (size_t)(row0 + ai * HALF + m * 16) * ldc + col0;
#pragma unroll
                for (int bj = 0; bj < 2; ++bj) { f32x4 v0 = acc[ai][bj][m][0], v1 = acc[ai][bj][m][1];
                    if (ACT == 1) { v0 = __builtin_elementwise_max(v0, (f32x4){0.f, 0.f, 0.f, 0.f}); v1 = __builtin_elementwise_max(v1, (f32x4){0.f, 0.f, 0.f, 0.f}); v0 = v0 * v0; v1 = v1 * v1; }
                    if (ACT == 2) { const int row_ = row0 + ai * HALF + m * 16, col_ = col0 + bj * HALF;
                        const u32x4 z = *(const u32x4*)(aux + ((size_t)((row_ >> 8) * 128 + (col_ >> 4)) * 256 + (row_ & 255)) * 16 + (col_ & 15));
                        const f32x4 z0 = {__uint_as_float(z.x << 16), __uint_as_float(z.x & 0xffff0000u), __uint_as_float(z.y << 16), __uint_as_float(z.y & 0xffff0000u)};
                        const f32x4 z1 = {__uint_as_float(z.z << 16), __uint_as_float(z.z & 0xffff0000u), __uint_as_float(z.w << 16), __uint_as_float(z.w & 0xffff0000u)};
#pragma unroll
                        for (int e = 0; e < 4; ++e) { v0[e] = z0[e] * __builtin_amdgcn_rcpf(1.f + __builtin_amdgcn_exp2f(-1.4426950408889634f * v0[e])); v1[e] = z1[e] * __builtin_amdgcn_rcpf(1.f + __builtin_amdgcn_exp2f(-1.4426950408889634f * v1[e])); } }
                    u32x4 w; w.x = cvt_pk_bf16(v0[0], v0[1]); w.y = cvt_pk_bf16(v0[2], v0[3]); w.z = cvt_pk_bf16(v1[0], v1[1]); w.w = cvt_pk_bf16(v1[2], v1[3]);
                    if (ACT == 3) { const int row = row0 + ai * HALF + m * 16, col = col0 + bj * HALF;
                        *(u32x4*)(O + ((size_t)((row >> 8) * 128 + (col >> 4)) * 256 + (row & 255)) * 16 + (col & 15)) = w; }
                    else *(u32x4*)(O + ro + bj * HALF) = w; } }
    }
};
}


namespace pg8 {
struct EpiQKV {
    static constexpr bool PERM = true, AFTER_DRAIN = false, ASCAN = false;
    bf16_t* QH; bf16_t* KBf; bf16_t* VBf; float* out; const float* qkn; const float* rope; PG8_LAS float* P;
    __device__ __forceinline__ void operator()(const f32x4 (&acc)[2][2][4][2], const Unit& u, int wr, int wc, int fr, int fq) const {
        const int pn = u.pn, pm = u.pm;
        const bool samp = pm >= 32; const int b = samp ? ((pm - 32) >> 4) : 0, tb = samp ? ((pm - 32) & 15) * 256 : 0;
        const int kind = pn < 4 ? 0 : pn == 4 ? 1 : pn == 5 ? 2 : pn < 10 ? 3 : pn < 14 ? 4 : 5;
        const bool nrm = kind <= 1, rp = samp && kind != 2 && kind != 5;
        const int j0 = wc * 32 + 8 * fq, t4 = 4 * (4 * wc + fq);
        if (nrm) {
#pragma unroll
            for (int ai = 0; ai < 2; ++ai)
#pragma unroll
                for (int m = 0; m < 4; ++m)
#pragma unroll
                    for (int bj = 0; bj < 2; ++bj) { const f32x4 a = acc[ai][bj][m][0], c = acc[ai][bj][m][1];
                        float ss = (a[0] * a[0] + a[1] * a[1]) + (a[2] * a[2] + a[3] * a[3]) + (c[0] * c[0] + c[1] * c[1]) + (c[2] * c[2] + c[3] * c[3]);
                        ss += __shfl_xor(ss, 16); ss += __shfl_xor(ss, 32);
                        if (fq == 0) P[((ai * HALF + wr * 64 + m * 16 + fr) * 2 + bj) * 4 + wc] = ss; }
            asm volatile("s_waitcnt lgkmcnt(0)" ::: "memory"); __builtin_amdgcn_s_barrier(); asm volatile("" ::: "memory");
        }
        f32x4 glo = {1.f, 1.f, 1.f, 1.f}, ghi = glo;
        if (nrm) { glo = *(const f32x4*)(qkn + kind * 128 + t4); ghi = *(const f32x4*)(qkn + kind * 128 + 64 + t4); }
#pragma unroll
        for (int ai = 0; ai < 2; ++ai)
#pragma unroll
            for (int m = 0; m < 4; ++m) {
                const int rl = ai * HALF + wr * 64 + m * 16 + fr, row = pm * BM + rl, tok = tb + rl;
                const size_t kvrow = samp ? (size_t)(8192 + b * 4352 + tok) : (size_t)row;
                f32x4 cs0 = {1.f, 0.f, 1.f, 0.f}, cs1 = cs0;
                if (rp) { cs0 = *(const f32x4*)(rope + ((size_t)tok * 64 + t4) * 2); cs1 = *(const f32x4*)(rope + ((size_t)tok * 64 + t4) * 2 + 4); }
#pragma unroll
                for (int bj = 0; bj < 2; ++bj) {
                    f32x4 v0 = acc[ai][bj][m][0], v1 = acc[ai][bj][m][1];
                    if (nrm) { const f32x4 q = *(const PG8_LAS f32x4*)(P + (rl * 2 + bj) * 4); const float r = 1.0f / sqrtf(((q[0] + q[1]) + (q[2] + q[3])) * (1.f / 128.f) + 1e-6f);
                        v0 = (f32x4){v0[0] * r * glo[0], v0[1] * r * ghi[0], v0[2] * r * glo[1], v0[3] * r * ghi[1]};
                        v1 = (f32x4){v1[0] * r * glo[2], v1[1] * r * ghi[2], v1[2] * r * glo[3], v1[3] * r * ghi[3]}; }
                    if (rp) {
                        v0 = (f32x4){v0[0] * cs0[0] - v0[1] * cs0[1], v0[0] * cs0[1] + v0[1] * cs0[0], v0[2] * cs0[2] - v0[3] * cs0[3], v0[2] * cs0[3] + v0[3] * cs0[2]};
                        v1 = (f32x4){v1[0] * cs1[0] - v1[1] * cs1[1], v1[0] * cs1[1] + v1[1] * cs1[0], v1[2] * cs1[2] - v1[3] * cs1[3], v1[2] * cs1[3] + v1[3] * cs1[2]}; }
                    u32x4 w; w.x = cvt_pk_bf16(v0[0], v0[1]); w.y = cvt_pk_bf16(v0[2], v0[3]); w.z = cvt_pk_bf16(v1[0], v1[1]); w.w = cvt_pk_bf16(v1[2], v1[3]);
                    if (kind == 0) *(u32x4*)(QH + (size_t)row * 2048 + (2 * pn + bj) * 128 + j0) = w;
                    else if (kind == 3) *(u32x4*)(QH + (size_t)row * 2048 + 1024 + (2 * (pn - 6) + bj) * 128 + j0) = w;
                    else if (kind == 1 || kind == 4) {
                        const int hb = (kind == 1) ? bj * 128 : 256 + (2 * (pn - 10) + bj) * 128;
                        *(u32x4*)(KBf + kvrow * 1280 + hb + j0) = w;
                        if (!samp) { float* o = (kind == 1) ? out + 35651584 - 2097152 + (size_t)row * 256 + bj * 128 : out + 37748736 + (size_t)row * 1024 + (2 * (pn - 10) + bj) * 128;
                            *(f32x4*)(o + t4) = (f32x4){v0[0], v0[2], v1[0], v1[2]}; *(f32x4*)(o + 64 + t4) = (f32x4){v0[1], v0[3], v1[1], v1[3]}; }
                    } else {
                        const int hb = (kind == 2) ? bj * 128 : 256 + (pn - 14) * 256 + bj * 128;
                        *(u32x4*)(VBf + kvrow * 1280 + hb + j0) = w;
                        if (!samp) { float* o = (kind == 2) ? out + 35651584 + (size_t)row * 256 + bj * 128 : out + 46137344 + (size_t)row * 1024 + (pn - 14) * 256 + bj * 128;
                            *(f32x4*)(o + j0) = v0; *(f32x4*)(o + j0 + 4) = v1; }
                    }
                }
            }
    }
};
}

#define LAS __attribute__((address_space(3)))
#define GAS __attribute__((address_space(1)))
constexpr int NWAVES = 8;
constexpr int RING_OFF = 0, RING_BYTES = 139264, LDSCTL_OFF = RING_BYTES, MISC_OFF = LDSCTL_OFF + 320, LDS_BYTES = 147456;
constexpr size_t WO_QKV = 0, WO_AO = 18 * MiB, WO_W1 = 26 * MiB, WO_W2 = 90 * MiB, WO_SI = 154 * MiB, WO_GL = 162 * MiB, WO_SO = 170 * MiB;
constexpr int CW_BAR = 4096, CW_ATTQ = 2048;

#define XB_TMO      128
#define XB_XCNT(j)  (256  + 64 * (j))
#define XB_XSUB(j)  (1280 + 64 * (j))
#define XB_XGEN(j)  (2304 + 64 * (j))
#define XB_TOP      3328
#define XB_TOPGEN   3392
#define XCD_BAR_WORDS 3456
#define XB_SPIN_CAP (1u << 18)
__device__ __forceinline__ unsigned xb_ld(unsigned* p)              { return __hip_atomic_load(p, __ATOMIC_RELAXED, __HIP_MEMORY_SCOPE_AGENT); }
__device__ __forceinline__ unsigned xb_add(unsigned* p, unsigned v) { return __hip_atomic_fetch_add(p, v, __ATOMIC_RELAXED, __HIP_MEMORY_SCOPE_AGENT); }
__device__ __forceinline__ unsigned xb_xcc_id() { return (unsigned)__builtin_amdgcn_s_getreg((3 << 11) | 20) & 0xFu; }
#define XB_SPIN(cond, bar) do { unsigned _sp = 0; while (cond) { __builtin_amdgcn_s_sleep(1); \
    if ((++_sp & 255u) == 0u) { if (xb_ld(&(bar)[XB_TMO])) break; if (_sp > XB_SPIN_CAP) { atomicAdd(&(bar)[XB_TMO], 1u); break; } } } } while (0)
struct XcdBarrier { unsigned* bar; unsigned x; volatile LAS unsigned* st; };
__device__ __forceinline__ XcdBarrier xcd_barrier_post(unsigned* bar, volatile LAS unsigned* st) {
    XcdBarrier b; b.bar = bar; b.x = xb_xcc_id(); b.st = st;
    if (threadIdx.x == 0) (void)xb_add(&bar[XB_XCNT(b.x)], 1u);
    return b;
}
__device__ __forceinline__ void xcd_barrier_complete(unsigned* bar, unsigned x, unsigned& nloc, unsigned& nx) {
    const unsigned G = gridDim.x * gridDim.y * gridDim.z;
    unsigned sum, cnt, mine, sp = 0u;
    for (;;) {
        sum = 0u; cnt = 0u; mine = 0u;
#pragma unroll
        for (unsigned j = 0; j < 16; ++j) { const unsigned c = xb_ld(&bar[XB_XCNT(j)]); sum += c; cnt += (c > 0u) ? 1u : 0u; mine = (j == x) ? c : mine; }
        if (sum == G) break;
        __builtin_amdgcn_s_sleep(1);
        if ((++sp & 255u) == 0u) { if (xb_ld(&bar[XB_TMO])) break; if (sp > XB_SPIN_CAP) { atomicAdd(&bar[XB_TMO], 1u); break; } }
    }
    nloc = mine > 0u ? mine : 1u; nx = cnt > 0u ? cnt : 1u;
}
__device__ __forceinline__ void xcd_barrier(const XcdBarrier& b) {
    asm volatile("s_waitcnt vmcnt(0)" ::: "memory");
    __syncthreads();
    if (threadIdx.x == 0) {
        unsigned* bar = b.bar;
        __builtin_amdgcn_s_waitcnt(0);
        unsigned nloc = b.st[0], nx = b.st[1];
        if (nloc == 0u) { xcd_barrier_complete(bar, b.x, nloc, nx); b.st[0] = nloc; b.st[1] = nx; }
        const unsigned old = xb_add(&bar[XB_XSUB(b.x)], 1u);
        const unsigned gen = old / nloc;
        if (old + 1u == (gen + 1u) * nloc) {
            __builtin_amdgcn_fence(__ATOMIC_RELEASE, "agent");
            asm volatile("s_waitcnt vmcnt(0)" ::: "memory");
            const unsigned og = xb_add(&bar[XB_TOP], 1u);
            const unsigned tg = og / nx;
            if (og + 1u == (tg + 1u) * nx) xb_add(&bar[XB_TOPGEN], 1u);
            else XB_SPIN(xb_ld(&bar[XB_TOPGEN]) == tg, bar);
            __builtin_amdgcn_fence(__ATOMIC_ACQUIRE, "agent");
            xb_add(&bar[XB_XGEN(b.x)], 1u);
            asm volatile("s_waitcnt vmcnt(0)" ::: "memory");
        } else {
            XB_SPIN(xb_ld(&bar[XB_XGEN(b.x)]) == gen, bar);
            __builtin_amdgcn_fence(__ATOMIC_ACQUIRE, "agent");
            asm volatile("s_waitcnt vmcnt(0)" ::: "memory");
        }
    }
    __syncthreads();
}

struct TItem { const float* src; bf16_t* dst; int N, K, n0, k0, qperm; };
__device__ __forceinline__ TItem titem_decode(const CP& p, int first, int it) {
    constexpr int I_QKV = (D / 64) * (NQKV / 32), I_SQ = (D / 64) * (D / 32), I_W1 = (D / 64) * (DFF / 32), I_W2 = (DFF / 64) * (D / 32);
    unsigned char* wb = p.ws + WS_W; TItem t; int r = it; t.qperm = 0;
    if (first == 0) {
        if (r < I_QKV) { t.src = p.attn_w_in; t.dst = (bf16_t*)(wb + WO_QKV); t.N = NQKV; t.K = D; t.qperm = 1; }
        else if ((r -= I_QKV) < I_SQ) { t.src = p.attn_w_out; t.dst = (bf16_t*)(wb + WO_AO); t.N = D; t.K = D; }
        else if ((r -= I_SQ) < I_W1) { t.src = p.mlp_w1; t.dst = (bf16_t*)(wb + WO_W1); t.N = DFF; t.K = D; }
        else { r -= I_W1; t.src = p.mlp_w2; t.dst = (bf16_t*)(wb + WO_W2); t.N = D; t.K = DFF; }
    } else {
        if (r < I_SQ) { t.src = p.ssm_w_in; t.dst = (bf16_t*)(wb + WO_SI); t.N = D; t.K = D; }
        else if ((r -= I_SQ) < I_SQ) { t.src = p.ssm_glu_w; t.dst = (bf16_t*)(wb + WO_GL); t.N = D; t.K = D; }
        else if ((r -= I_SQ) < I_SQ) { t.src = p.ssm_w_out; t.dst = (bf16_t*)(wb + WO_SO); t.N = D; t.K = D; }
        else if ((r -= I_SQ) < I_W1) { t.src = p.mlp_w1 + (size_t)D * DFF; t.dst = (bf16_t*)(wb + WO_W1 + 32 * MiB); t.N = DFF; t.K = D; }
        else { r -= I_W1; t.src = p.mlp_w2 + (size_t)DFF * D; t.dst = (bf16_t*)(wb + WO_W2 + 32 * MiB); t.N = D; t.K = DFF; }
    }
    const int nblk = t.N / 32, kb = r / nblk, nb = r % nblk; t.k0 = 64 * kb; t.n0 = 32 * nb;
    return t;
}
__device__ __forceinline__ int qkv_pos(int c) {
    const bool isv = (c >= 1280 && c < 1536) || c >= 3584; if (isv) return c;
    const int cl = c & 127, i = cl & 63, s = cl >> 6; return (c & ~127) + 8 * (i >> 2) + 2 * (i & 3) + s;
}
__device__ __forceinline__ void titem_load(float (&wv)[32], const TItem& t, int lane) {
    const float* s = t.src + (size_t)(t.k0 + (lane >> 3)) * t.N + t.n0 + (lane & 7) * 4;
#pragma unroll
    for (int i = 0; i < 8; ++i) { const f32x4 v = *(const f32x4*)(s + (size_t)(8 * i) * t.N); wv[4 * i] = v[0]; wv[4 * i + 1] = v[1]; wv[4 * i + 2] = v[2]; wv[4 * i + 3] = v[3]; }
}
__device__ __forceinline__ void titem_store(const float (&wv)[32], const TItem& t, LAS float* scr, int lane) {
#pragma unroll
    for (int i = 0; i < 8; ++i) { LAS float* d = scr + ((lane >> 3) + 8 * i) * 33 + (lane & 7) * 4; d[0] = wv[4 * i]; d[1] = wv[4 * i + 1]; d[2] = wv[4 * i + 2]; d[3] = wv[4 * i + 3]; }
    asm volatile("s_waitcnt lgkmcnt(0)" ::: "memory");
    const int c = lane & 7;
#pragma unroll
    for (int j = 0; j < 4; ++j) { const int n = (lane >> 3) + 8 * j; const LAS float* s = scr + (8 * c) * 33 + n;
        u32x4 o; o.x = pk2(s[0 * 33], s[1 * 33]); o.y = pk2(s[2 * 33], s[3 * 33]); o.z = pk2(s[4 * 33], s[5 * 33]); o.w = pk2(s[6 * 33], s[7 * 33]);
        const int row = t.qperm ? qkv_pos(t.n0 + n) : t.n0 + n;
        *(u32x4*)(t.dst + (size_t)row * t.K + t.k0 + 8 * c) = o; }
    asm volatile("s_waitcnt lgkmcnt(0)" ::: "memory");
}
__device__ __forceinline__ void transpose_run(const CP& p, LAS float* scr, int lane, int first, int start, int stride, int end) {
    if (start >= end) return;
    float wa[32], wb[32]; TItem ta = titem_decode(p, first, start), tb = ta;
    titem_load(wa, ta, lane);
    int it = start;
    for (;;) {
        const int i1 = it + stride; const bool h1 = i1 < end;
        if (h1) { tb = titem_decode(p, first, i1); titem_load(wb, tb, lane); }
        asm volatile("" ::: "memory");
        titem_store(wa, ta, scr, lane);
        if (!h1) break;
        const int i2 = i1 + stride; const bool h2 = i2 < end;
        if (h2) { ta = titem_decode(p, first, i2); titem_load(wa, ta, lane); }
        asm volatile("" ::: "memory");
        titem_store(wb, tb, scr, lane);
        if (!h2) break;
        it = i2;
    }
}
__device__ __forceinline__ void ph_prologue(const CP& p, LAS unsigned char* L, int lane, int wave) {
    const int gw = blockIdx.x * NWAVES + wave, NGW = gridDim.x * NWAVES;
    LAS float* sl = (LAS float*)(L + RING_OFF + 8 * 8704);
    for (int j = threadIdx.x; j < 3 * D; j += NWAVES * 64) { const int cls = j / D, k = j - cls * D; const float c0 = (cls == 0) ? p.c_ctx[k] : p.c[(cls - 1) * D + k]; sl[j] = c0 / (1.f + expf(-c0)); }
    __syncthreads();
    for (int it = gw; it < 2 * KCH * 48; it += NGW) {
        const int cb = it % 48, kc = (it / 48) % KCH, l = it / (48 * KCH);
        const float* w = p.ada_w + ((size_t)l * D + kc * 128) * NMOD + cb * 256 + lane * 4;
        f32x4 a0 = {0, 0, 0, 0}, a1 = a0, a2 = a0;
#pragma unroll 16
        for (int kk = 0; kk < 128; ++kk) {
            const int k = kc * 128 + kk;
            const float s0 = sl[k], s1 = sl[D + k], s2 = sl[2 * D + k];
            const f32x4 wv = *(const f32x4*)(w + (size_t)kk * NMOD);
            a0 += wv * s0; a1 += wv * s1; a2 += wv * s2;
        }
        float* o = (float*)(p.ws + WS_MODP) + ((size_t)(l * KCH + kc) * 3) * NMOD + cb * 256 + lane * 4;
        *(f32x4*)(o) = a0; *(f32x4*)(o + NMOD) = a1; *(f32x4*)(o + 2 * NMOD) = a2;
    }
    {
        LAS float* scr = (LAS float*)(L + RING_OFF + wave * 8704);
        constexpr int I_QKV = (D / 64) * (NQKV / 32), I_SQ = (D / 64) * (D / 32), I_W1 = (D / 64) * (DFF / 32), I_W2 = (DFF / 64) * (D / 32);
        constexpr int NITEMS0 = I_QKV + I_SQ + I_W1 + I_W2, NGEMV = 2 * KCH * 48;
        const int ng = NGW < NGEMV ? NGW : NGEMV;
        const int split = (NGW > ng) ? 8 * ng : NITEMS0;
        if (gw < ng) transpose_run(p, scr, lane, 0, gw, ng, split);
        else transpose_run(p, scr, lane, 0, split + (gw - ng), NGW - ng, NITEMS0);
    }
    for (int i = gw * 64 + lane; i < LQ * 64; i += NGW * 64) {
        const int t = i >> 6, j = i & 63;
        const float inv = powf(10000.f, -(float)(j & 31) / 32.f);
        const float pos = (j < 32) ? (float)(t >> 6) : (float)(t & 63);
        const float ang = pos * inv;
        ((f32x2*)(p.ws + WS_ROPE))[i] = (f32x2){cosf(ang), sinf(ang)};
    }
    for (int i2 = gw * 64 + lane; i2 < 2 * 128 * 64 * 16; i2 += NGW * 64) {
        const int c = i2 & 15, i = i2 >> 4, n = i & 63, kg = i >> 6;
        const float are = p.ssm_a_re[i], aim = p.ssm_a_im[i], dt = expf(p.ssm_log_dt[kg]);
        const float er = expf(are * dt), abr = er * cosf(aim * dt), abi = er * sinf(aim * dt);
        const float nr = abr - 1.f, ni = abi, den = are * are + aim * aim; const float cr = (nr * are + ni * aim) / den, ci = (ni * are - nr * aim) / den;
        if (c == 0) {
            ((f32x2*)(p.ws + WS_ABAR))[i] = (f32x2){abr, abi};
            float pr = abr, pi_ = abi;
#pragma unroll
            for (int s = 0; s < 8; ++s) { const float t = pr * pr - pi_ * pi_; pi_ = 2.f * pr * pi_; pr = t; }
            ((f32x2*)(p.ws + WS_A256))[i] = (f32x2){pr, pi_};
        }
        bf16_t* bbar = (bf16_t*)(p.ws + WS_BBAR) + (size_t)kg * 4 * 512; bf16_t* cmat = (bf16_t*)(p.ws + WS_CMAT) + (size_t)kg * 4 * 512;
        const int nn = n & 31, nh = n >> 5;
        const float br = p.ssm_b_re[(size_t)i * 16 + c], bi = p.ssm_b_im[(size_t)i * 16 + c];
        const int ln = (c >> 3) * 32 + nn, j = c & 7;
        bbar[(nh) * 512 + ln * 8 + j] = (bf16_t)f2bf(cr * br - ci * bi);
        bbar[(2 + nh) * 512 + ln * 8 + j] = (bf16_t)f2bf(cr * bi + ci * br);
        {
          const float vr = cr * br - ci * bi, vi = cr * bi + ci * br; float pr = 1.f, pi_ = 0.f;
#pragma unroll
          for (int e = 0; e < 4; ++e) {
              bf16_t* b4 = (bf16_t*)(p.ws + WS_BB4) + ((size_t)(3 - e) * 256 + kg) * 4 * 512;
              b4[(nh) * 512 + ln * 8 + j] = (bf16_t)f2bf(pr * vr - pi_ * vi); b4[(2 + nh) * 512 + ln * 8 + j] = (bf16_t)f2bf(pr * vi + pi_ * vr);
              const float t = pr * abr - pi_ * abi; pi_ = pr * abi + pi_ * abr; pr = t; }
          if (c == 0) ((f32x2*)(p.ws + WS_A4))[i] = (f32x2){pr, pi_}; }
        const float c_re = p.ssm_c_re[((size_t)kg * 16 + c) * 64 + n], c_im = p.ssm_c_im[((size_t)kg * 16 + c) * 64 + n];
        const int K0 = 4 * nn + 2 * nh;
        { const int K = K0, s = K >> 5, l2 = c + 16 * ((K & 31) >> 3), jj = K & 7; cmat[s * 512 + l2 * 8 + jj] = (bf16_t)f2bf(c_re); }
        { const int K = K0 + 1, s = K >> 5, l2 = c + 16 * ((K & 31) >> 3), jj = K & 7; cmat[s * 512 + l2 * 8 + jj] = (bf16_t)f2bf(-c_im); }
    }
    bf16_t* KBf = (bf16_t*)(p.ws + WS_KB); bf16_t* VBf = (bf16_t*)(p.ws + WS_VB);
    for (int r = gw; r < 512; r += NGW) {
        const int b = r >> 8, t = r & 255; const size_t kr = (size_t)(MP + b * LKV + LQ + t) * KVW;
        for (int c = lane * 2; c < 256; c += 128) { const size_t s = ((size_t)(b * 256 + t)) * 256 + c;
            KBf[kr + qkv_pos(c)] = (bf16_t)f2bf(p.cache_a_k[s]); KBf[kr + qkv_pos(c + 1)] = (bf16_t)f2bf(p.cache_a_k[s + 1]); *(unsigned*)(VBf + kr + c) = pk2(p.cache_a_v[s], p.cache_a_v[s + 1]); }
        for (int c = lane * 2; c < 1024; c += 128) { const size_t s = ((size_t)(b * 256 + t)) * 1024 + c;
            KBf[kr + 256 + qkv_pos(c)] = (bf16_t)f2bf(p.cache_b_k[s]); KBf[kr + 256 + qkv_pos(c + 1)] = (bf16_t)f2bf(p.cache_b_k[s + 1]); *(unsigned*)(VBf + kr + 256 + c) = pk2(p.cache_b_v[s], p.cache_b_v[s + 1]); }
    }
}


__device__ __forceinline__ void ph_late_weights(const CP& p, LAS unsigned char* L, int lane, int wave, int widx, int nw) {
    LAS float* scr = (LAS float*)(L + RING_OFF + wave * 8704);
    constexpr int I_SQ = (D / 64) * (D / 32), I_W1 = (D / 64) * (DFF / 32), I_W2 = (DFF / 64) * (D / 32);
    transpose_run(p, scr, lane, 1, widx, nw, 3 * I_SQ + I_W1 + I_W2);
}

template <bool FINAL>
__device__ __forceinline__ void ld_mod(const CP& p, LAS float* dst, int l, int cls, int idx, int tid) {
    for (int j = tid; j < D; j += NWAVES * 64) {
        if (FINAL) { dst[j] = ((const float*)(p.ws + WS_MOD))[((size_t)(l * 3 + cls) * 6 + idx) * D + j]; }
        else {
            float s = p.ada_b[l * NMOD + idx * D + j];
            const float* mp = (const float*)(p.ws + WS_MODP) + ((size_t)(l * KCH) * 3 + cls) * NMOD + idx * D + j;
#pragma unroll
            for (int kc = 0; kc < KCH; ++kc) s += mp[(size_t)kc * 3 * NMOD];
            dst[j] = s;
        }
    }
}
__device__ __forceinline__ void mod_finish(const CP& p, int tid) {
    const int per = (2 * 3 * NMOD + (int)gridDim.x - 1) / (int)gridDim.x;
    for (int i = (int)blockIdx.x * per + tid; i < ((int)blockIdx.x + 1) * per && i < 2 * 3 * NMOD; i += NWAVES * 64) {
        const int j = i % NMOD, cls = (i / NMOD) % 3, l = i / (3 * NMOD);
        float s = p.ada_b[l * NMOD + j];
        const float* mp = (const float*)(p.ws + WS_MODP) + ((size_t)(l * KCH) * 3 + cls) * NMOD + j;
#pragma unroll
        for (int kc = 0; kc < KCH; ++kc) s += mp[(size_t)kc * 3 * NMOD];
        ((float*)(p.ws + WS_MOD))[i] = s;
    }
}
struct RowIn { f32x4 xf[8]; u32x2 xh[8]; u32x2 ow[8]; };
template <bool BR, bool XIN16>
__device__ __forceinline__ void row_load(RowIn& in, int m, int lane, const float* xin_row, const bf16_t* xin16, const bf16_t* o) {
    if (XIN16) {
#pragma unroll
        for (int j = 0; j < 8; ++j) in.xh[j] = *(const u32x2*)(xin16 + (size_t)m * D + j * 256 + lane * 4);
    } else {
#pragma unroll
        for (int j = 0; j < 8; ++j) in.xf[j] = *(const f32x4*)(xin_row + j * 256 + lane * 4);
    }
    if (BR) {
#pragma unroll
        for (int j = 0; j < 8; ++j) in.ow[j] = *(const u32x2*)(o + (size_t)m * D + j * 256 + lane * 4);
    }
}
template <bool BR, bool NX, bool XIN16, bool XOUT16>
__device__ __forceinline__ void row_compute(const CP& p, const RowIn& in, int m, int lane, bf16_t* xout16, bf16_t* xn,
                                            const LAS float* gate, const float* gp, const LAS float* sh, const LAS float* sc, const float* gn) {
    f32x4 x[8];
#pragma unroll
    for (int j = 0; j < 8; ++j) {
        if (XIN16) { const u32x2 w = in.xh[j]; x[j] = (f32x4){__uint_as_float(w.x << 16), __uint_as_float(w.x & 0xffff0000u), __uint_as_float(w.y << 16), __uint_as_float(w.y & 0xffff0000u)}; }
        else x[j] = in.xf[j];
    }
    if (BR) {
        f32x4 ov[8]; float ss = 0.f;
#pragma unroll
        for (int j = 0; j < 8; ++j) { const u32x2 w = in.ow[j];
            ov[j] = (f32x4){__uint_as_float(w.x << 16), __uint_as_float(w.x & 0xffff0000u), __uint_as_float(w.y << 16), __uint_as_float(w.y & 0xffff0000u)};
            ss += ov[j].x * ov[j].x + ov[j].y * ov[j].y + ov[j].z * ov[j].z + ov[j].w * ov[j].w; }
        const float r = 1.0f / sqrtf(wave_sum(ss) * (1.f / D) + EPS);
        float* xo = p.out + OUT_Y + (size_t)m * D;
#pragma unroll
        for (int j = 0; j < 8; ++j) { const f32x4 g4 = *(const LAS f32x4*)(gate + j * 256 + lane * 4);
            x[j] = x[j] + g4 * (ov[j] * r);
            if (XOUT16) { u32x2 w; w.x = pk2(x[j].x, x[j].y); w.y = pk2(x[j].z, x[j].w); *(u32x2*)(xout16 + (size_t)m * D + j * 256 + lane * 4) = w; }
            else *(f32x4*)(xo + j * 256 + lane * 4) = x[j]; }
    }
    if (NX) {
        float ss = 0.f;
#pragma unroll
        for (int j = 0; j < 8; ++j) ss += x[j].x * x[j].x + x[j].y * x[j].y + x[j].z * x[j].z + x[j].w * x[j].w;
        const float r = 1.0f / sqrtf(wave_sum(ss) * (1.f / D) + EPS);
#pragma unroll
        for (int j = 0; j < 8; ++j) { const f32x4 s4 = *(const LAS f32x4*)(sh + j * 256 + lane * 4), c4 = *(const LAS f32x4*)(sc + j * 256 + lane * 4);
            const f32x4 v = (x[j] * r) * c4 + s4;
            u32x2 w; w.x = pk2(v.x, v.y); w.y = pk2(v.z, v.w); *(u32x2*)(xn + (size_t)m * D + j * 256 + lane * 4) = w; }
    }
}
template <bool BR, bool NX, bool XIN16, bool XOUT16>
__device__ __forceinline__ void rows8(const CP& p, int mbase, int lane, const bf16_t* xin16, bf16_t* xout16, const bf16_t* o, bf16_t* xn,
                                      const LAS float* gate, const float* gp, const LAS float* sh, const LAS float* sc, const float* gn) {
#define ROW_LD(R, mm) row_load<BR, XIN16>(R, (mm), lane, XIN16 ? nullptr : x_row(p, (mm)), xin16, o); asm volatile("" ::: "memory")
#define ROW_DO(R, mm) row_compute<BR, NX, XIN16, XOUT16>(p, R, (mm), lane, xout16, xn, gate, gp, sh, sc, gn)
    RowIn A, B; ROW_LD(A, mbase);
#pragma unroll 1
    for (int i = 0; i < 6; i += 2) {
        ROW_LD(B, mbase + i + 1); ROW_DO(A, mbase + i);
        ROW_LD(A, mbase + i + 2); ROW_DO(B, mbase + i + 1);
    }
    ROW_LD(B, mbase + 7); ROW_DO(A, mbase + 6); ROW_DO(B, mbase + 7);
#undef ROW_LD
#undef ROW_DO
}
template <int MODE>
__device__ __forceinline__ void ph_rowop(const CP& p, LAS unsigned char* L, int tid, int lane, int wave, int l, const bf16_t* o, bf16_t* xn) {
    LAS float* vg = (LAS float*)(L + RING_OFF); LAS float* vs = vg + D; LAS float* vc = vs + D;
    constexpr bool BR = MODE != 0, NX = MODE != 3;
    const int lb = l, ib = (MODE == 1) ? 0 : 3, ln = (MODE == 2) ? l + 1 : l, in_ = (MODE == 1) ? 3 : 0;
    int cur = -1;
    const bool own = gridDim.x == 256;
    for (int mb_ = blockIdx.x * 64; mb_ < M; mb_ += gridDim.x * 64) {
        const int c_ = (int)blockIdx.x, m0 = own ? (8 * (c_ % 8) + (c_ / 8) % 8) * 256 + 64 * (c_ / 64) : mb_;
        const int cls = row_class(m0);
        if (cls != cur) {
            __syncthreads();
            const float* gp = p.norm_g + (size_t)(lb * 4 + (ib == 0 ? 1 : 3)) * D; const float* gn = p.norm_g + (size_t)(ln * 4 + (in_ == 0 ? 0 : 2)) * D;
            if (BR) ld_mod<MODE != 0>(p, vg, lb, cls, ib + 2, tid);
            if (NX) { ld_mod<MODE != 0>(p, vs, ln, cls, in_, tid); ld_mod<MODE != 0>(p, vc, ln, cls, in_ + 1, tid); }
            for (int j = tid; j < D; j += NWAVES * 64) {
                if (BR) vg[j] = vg[j] * gp[j];
                if (NX) vc[j] = (vc[j] + 1.0f) * gn[j]; }
            __syncthreads(); cur = cls;
        }
        const float* gp = nullptr; const float* gn = nullptr;
        { const int mb = m0 + wave * 8;
            bf16_t* XR = (bf16_t*)(p.ws + WS_QH);
            if (MODE == 0) rows8<BR, NX, false, true>(p, mb, lane, nullptr, nullptr, o, xn, vg, gp, vs, vc, gn);
            else if (MODE == 1 && l == 0) rows8<BR, NX, false, true>(p, mb, lane, nullptr, XR, o, xn, vg, gp, vs, vc, gn);
            else if (MODE == 3) rows8<BR, NX, true, false>(p, mb, lane, XR, nullptr, o, xn, vg, gp, vs, vc, gn);
            else rows8<BR, NX, true, true>(p, mb, lane, XR, XR, o, xn, vg, gp, vs, vc, gn); }
    }
    if (MODE == 0) mod_finish(p, tid);
    __syncthreads();
}

__device__ __forceinline__ void ph_combine(const CP& p, int lane, int wave, bf16_t* OC) {
    const int gw = blockIdx.x * NWAVES + wave, NGW = gridDim.x * NWAVES;
    const bf16_t* O = (const bf16_t*)(p.ws + WS_O);
    const float* lp = p.diff_lambda;
    const float s1 = wave_sum(lp[2 * lane] * lp[128 + 2 * lane] + lp[2 * lane + 1] * lp[128 + 2 * lane + 1]);
    const float s2 = wave_sum(lp[256 + 2 * lane] * lp[384 + 2 * lane] + lp[256 + 2 * lane + 1] * lp[384 + 2 * lane + 1]);
    const float lam_init = 0.2f, lam = expf(s1) - expf(s2) + lam_init;
    for (int m = gw; m < M; m += NGW) {
        const bf16_t* orow = O + (size_t)m * D - 1024; bf16_t* oc = OC + (size_t)m * D;
#pragma unroll
        for (int h = 0; h < 4; ++h) {
            float v[2][2]; float ss = 0.f;
#pragma unroll
            for (int vh = 0; vh < 2; ++vh) {
                const unsigned w0 = *(const unsigned*)(orow + 1024 + (4 * h + vh) * 128 + 2 * lane), w1 = *(const unsigned*)(orow + 1024 + (4 * h + 2 + vh) * 128 + 2 * lane);
                v[vh][0] = __uint_as_float(w0 << 16) - lam * __uint_as_float(w1 << 16); v[vh][1] = __uint_as_float(w0 & 0xffff0000u) - lam * __uint_as_float(w1 & 0xffff0000u);
                ss += v[vh][0] * v[vh][0] + v[vh][1] * v[vh][1];
            }
            const float r = (1.0f / sqrtf(wave_sum(ss) * (1.f / 256.f) + EPS)) * (1.f - lam_init);
#pragma unroll
            for (int vh = 0; vh < 2; ++vh) { const float* g = p.diff_subln + vh * 128 + 2 * lane;
                *(unsigned*)(oc + 1024 + h * 256 + vh * 128 + 2 * lane) = pk2(v[vh][0] * r * g[0], v[vh][1] * r * g[1]); }
        }
    }
}

template <int ACT>
__device__ __forceinline__ void ph_gemm(LAS unsigned char* L, const bf16_t* A, const bf16_t* Bt, int N, int K, bf16_t* C, const bf16_t* aux, int wgm = pg8::WGM) {
    pg8::Gemm g{A, Bt, M, N, K}; pg8::StaticOrder S; S.init(M, N, (int)gridDim.x, (int)blockIdx.x, wgm);
    pg8::EpiStore<ACT> E{C, N, aux};
    pg8::gemm_phase<pg8::EpiStore<ACT>, pg8::StaticOrder, true, true>(L + RING_OFF, g, S, E);
}


__device__ __forceinline__ void ph_gemm_qkv(const CP& p, LAS unsigned char* L, const bf16_t* A, const bf16_t* Bt, int lane, int wave) {
    pg8::Gemm g{A, Bt, M, NQKV, D}; pg8::StaticOrder S; S.init(M, NQKV, (int)gridDim.x, (int)blockIdx.x);
    pg8::EpiQKV E{(bf16_t*)(p.ws + WS_QH), (bf16_t*)(p.ws + WS_KB), (bf16_t*)(p.ws + WS_VB), p.out, p.qk_norm, (const float*)(p.ws + WS_ROPE), (LAS float*)(L + 131072)};
    pg8::gemm_phase<pg8::EpiQKV, pg8::StaticOrder, true, true>(L + RING_OFF, g, S, E);
    const int G = (int)gridDim.x, nfull = 1152 / G, first_idle = 1152 - nfull * G;
    if ((int)blockIdx.x >= first_idle) ph_late_weights(p, L, lane, wave, ((int)blockIdx.x - first_idle) * NWAVES + wave, (G - first_idle) * NWAVES);
}

__device__ __forceinline__ void ph_attn(const CP& p, unsigned char* lds, bf16_t* OC) {
    const int G = gridDim.x, bx = blockIdx.x;
    const int vcu = (G % 8 == 0) ? (bx % 8) * (G / 8) + bx / 8 : bx;
    const bf16_t* QH = (const bf16_t*)(p.ws + WS_QH); const bf16_t* KBf = (const bf16_t*)(p.ws + WS_KB); const bf16_t* VBf = (const bf16_t*)(p.ws + WS_VB);
    bf16_t* O = (bf16_t*)(p.ws + WS_O);
    for (int U = vcu; U < 256; U += G) {
        const int b = U >> 7, hm = (U >> 4) & 7, qb = U & 15, qrow0 = MP + b * LQ + qb * 256, krow0 = MP + b * LKV;
        int seq = LKV; asm volatile("" : "+s"(seq));
        att::attn_wide_body<2>((const att::bf16*)(QH + (size_t)qrow0 * D + 1024 + hm * 128), (const att::bf16*)(KBf + (size_t)krow0 * KVW + 256 + hm * 128),
                            (const att::bf16*)(VBf + (size_t)krow0 * KVW + 256 + (hm >> 1) * 256), O + (size_t)qrow0 * D + hm * 256, D, seq, (char*)lds);
    }
    for (int U = vcu; U < 256; U += G) {
        const int b = U >> 7, inst = (U >> 4) & 7, qb = U & 15, qrow0 = MP + b * LQ + qb * 256, krow0 = MP + b * LKV;
        int seq = LKV; asm volatile("" : "+s"(seq));
        const int koff = (inst >> 2) * 128;
        att::attn_wide_body<1>((const att::bf16*)(QH + (size_t)qrow0 * D + inst * 128), (const att::bf16*)(KBf + (size_t)krow0 * KVW + koff),
                               (const att::bf16*)(VBf + (size_t)krow0 * KVW + koff), OC + (size_t)qrow0 * D + inst * 128, D, seq, (char*)lds);
    }
    __syncthreads();
    for (int t = vcu; t < 768; t += G) {
        const int b = (int)t / 24, inst = (int)t % 24, qrow0 = b * 256, krow0 = b * 256;
        int qoff, koff, voff, ooff;
        if (inst < 8) { qoff = inst * 128; koff = (inst >> 2) * 128; voff = koff; ooff = inst * 128; }
        else { const int i2 = inst - 8, hm = i2 >> 1, vh = i2 & 1; qoff = 1024 + hm * 128; koff = 256 + hm * 128; voff = 256 + (hm >> 1) * 256 + vh * 128; ooff = 1024 + i2 * 128; }
        bf16_t* op = (inst < 8) ? OC + (size_t)qrow0 * D + ooff : O + (size_t)qrow0 * D + (ooff - 1024);
        att::attn_small_body((const att::bf16*)(QH + (size_t)qrow0 * D + qoff), (const att::bf16*)(KBf + (size_t)krow0 * KVW + koff),
                             (const att::bf16*)(VBf + (size_t)krow0 * KVW + voff), op, D, (char*)lds);
    }
}


typedef short s16x8 __attribute__((ext_vector_type(8)));
typedef float f32x16 __attribute__((ext_vector_type(16)));
constexpr int SSM_IMG_ROW = 272, SSM_IMG = 16 * SSM_IMG_ROW, SSM_YBUF = 8192, SSM_WAVE_LDS = 2 * SSM_IMG + SSM_YBUF;
__device__ __forceinline__ float gelu_fast(float v) { const float u = 0.7978845608028654f * (v + 0.044715f * v * v * v); return v * __builtin_amdgcn_rcpf(1.f + __builtin_amdgcn_exp2f(-2.8853900817779268f * u)); }
struct SsmItem {
    f32x2 alo, ahi; const s16x8* BB; const s16x8* CM; unsigned fo; f32x4 dd4; unsigned uo; int ustep; const bf16_t* U; bf16_t* Z; int t0, g, hh;
    LAS unsigned char* img; LAS unsigned char* ybuf; int nn, half, ti, cq;
};
template <int MODE>
__device__ __forceinline__ void ssm_tile(const SsmItem& S, int tau, f32x16 (&acur)[4], f32x16 (&anxt)[4], const s16x8& ux, s16x8& uy, f32x2& hlo, f32x2& hhi, u32x2& uf4n, u32x2& ub4n, s16x8 (&bfw)[4], s16x8 (&bbw)[4]) {
    const u32x2 uf4 = uf4n, ub4 = ub4n;
    if (tau + 2 < 16) uy = *(const s16x8*)(S.U + (unsigned)((int)S.uo + (tau + 2) * S.ustep));
    if (MODE == 1 && tau >= 7 && tau < 15) {
        uf4n = *(const u32x2*)(S.U + (unsigned)((S.t0 + 16 * (tau + 1) + S.ti) * D + 16 * S.g + 4 * S.cq));
        ub4n = *(const u32x2*)(S.U + (unsigned)((S.t0 + 255 - 16 * (tau + 1) - S.ti) * D + 16 * S.g + 4 * S.cq)); }
    if (tau + 1 < 16) {
        const s16x8 z8 = {0, 0, 0, 0, 0, 0, 0, 0};
        const s16x8 uf = S.hh ? z8 : ux, ub = S.hh ? ux : z8;
#pragma unroll
        for (int q = 0; q < 4; ++q) { anxt[q] = __builtin_amdgcn_mfma_f32_32x32x16_bf16(uf, bfw[q], (f32x16){0.f}, 0, 0, 0); anxt[q] = __builtin_amdgcn_mfma_f32_32x32x16_bf16(ub, bbw[q], anxt[q], 0, 0, 0); }
    }
    const f32x2 alo = S.alo, ahi = S.ahi;
    s16x8 cfw[4], cbw[4];
#pragma unroll
    for (int i = 0; i < 16; ++i) {
        float lr = __builtin_fmaf(alo.x, hlo.x, __builtin_fmaf(-alo.y, hlo.y, acur[0][i])); asm volatile("" : "+v"(lr));
        float li = __builtin_fmaf(alo.x, hlo.y, __builtin_fmaf(alo.y, hlo.x, acur[2][i])); asm volatile("" : "+v"(li));
        float hr = __builtin_fmaf(ahi.x, hhi.x, __builtin_fmaf(-ahi.y, hhi.y, acur[1][i])); asm volatile("" : "+v"(hr));
        float hi2 = __builtin_fmaf(ahi.x, hhi.y, __builtin_fmaf(ahi.y, hhi.x, acur[3][i])); asm volatile("" : "+v"(hi2));
        hlo = (f32x2){lr, li}; hhi = (f32x2){hr, hi2};
        if (MODE == 1) { u32x2 w; w.x = pk2(lr, li); w.y = pk2(hr, hi2); *(LAS u32x2*)(S.img + S.half * SSM_IMG + i * SSM_IMG_ROW + S.nn * 8) = w; }
        if (MODE == 1 && i == 11 && tau + 2 < 16) {
            asm volatile("" ::: "memory");
#pragma unroll
            for (int q = 0; q < 4; ++q) { bfw[q] = S.BB[S.fo + q * 64]; bbw[q] = S.BB[S.fo + 32768u + q * 64]; }
        }
        if (MODE == 1 && i == 7) {
            asm volatile("" ::: "memory");
#pragma unroll
            for (int q = 0; q < 4; ++q) { cfw[q] = S.CM[S.fo + q * 64]; cbw[q] = S.CM[S.fo + 32768u + q * 64]; }
        }
    }
    if (MODE == 1) {
        const int ti = S.ti, cq = S.cq, g = S.g, t0 = S.t0;
        asm volatile("" ::: "memory");
        f32x4 y0 = {0.f, 0.f, 0.f, 0.f}, y1 = {0.f, 0.f, 0.f, 0.f};
#pragma unroll
        for (int s = 0; s < 4; ++s) {
            const s16x8 b0 = *(const LAS s16x8*)(S.img + ti * SSM_IMG_ROW + 64 * s + 16 * cq), b1 = *(const LAS s16x8*)(S.img + SSM_IMG + ti * SSM_IMG_ROW + 64 * s + 16 * cq);
            y0 = __builtin_amdgcn_mfma_f32_16x16x32_bf16(cfw[s], b0, y0, 0, 0, 0); y1 = __builtin_amdgcn_mfma_f32_16x16x32_bf16(cbw[s], b1, y1, 0, 0, 0);
        }
        asm volatile("s_nop 15\n\ts_nop 7" : "+v"(y0), "+v"(y1) :: "memory");
        LAS unsigned char* af = S.ybuf + tau * 512 + ti * 32 + 8 * cq; LAS unsigned char* ab = S.ybuf + (15 - tau) * 512 + (15 - ti) * 32 + 8 * cq;
        if (tau < 8) {
            u32x2 w; w.x = pk2(y0[0], y0[1]); w.y = pk2(y0[2], y0[3]); *(LAS u32x2*)af = w;
            w.x = pk2(y1[0], y1[1]); w.y = pk2(y1[2], y1[3]); *(LAS u32x2*)ab = w;
        } else {
            const u32x2 sf = *(const LAS u32x2*)af, sb = *(const LAS u32x2*)ab;
            const unsigned tokf = (unsigned)(t0 + 16 * tau + ti), tokb = (unsigned)(t0 + 255 - 16 * tau - ti);
            f32x4 tf = y0 + (f32x4){__uint_as_float(sf.x << 16), __uint_as_float(sf.x & 0xffff0000u), __uint_as_float(sf.y << 16), __uint_as_float(sf.y & 0xffff0000u)};
            f32x4 tb = y1 + (f32x4){__uint_as_float(sb.x << 16), __uint_as_float(sb.x & 0xffff0000u), __uint_as_float(sb.y << 16), __uint_as_float(sb.y & 0xffff0000u)};
            tf = tf + S.dd4 * (f32x4){__uint_as_float(uf4.x << 16), __uint_as_float(uf4.x & 0xffff0000u), __uint_as_float(uf4.y << 16), __uint_as_float(uf4.y & 0xffff0000u)};
            tb = tb + S.dd4 * (f32x4){__uint_as_float(ub4.x << 16), __uint_as_float(ub4.x & 0xffff0000u), __uint_as_float(ub4.y << 16), __uint_as_float(ub4.y & 0xffff0000u)};
            u32x2 w; w.x = pk2(gelu_fast(tf[0]), gelu_fast(tf[1])); w.y = pk2(gelu_fast(tf[2]), gelu_fast(tf[3])); *(u32x2*)(S.Z + (tokf * D + 16 * g + 4 * cq)) = w;
            w.x = pk2(gelu_fast(tb[0]), gelu_fast(tb[1])); w.y = pk2(gelu_fast(tb[2]), gelu_fast(tb[3])); *(u32x2*)(S.Z + (tokb * D + 16 * g + 4 * cq)) = w;
        }
        asm volatile("" ::: "memory");
    }
}
template <int MODE  >
__device__ __forceinline__ void ph_ssm_scan(const CP& p, LAS unsigned char* L, int lane, int wave, const bf16_t* U, bf16_t* Z) {
    const int gw = blockIdx.x * NWAVES + wave, NGW = gridDim.x * NWAVES;
    const f32x2* ABAR = (const f32x2*)(p.ws + WS_ABAR); const f32x2* SST = (const f32x2*)(p.ws + WS_SST);
    const s16x8* BBAR = (const s16x8*)(p.ws + WS_BBAR); const s16x8* CMAT = (const s16x8*)(p.ws + WS_CMAT);
    constexpr int NITEMS = (MODE == 0 ? 32 : 64) * 128;
    SsmItem S;
    S.img = L + RING_OFF + wave * SSM_WAVE_LDS; S.ybuf = S.img + 2 * SSM_IMG;
    S.nn = lane & 31; S.half = lane >> 5; S.ti = lane & 15; S.cq = lane >> 4; S.U = U; S.Z = Z;
    const int nn = S.nn, half = S.half;
#pragma unroll 1
    for (int it = gw; it < NITEMS; it += NGW) {
        const int g = it & 127, ci = it >> 7;
        const bool samp = (MODE == 0) || ci >= 32; const int sc = (MODE == 0) ? ci : ci - 32;
        const int t0 = samp ? MP + sc * 256 : ci * 256;
        const int pidx = (half * 128 + g) * 64;
        S.g = g; S.t0 = t0;
        S.alo = ABAR[pidx + nn]; S.ahi = ABAR[pidx + nn + 32];
        S.BB = BBAR; S.CM = CMAT; S.fo = (unsigned)(g * 256 + lane);
        s16x8 bfw[4], bbw[4];
#pragma unroll
        for (int q = 0; q < 4; ++q) { bfw[q] = BBAR[S.fo + q * 64]; bbw[q] = BBAR[S.fo + 32768u + q * 64]; }
        f32x2 hlo = {0.f, 0.f}, hhi = {0.f, 0.f};
        if (MODE == 1 && samp) {
            const int bq = sc >> 4, cq2 = sc & 15; const f32x2* A256 = (const f32x2*)(p.ws + WS_A256);
            const f32x2 qlo = A256[pidx + nn], qhi = A256[pidx + nn + 32];
            const float* st = p.state_ssm + ((size_t)(bq * 2 + half) * 128 + g) * 128;
            hlo = (f32x2){st[2 * nn], st[2 * nn + 1]}; hhi = (f32x2){st[2 * nn + 64], st[2 * nn + 65]};
            const int nst = half ? 15 - cq2 : cq2;
            f32x2 s0[15], s1[15];
#pragma unroll
            for (int k = 0; k < 15; ++k) { const int j = half ? 15 - k : k; const size_t o = ((size_t)((bq * 16 + j) * 2 + half) * 128 + g) * 64; s0[k] = SST[o + nn]; s1[k] = SST[o + nn + 32]; }
#pragma unroll
            for (int k = 0; k < 15; ++k) {
                const f32x2 nl = {qlo.x * hlo.x - qlo.y * hlo.y + s0[k].x, qlo.x * hlo.y + qlo.y * hlo.x + s0[k].y};
                const f32x2 nh = {qhi.x * hhi.x - qhi.y * hhi.y + s1[k].x, qhi.x * hhi.y + qhi.y * hhi.x + s1[k].y};
                hlo = (k < nst) ? nl : hlo; hhi = (k < nst) ? nh : hhi;
            }
        }
        const int r = lane & 31, hh = (r >> 2) & 1, si = 4 * (r >> 3) + (r & 3);
        S.hh = hh;
        S.uo = (unsigned)((hh ? t0 + 255 - si : t0 + si) * D + 16 * g + 8 * (lane >> 5));
        S.ustep = hh ? -16 * D : 16 * D;
        S.dd4 = *(const f32x4*)(p.ssm_d + 16 * g + 4 * S.cq);
        const s16x8 u0 = *(const s16x8*)(U + S.uo); s16x8 uX = *(const s16x8*)(U + (unsigned)((int)S.uo + S.ustep)), uY = uX;
        u32x2 uf4n = {0u, 0u}, ub4n = {0u, 0u};
        f32x16 accA[4], accB[4];
        { const s16x8 z8 = {0, 0, 0, 0, 0, 0, 0, 0}; const s16x8 uf = hh ? z8 : u0, ub = hh ? u0 : z8;
#pragma unroll
          for (int q = 0; q < 4; ++q) { accA[q] = __builtin_amdgcn_mfma_f32_32x32x16_bf16(uf, bfw[q], (f32x16){0.f}, 0, 0, 0); accA[q] = __builtin_amdgcn_mfma_f32_32x32x16_bf16(ub, bbw[q], accA[q], 0, 0, 0); } }
#pragma unroll 1
        for (int tau = 0; tau < 16; tau += 2) {
            ssm_tile<MODE>(S, tau, accA, accB, uX, uY, hlo, hhi, uf4n, ub4n, bfw, bbw);
            ssm_tile<MODE>(S, tau + 1, accB, accA, uY, uX, hlo, hhi, uf4n, ub4n, bfw, bbw);
        }
        if (MODE == 0) { f32x2* o = (f32x2*)(p.ws + WS_SST) + ((size_t)(sc * 2 + half) * 128 + g) * 64; o[nn] = hlo; o[nn + 32] = hhi; }
        else if (!samp) { f32x2* o = (f32x2*)(p.out + OUT_ST) + ((size_t)(ci * 2 + half) * 128 + g) * 64; o[nn] = hlo; o[nn + 32] = hhi; }
    }
}
__device__ __forceinline__ void ph_ssm_state4(const CP& p, int lane, int wave, const bf16_t* U) {
    const int gw = blockIdx.x * NWAVES + wave, NGW = gridDim.x * NWAVES;
    const int nn = lane & 31, half = lane >> 5;
    const f32x2* A4 = (const f32x2*)(p.ws + WS_A4); const s16x8* BB4 = (const s16x8*)(p.ws + WS_BB4);
    const int r = lane & 31, hh = (r >> 2) & 1, sg = 4 * (r >> 3) + (r & 3);
    int gcur = -1; s16x8 bf4[4][4], bb4[4][4]; f32x2 alo = {0.f, 0.f}, ahi = {0.f, 0.f};
#pragma unroll 1
    for (int it = gw; it < 32 * 128; it += NGW) {
        const int g = it & 127, sc = it >> 7, t0 = MP + sc * 256;
        if (g != gcur) {
#pragma unroll
            for (int j = 0; j < 4; ++j)
#pragma unroll
                for (int q = 0; q < 4; ++q) { bf4[j][q] = BB4[((size_t)(j * 256 + g) * 4 + q) * 64 + lane]; bb4[j][q] = BB4[((size_t)(j * 256 + 128 + g) * 4 + q) * 64 + lane]; }
            const int pidx = (half * 128 + g) * 64; alo = A4[pidx + nn]; ahi = A4[pidx + nn + 32]; gcur = g;
        }
        const bf16_t* ua = U + ((size_t)(t0 >> 8) * 128 + g) * 4096 + (hh ? 255 - 4 * sg : 4 * sg) * 16 + 8 * (lane >> 5);
        const long js = hh ? -16L : 16L;
        s16x8 u[4];
#pragma unroll
        for (int j = 0; j < 4; ++j) u[j] = *(const s16x8*)(ua + j * js);
        f32x2 hlo = {0.f, 0.f}, hhi = {0.f, 0.f};
#pragma unroll 1
        for (int m = 0; m < 4; ++m) {
            f32x16 acc[4]; const s16x8 z8 = {0, 0, 0, 0, 0, 0, 0, 0};
#pragma unroll
            for (int j = 0; j < 4; ++j) { const s16x8 uf = hh ? z8 : u[j], ub = hh ? u[j] : z8;
#pragma unroll
                for (int q = 0; q < 4; ++q) {
                    if (j == 0) acc[q] = __builtin_amdgcn_mfma_f32_32x32x16_bf16(uf, bf4[j][q], (f32x16){0.f}, 0, 0, 0); else acc[q] = __builtin_amdgcn_mfma_f32_32x32x16_bf16(uf, bf4[j][q], acc[q], 0, 0, 0);
                    acc[q] = __builtin_amdgcn_mfma_f32_32x32x16_bf16(ub, bb4[j][q], acc[q], 0, 0, 0); } }
            const long mo = (long)(m + 1 < 4 ? m + 1 : 3) * 64 * js;
#pragma unroll
            for (int j = 0; j < 4; ++j) u[j] = *(const s16x8*)(ua + mo + j * js);
#pragma unroll
            for (int i = 0; i < 16; ++i) {
                float lr = __builtin_fmaf(alo.x, hlo.x, __builtin_fmaf(-alo.y, hlo.y, acc[0][i])); asm volatile("" : "+v"(lr));
                float li = __builtin_fmaf(alo.x, hlo.y, __builtin_fmaf(alo.y, hlo.x, acc[2][i])); asm volatile("" : "+v"(li));
                float hr = __builtin_fmaf(ahi.x, hhi.x, __builtin_fmaf(-ahi.y, hhi.y, acc[1][i])); asm volatile("" : "+v"(hr));
                float hi2 = __builtin_fmaf(ahi.x, hhi.y, __builtin_fmaf(ahi.y, hhi.x, acc[3][i])); asm volatile("" : "+v"(hi2));
                hlo = (f32x2){lr, li}; hhi = (f32x2){hr, hi2};
            }
        }
        f32x2* o = (f32x2*)(p.ws + WS_SST) + ((size_t)(sc * 2 + half) * 128 + g) * 64; o[nn] = hlo; o[nn + 32] = hhi;
    }
}
template <int MODE  >
__device__ __forceinline__ void ph_ssm_scan_np(const CP& p, LAS unsigned char* L, int lane, int wave, const bf16_t* U, bf16_t* Z) {
    const int gw = blockIdx.x * NWAVES + wave, NGW = gridDim.x * NWAVES;
    LAS unsigned char* img = L + RING_OFF + wave * SSM_WAVE_LDS;
    LAS unsigned char* ybuf = img + 2 * SSM_IMG;
    const int nn = lane & 31, half = lane >> 5, ti = lane & 15, cq = lane >> 4;
    const f32x2* ABAR = (const f32x2*)(p.ws + WS_ABAR); const f32x2* SST = (const f32x2*)(p.ws + WS_SST);
    const s16x8* BBAR = (const s16x8*)(p.ws + WS_BBAR); const s16x8* CMAT = (const s16x8*)(p.ws + WS_CMAT);
    constexpr int NITEMS = (MODE == 0 ? 32 : 64) * 128;
#pragma unroll 1
    for (int it = gw; it < NITEMS; it += NGW) {
        const int g = it & 127, ci = it >> 7;
        const bool samp = (MODE == 0) || ci >= 32; const int sc = (MODE == 0) ? ci : ci - 32;
        const int t0 = samp ? MP + sc * 256 : ci * 256;
        const int pidx = (half * 128 + g) * 64;
        const f32x2 alo = ABAR[pidx + nn], ahi = ABAR[pidx + nn + 32];
        s16x8 bfw[4], bbw[4], cfw[4], cbw[4];
#pragma unroll
        for (int q = 0; q < 4; ++q) { bfw[q] = BBAR[((size_t)(0 * 128 + g) * 4 + q) * 64 + lane]; bbw[q] = BBAR[((size_t)(1 * 128 + g) * 4 + q) * 64 + lane]; }
        if (MODE == 1) {
#pragma unroll
            for (int q = 0; q < 4; ++q) { cfw[q] = CMAT[((size_t)(0 * 128 + g) * 4 + q) * 64 + lane]; cbw[q] = CMAT[((size_t)(1 * 128 + g) * 4 + q) * 64 + lane]; }
        }
        f32x2 hlo = {0.f, 0.f}, hhi = {0.f, 0.f};
        if (MODE == 1 && samp) {
            const int bq = sc >> 4, cq2 = sc & 15; const f32x2* A256 = (const f32x2*)(p.ws + WS_A256);
            const f32x2 qlo = A256[pidx + nn], qhi = A256[pidx + nn + 32];
            const float* st = p.state_ssm + ((size_t)(bq * 2 + half) * 128 + g) * 128;
            hlo = (f32x2){st[2 * nn], st[2 * nn + 1]}; hhi = (f32x2){st[2 * nn + 64], st[2 * nn + 65]};
            const int nst = half ? 15 - cq2 : cq2;
            f32x2 s0[15], s1[15];
#pragma unroll
            for (int k = 0; k < 15; ++k) { const int j = half ? 15 - k : k; const size_t o = ((size_t)((bq * 16 + j) * 2 + half) * 128 + g) * 64; s0[k] = SST[o + nn]; s1[k] = SST[o + nn + 32]; }
#pragma unroll
            for (int k = 0; k < 15; ++k) {
                const f32x2 nl = {qlo.x * hlo.x - qlo.y * hlo.y + s0[k].x, qlo.x * hlo.y + qlo.y * hlo.x + s0[k].y};
                const f32x2 nh = {qhi.x * hhi.x - qhi.y * hhi.y + s1[k].x, qhi.x * hhi.y + qhi.y * hhi.x + s1[k].y};
                hlo = (k < nst) ? nl : hlo; hhi = (k < nst) ? nh : hhi;
            }
        }
        const int r = lane & 31, hh = (r >> 2) & 1, si = 4 * (r >> 3) + (r & 3);
        bf16_t* zg = Z + ((size_t)(t0 >> 8) * 128 + g) * 4096;
        const bf16_t* ug = U + ((size_t)(t0 >> 8) * 128 + g) * 4096;
        const bf16_t* ua = ug + (hh ? 255 - si : si) * 16 + 8 * (lane >> 5);
        const long ustep = hh ? -256L : 256L;
        const f32x4 dd4 = *(const f32x4*)(p.ssm_d + 16 * g + 4 * cq);
        const s16x8 z8 = {0, 0, 0, 0, 0, 0, 0, 0};
        s16x8 un = *(const s16x8*)(ua + ustep);
        u32x2 uf4n = {0u, 0u}, ub4n = {0u, 0u};
        f32x16 acc[4];
        { const s16x8 u0 = *(const s16x8*)ua; const s16x8 uf = hh ? z8 : u0, ub = hh ? u0 : z8;
#pragma unroll
          for (int q = 0; q < 4; ++q) { acc[q] = __builtin_amdgcn_mfma_f32_32x32x16_bf16(uf, bfw[q], (f32x16){0.f}, 0, 0, 0); acc[q] = __builtin_amdgcn_mfma_f32_32x32x16_bf16(ub, bbw[q], acc[q], 0, 0, 0); } }
#define SSM_NP_TILE(FIN_) do { \
            const s16x8 uc = un; const u32x2 uf4 = uf4n, ub4 = ub4n; \
            un = *(const s16x8*)(ua + (long)(tau + 2 < 16 ? tau + 2 : 15) * ustep); \
            if (MODE == 1) { const int tn_ = FIN_ ? (tau + 1 < 16 ? tau + 1 : 15) : 8; \
                uf4n = *(const u32x2*)(ug + (16 * tn_ + ti) * 16 + 4 * cq); \
                ub4n = *(const u32x2*)(ug + (255 - 16 * tn_ - ti) * 16 + 4 * cq); } \
_Pragma("unroll") \
            for (int i = 0; i < 16; ++i) { \
                float lr = __builtin_fmaf(alo.x, hlo.x, __builtin_fmaf(-alo.y, hlo.y, acc[0][i])); asm volatile("" : "+v"(lr)); \
                float li = __builtin_fmaf(alo.x, hlo.y, __builtin_fmaf(alo.y, hlo.x, acc[2][i])); asm volatile("" : "+v"(li)); \
                float hr = __builtin_fmaf(ahi.x, hhi.x, __builtin_fmaf(-ahi.y, hhi.y, acc[1][i])); asm volatile("" : "+v"(hr)); \
                float hi2 = __builtin_fmaf(ahi.x, hhi.y, __builtin_fmaf(ahi.y, hhi.x, acc[3][i])); asm volatile("" : "+v"(hi2)); \
                hlo = (f32x2){lr, li}; hhi = (f32x2){hr, hi2}; \
                if (MODE == 1) { u32x2 w; w.x = pk2(lr, li); w.y = pk2(hr, hi2); *(LAS u32x2*)(img + half * SSM_IMG + i * SSM_IMG_ROW + nn * 8) = w; } \
            } \
            if (!FIN_ || tau < 15) { \
                const s16x8 uf = hh ? z8 : uc, ub = hh ? uc : z8; \
_Pragma("unroll") \
                for (int q = 0; q < 4; ++q) { acc[q] = __builtin_amdgcn_mfma_f32_32x32x16_bf16(uf, bfw[q], (f32x16){0.f}, 0, 0, 0); acc[q] = __builtin_amdgcn_mfma_f32_32x32x16_bf16(ub, bbw[q], acc[q], 0, 0, 0); } \
            } \
            if (MODE == 1) { \
                asm volatile("" ::: "memory"); \
                f32x4 y0 = {0.f, 0.f, 0.f, 0.f}, y1 = {0.f, 0.f, 0.f, 0.f}; \
_Pragma("unroll") \
                for (int s = 0; s < 4; ++s) { \
                    const s16x8 b0 = *(const LAS s16x8*)(img + ti * SSM_IMG_ROW + 64 * s + 16 * cq), b1 = *(const LAS s16x8*)(img + SSM_IMG + ti * SSM_IMG_ROW + 64 * s + 16 * cq); \
                    y0 = __builtin_amdgcn_mfma_f32_16x16x32_bf16(cfw[s], b0, y0, 0, 0, 0); y1 = __builtin_amdgcn_mfma_f32_16x16x32_bf16(cbw[s], b1, y1, 0, 0, 0); \
                } \
                asm volatile("s_nop 15\n\ts_nop 7" : "+v"(y0), "+v"(y1) :: "memory"); \
                LAS unsigned char* af = ybuf + tau * 512 + ti * 32 + 8 * cq; LAS unsigned char* ab = ybuf + (15 - tau) * 512 + (15 - ti) * 32 + 8 * cq; \
                if (!FIN_) { \
                    u32x2 w; w.x = pk2(y0[0], y0[1]); w.y = pk2(y0[2], y0[3]); *(LAS u32x2*)af = w; \
                    w.x = pk2(y1[0], y1[1]); w.y = pk2(y1[2], y1[3]); *(LAS u32x2*)ab = w; \
                } else { \
                    const u32x2 sf = *(const LAS u32x2*)af, sb = *(const LAS u32x2*)ab; \
                    const size_t tokf = (size_t)(t0 + 16 * tau + ti), tokb = (size_t)(t0 + 255 - 16 * tau - ti); \
                    f32x4 tf = y0 + (f32x4){__uint_as_float(sf.x << 16), __uint_as_float(sf.x & 0xffff0000u), __uint_as_float(sf.y << 16), __uint_as_float(sf.y & 0xffff0000u)}; \
                    f32x4 tb = y1 + (f32x4){__uint_as_float(sb.x << 16), __uint_as_float(sb.x & 0xffff0000u), __uint_as_float(sb.y << 16), __uint_as_float(sb.y & 0xffff0000u)}; \
                    tf = tf + dd4 * (f32x4){__uint_as_float(uf4.x << 16), __uint_as_float(uf4.x & 0xffff0000u), __uint_as_float(uf4.y << 16), __uint_as_float(uf4.y & 0xffff0000u)}; \
                    tb = tb + dd4 * (f32x4){__uint_as_float(ub4.x << 16), __uint_as_float(ub4.x & 0xffff0000u), __uint_as_float(ub4.y << 16), __uint_as_float(ub4.y & 0xffff0000u)}; \
                    u32x2 w; w.x = pk2(gelu_fast(tf[0]), gelu_fast(tf[1])); w.y = pk2(gelu_fast(tf[2]), gelu_fast(tf[3])); *(u32x2*)(zg + (16 * tau + ti) * 16 + 4 * cq) = w; \
                    w.x = pk2(gelu_fast(tb[0]), gelu_fast(tb[1])); w.y = pk2(gelu_fast(tb[2]), gelu_fast(tb[3])); *(u32x2*)(zg + (255 - 16 * tau - ti) * 16 + 4 * cq) = w; \
                } \
                asm volatile("" ::: "memory"); \
            } \
        } while (0)
#pragma unroll 1
        for (int tau = 0; tau < 8; ++tau) SSM_NP_TILE(false);
#pragma unroll 1
        for (int tau = 8; tau < 16; ++tau) SSM_NP_TILE(true);
#undef SSM_NP_TILE
        if (MODE == 0) { f32x2* o = (f32x2*)(p.ws + WS_SST) + ((size_t)(sc * 2 + half) * 128 + g) * 64; o[nn] = hlo; o[nn + 32] = hhi; }
        else if (!samp) { f32x2* o = (f32x2*)(p.out + OUT_ST) + ((size_t)(ci * 2 + half) * 128 + g) * 64; o[nn] = hlo; o[nn + 32] = hhi; }
    }
}

#ifndef UP_WGM
#define UP_WGM 4
#endif
enum Phase { PH_PRO = 0, PH_XN0, PH_QKV, PH_ATTN, PH_COMBINE, PH_AO, PH_ROW1_0, PH_UP0, PH_DOWN0, PH_ROW2_0, PH_SSMIN, PH_SSMA, PH_SSM, PH_GLU, PH_SO, PH_ROW1_1, PH_UP1, PH_DOWN1, PH_ROW3, PH_N };
__global__ void __launch_bounds__(NWAVES * 64, 2) mk_fwd(Params p_, int ph_lo, int ph_hi, int li) {
    const CP& p = *(const CP*)__builtin_amdgcn_kernarg_segment_ptr();
    extern __shared__ __attribute__((aligned(16))) unsigned char lds[];
    LAS unsigned char* L = (LAS unsigned char*)lds;
    volatile LAS unsigned* MISC = (volatile LAS unsigned*)(L + MISC_OFF);
    const int tid = threadIdx.x, lane = tid & 63, wave = __builtin_amdgcn_readfirstlane(tid >> 6);
    for (int u = tid; u < (LDS_BYTES - LDSCTL_OFF) / 4; u += NWAVES * 64) ((LAS unsigned*)(L + LDSCTL_OFF))[u] = 0u;
    __syncthreads();
    XcdBarrier bar = xcd_barrier_post((unsigned*)(p.ws + WS_CTL) + CW_BAR + li * XCD_BAR_WORDS, MISC + 8);
    unsigned char* ws = p.ws; unsigned char* wb = ws + WS_W;
    bf16_t* A1 = (bf16_t*)(ws + WS_A1); bf16_t* A2 = (bf16_t*)(ws + WS_A2); bf16_t* BIG = (bf16_t*)(ws + WS_BIG);
#define IN(k) (ph_lo <= (k) && (k) < ph_hi)
#define SEAM(k) do { if (IN(k) && IN((k) + 1)) xcd_barrier(bar); } while (0)
    if (IN(PH_PRO)) { ph_prologue(p, L, lane, wave); } SEAM(PH_PRO);
    if (IN(PH_XN0)) { ph_rowop<0>(p, L, tid, lane, wave, 0, nullptr, A1); } SEAM(PH_XN0);
    if (IN(PH_QKV)) { ph_gemm_qkv(p, L, A1, (const bf16_t*)(wb + WO_QKV), lane, wave); } SEAM(PH_QKV);
    if (IN(PH_ATTN)) { ph_attn(p, lds, A1); }
    SEAM(PH_ATTN);
    if (IN(PH_COMBINE)) { ph_combine(p, lane, wave, A1); } SEAM(PH_COMBINE);
    if (IN(PH_AO)) { ph_gemm<0>(L, A1, (const bf16_t*)(wb + WO_AO), D, D, A2, nullptr); } SEAM(PH_AO);
    if (IN(PH_ROW1_0)) { ph_rowop<1>(p, L, tid, lane, wave, 0, A2, A1); } SEAM(PH_ROW1_0);
    if (IN(PH_UP0)) { ph_gemm<1>(L, A1, (const bf16_t*)(wb + WO_W1), DFF, D, BIG, nullptr, UP_WGM); } SEAM(PH_UP0);
    if (IN(PH_DOWN0)) { ph_gemm<0>(L, BIG, (const bf16_t*)(wb + WO_W2), D, DFF, A2, nullptr); } SEAM(PH_DOWN0);
    if (IN(PH_ROW2_0)) { ph_rowop<2>(p, L, tid, lane, wave, 0, A2, A1); } SEAM(PH_ROW2_0);
    if (IN(PH_SSMIN)) { ph_gemm<3>(L, A1, (const bf16_t*)(wb + WO_SI), D, D, A2, nullptr); } SEAM(PH_SSMIN);
    if (IN(PH_SSMA)) { ph_ssm_state4(p, lane, wave, A2); } SEAM(PH_SSMA);
    if (IN(PH_SSM)) { ph_ssm_scan_np<1>(p, L, lane, wave, A2, A1); }
    SEAM(PH_SSM);
    if (IN(PH_GLU)) { ph_gemm<2>(L, A1, (const bf16_t*)(wb + WO_GL), D, D, A2, A1); } SEAM(PH_GLU);
    if (IN(PH_SO)) { ph_gemm<0>(L, A2, (const bf16_t*)(wb + WO_SO), D, D, A1, nullptr); } SEAM(PH_SO);
    if (IN(PH_ROW1_1)) { ph_rowop<1>(p, L, tid, lane, wave, 1, A1, A2); } SEAM(PH_ROW1_1);
    if (IN(PH_UP1)) { ph_gemm<1>(L, A2, (const bf16_t*)(wb + WO_W1 + 32 * MiB), DFF, D, BIG, nullptr, UP_WGM); } SEAM(PH_UP1);
    if (IN(PH_DOWN1)) { ph_gemm<0>(L, BIG, (const bf16_t*)(wb + WO_W2 + 32 * MiB), D, DFF, A1, nullptr); } SEAM(PH_DOWN1);
    if (IN(PH_ROW3)) { ph_rowop<3>(p, L, tid, lane, wave, 1, A1, nullptr); }
#undef IN
#undef SEAM
}

extern "C" void kernel_launch(void* const* d_in, const int* in_sizes, int n_in, void* d_out, int out_size, void* d_ws, size_t ws_size, hipStream_t stream) {
    static int grid = 0;
    if (grid == 0) {
        if (n_in != 30 || out_size != (int)OUT_END || ws_size < WS_END) { fprintf(stderr, "kernel_launch: unexpected shapes: n_in %d out %d ws %zu (need %zu)\n", n_in, out_size, ws_size, (size_t)WS_END); grid = -1; return; }
        int dev = 0, cus = 0;
        if (hipGetDevice(&dev) != hipSuccess || hipDeviceGetAttribute(&cus, hipDeviceAttributeMultiprocessorCount, dev) != hipSuccess) { grid = -1; return; }
        if (hipFuncSetAttribute((const void*)mk_fwd, hipFuncAttributeMaxDynamicSharedMemorySize, LDS_BYTES) != hipSuccess) { fprintf(stderr, "kernel_launch: hipFuncSetAttribute failed\n"); grid = -1; return; }
        int per_cu = 0;
        if (hipOccupancyMaxActiveBlocksPerMultiprocessor(&per_cu, (const void*)mk_fwd, NWAVES * 64, LDS_BYTES) != hipSuccess || per_cu < 1) fprintf(stderr, "kernel_launch: occupancy query reports %d\n", per_cu);
        (void)hipGetLastError();
        grid = cus;
    }
    if (grid < 0) return;
    Params p{};
    const float** pp = (const float**)&p;
    for (int i = 0; i < 30; ++i) pp[i] = (const float*)d_in[i];
    p.out = (float*)d_out; p.ws = (unsigned char*)d_ws;
    unsigned char* ws = p.ws;
    bf16_t* A1 = (bf16_t*)(ws + WS_A1); bf16_t* A2 = (bf16_t*)(ws + WS_A2); bf16_t* BIG = (bf16_t*)(ws + WS_BIG);
    (void)hipMemsetAsync(ws + WS_CTL, 0, 1 * MiB, stream);
    int li = 0;
#if ONE_PER_PHASE
    for (int ph = PH_PRO; ph < PH_N; ++ph) hipLaunchKernelGGL(mk_fwd, dim3(grid), dim3(NWAVES * 64), LDS_BYTES, stream, p, ph, ph + 1, li++);
#else
    hipLaunchKernelGGL(mk_fwd, dim3(grid), dim3(NWAVES * 64), LDS_BYTES, stream, p, (int)PH_PRO, (int)PH_N, li++);
#endif
    const hipError_t le = hipPeekAtLastError();
    if (le != hipSuccess) fprintf(stderr, "kernel_launch: launch failed: %s\n", hipGetErrorName(le));
}
```

```cpp
#include <hip/hip_runtime.h>
#include <hip/hip_bf16.h>
#include <cstdio>
#include <cstdint>

typedef unsigned short bf16_t;
typedef float f32x4 __attribute__((ext_vector_type(4)));
typedef float f32x2 __attribute__((ext_vector_type(2)));
typedef unsigned u32x4 __attribute__((ext_vector_type(4)));
typedef unsigned u32x2 __attribute__((ext_vector_type(2)));

constexpr int D = 2048, MP = 8192, MS = 8192, M = MP + MS, NQKV = 4608, DFF = 8192;
constexpr int LQ = 4096, LKV = 4352, NMOD = 12288;
constexpr int KB_ROWS = MP + 2 * LKV;
constexpr int KVW = 1280;
constexpr int OW = 3072;
constexpr float EPS = 1e-6f;
constexpr int KCH = 16;

constexpr size_t OUT_Y = 0, OUT_AK = 33554432, OUT_AV = 35651584, OUT_BK = 37748736, OUT_BV = 46137344, OUT_ST = 54525952, OUT_END = 55574528;

constexpr size_t MiB = 1u << 20;
constexpr size_t WS_CTL = 0, WS_MODP = 1 * MiB, WS_MOD = 6 * MiB, WS_ABAR = 7 * MiB, WS_A256 = 7 * MiB + 512 * 1024, WS_BBAR = 8 * MiB, WS_CMAT = 9 * MiB,
                 WS_ROPE = 10 * MiB, WS_SST = 12 * MiB, WS_HIN = 16 * MiB, WS_W = 20 * MiB, WS_A1 = 200 * MiB, WS_A2 = 264 * MiB, WS_BIG = 328 * MiB,
                 WS_QH = 584 * MiB, WS_KB = 648 * MiB, WS_VB = 690 * MiB, WS_END = 732 * MiB;
constexpr size_t WS_BB4 = 16 * MiB, WS_A4 = 7 * MiB + 768 * 1024;
constexpr size_t WS_O = WS_BIG + 144 * MiB;

struct Params {
    const float *x_prompt, *x_sample, *c, *cache_a_k, *cache_a_v, *cache_b_k, *cache_b_v, *state_ssm, *c_ctx, *ada_w, *ada_b, *norm_g, *mlp_w1, *mlp_w2,
        *attn_w_in, *attn_w_out, *qk_norm, *diff_lambda, *diff_subln, *ssm_w_in, *ssm_a_re, *ssm_a_im, *ssm_log_dt, *ssm_b_re, *ssm_b_im, *ssm_c_re, *ssm_c_im,
        *ssm_d, *ssm_glu_w, *ssm_w_out;
    float* out; unsigned char* ws;
};

__device__ __forceinline__ float bf2f(bf16_t v) { return __uint_as_float((unsigned)v << 16); }
__device__ __forceinline__ unsigned f2bf(float f) { unsigned u = __float_as_uint(f); return (u + 0x7fffu + ((u >> 16) & 1u)) >> 16; }
__device__ __forceinline__ unsigned pk2(float lo, float hi) { unsigned r; asm("v_cvt_pk_bf16_f32 %0, %1, %2" : "=v"(r) : "v"(lo), "v"(hi)); return r; }
__device__ __forceinline__ float wave_sum(float v) {
#pragma unroll
    for (int o = 1; o < 64; o <<= 1) v += __shfl_xor(v, o);
    return v;
}
__device__ __forceinline__ int row_class(int m) { return m < MP ? 0 : 1 + ((m - MP) >> 12); }
template <class P> __device__ __forceinline__ const float* x_row(const P& p, int m) { return m < MP ? p.x_prompt + (size_t)m * D : p.x_sample + (size_t)(m - MP) * D; }

typedef const __attribute__((address_space(4))) Params CP;

namespace pg8 {
#define PG8_LAS __attribute__((address_space(3)))
typedef unsigned short bf16_t;
typedef short bf16x8 __attribute__((ext_vector_type(8)));
typedef float f32x4 __attribute__((ext_vector_type(4)));
typedef unsigned u32x4 __attribute__((ext_vector_type(4)));
constexpr int BM = 256, BK = 64, HALF = 128, HTB = HALF * BK * 2  , STAGE_BYTES = 8 * HTB, NXCD = 8, WGM = 4;

__host__ __device__ __forceinline__ int lds_byte(int r, int c) { const int st = (r >> 4) * 2 + (c >> 5), rr = r & 15, cc = c & 31, ob = rr * 64 + cc * 2; return st * 1024 + (ob ^ (((ob >> 9) & 1) << 5)); }
__host__ __device__ __forceinline__ void stage_rc(int b, int& R, int& C) { const int st = b / 1024, sb = b % 1024, swz = sb ^ (((sb >> 9) & 1) << 5); R = (st >> 1) * 16 + swz / 64; C = (st & 1) * 32 + (swz % 64) / 2; }
__host__ __device__ __forceinline__ int perm32(int rho) { const int n = rho >> 4, i = rho & 15; return 8 * (i >> 2) + 4 * n + (i & 3); }

struct Unit { int pm, pn; };
struct Gemm { const bf16_t* A; const bf16_t* Bt; int M, N, K; };

struct StaticOrder {
    int nM, nN, nwg, G, c, wgm;
    __host__ __device__ void init(int M, int N, int G_, int c_, int wgm_ = WGM) { nM = M / BM; nN = N / BM; nwg = nM * nN; G = G_; c = c_; wgm = wgm_; }
    __host__ __device__ bool next(int i, Unit& u) const {
        const long L = (long)i * G + c; if (L >= nwg) return false;
        int wgid = (int)L; { const int q = nwg / NXCD, r = nwg % NXCD, xcd = wgid % NXCD, off = wgid / NXCD; wgid = (xcd < r ? xcd * (q + 1) : r * (q + 1) + (xcd - r) * q) + off; }
        const int nig = wgm * nN, gid = wgid / nig, fm = gid * wgm, gsz = (nM - fm) < wgm ? (nM - fm) : wgm;
        u.pm = fm + ((wgid % nig) % gsz); u.pn = (wgid % nig) / gsz; return true;
    }
    __device__ __forceinline__ void a_ready(const Unit&) const {}
    __device__ __forceinline__ void done(const Unit&) const {}
};

__device__ __forceinline__ unsigned cvt_pk_bf16(float lo, float hi) { unsigned r; asm volatile("v_cvt_pk_bf16_f32 %0, %1, %2" : "=v"(r) : "v"(lo), "v"(hi)); return r; }
typedef float f32x2 __attribute__((ext_vector_type(2)));
template <class Epi, class Sched, bool ALIGN_EPI = false, bool SP2 = false>
__device__ __forceinline__ void gemm_phase(PG8_LAS unsigned char* lds, const Gemm g, const Sched& S, const Epi& E) {
    const int tid = threadIdx.x, wid = __builtin_amdgcn_readfirstlane(tid >> 6), lane = tid & 63, wr = wid >> 2, wc = wid & 3, fr = lane & 15, fq = lane >> 4;
    const int K = g.K, nt = K / BK;
    unsigned voffA[2], voffB[2];
#pragma unroll
    for (int i = 0; i < 2; ++i) { int R, C; stage_rc(tid * 16 + i * 8192, R, C); const int Rb = Epi::PERM ? ((R & ~31) + perm32(R & 31)) : R;
        voffA[i] = Epi::ASCAN ? (unsigned)(((C >> 4) * 256 + R) * 16 + (C & 15)) * 2u : (unsigned)(R * K + C) * 2u; voffB[i] = (unsigned)(Rb * K + C) * 2u; }
    const size_t kstep = (size_t)(BK * 2);
    const size_t hstep = (size_t)HALF * K * 2;
    const size_t tstep = 2 * hstep;
    const size_t kstepA = Epi::ASCAN ? (size_t)32768 : kstep, hstepA = Epi::ASCAN ? (size_t)4096 : hstep;
    const unsigned ldsw = (unsigned)wid * 1024u;
    const int aoff = lds_byte(wr * 64 + fr, fq * 8), boff = lds_byte(wc * 32 + fr, fq * 8);
#define PG8_SA(b, h) (((b) * 2 + (h)) * HTB)
#define PG8_SB(b, h) ((4 + (b) * 2 + (h)) * HTB)
#define PG8_STAGE(bufoff, gbase, voff) do { _Pragma("unroll") for (int _i = 0; _i < 2; ++_i) \
        __builtin_amdgcn_global_load_lds((const unsigned*)((const char*)(gbase) + (voff)[_i]), (PG8_LAS unsigned*)(lds + (bufoff) + ldsw + _i * 8192), 16, 0, 0); } while (0)
#define PG8_LDA(dst, b, h) do { _Pragma("unroll") for (int m = 0; m < 4; ++m) _Pragma("unroll") for (int k = 0; k < 2; ++k) dst[m][k] = *(const PG8_LAS bf16x8*)(lds + PG8_SA(b, h) + aoff + m * 2048 + k * 1024); } while (0)
#define PG8_LDB(dst, b, h) do { _Pragma("unroll") for (int n = 0; n < 2; ++n) _Pragma("unroll") for (int k = 0; k < 2; ++k) dst[n][k] = *(const PG8_LAS bf16x8*)(lds + PG8_SB(b, h) + boff + n * 2048 + k * 1024); } while (0)
#define PG8_MMA(ai, bj, At, Bt) do { __builtin_amdgcn_s_setprio(1); _Pragma("unroll") for (int m = 0; m < 4; ++m) _Pragma("unroll") for (int n = 0; n < 2; ++n) _Pragma("unroll") for (int k = 0; k < 2; ++k) \
        acc[ai][bj][m][n] = __builtin_amdgcn_mfma_f32_16x16x32_bf16(Bt[n][k], At[m][k], acc[ai][bj][m][n], 0, 0, 0); __builtin_amdgcn_s_setprio(0); } while (0)
#define PG8_WAIT_V(n) asm volatile("s_waitcnt vmcnt(" #n ")" ::: "memory")
#define PG8_WAIT_L(n) asm volatile("s_waitcnt lgkmcnt(" #n ")" ::: "memory")
#define PG8_BAR __builtin_amdgcn_s_barrier()
#define PG8_SCHED __builtin_amdgcn_sched_barrier(0)
    Unit cur, nxt; int ui = 0;
    if (!S.next(0, cur)) return;
    f32x4 acc[2][2][4][2];
#pragma unroll
    for (int a = 0; a < 2; ++a)
#pragma unroll
        for (int b = 0; b < 2; ++b)
#pragma unroll
            for (int m = 0; m < 4; ++m)
#pragma unroll
                for (int n = 0; n < 2; ++n) acc[a][b][m][n] = (f32x4){0.f, 0.f, 0.f, 0.f};
    bf16x8 At[4][2], B0[2][2], B1[2][2];
    const char* cA = (const char*)g.A + (size_t)cur.pm * tstep; const char* cB = (const char*)g.Bt + (size_t)cur.pn * tstep;
    S.a_ready(cur);
    if constexpr (SP2) {
        PG8_STAGE(PG8_SB(0, 0), cB, voffB); PG8_STAGE(PG8_SB(0, 1), cB + hstep, voffB); PG8_STAGE(PG8_SA(0, 0), cA, voffA); PG8_STAGE(PG8_SA(0, 1), cA + hstepA, voffA);
        if (wr == 1) PG8_BAR;
        PG8_WAIT_V(2); PG8_BAR;
        PG8_STAGE(PG8_SB(1, 0), cB + kstep, voffB); PG8_STAGE(PG8_SA(1, 0), cA + kstepA, voffA); PG8_STAGE(PG8_SB(1, 1), cB + hstep + kstep, voffB);
        PG8_WAIT_V(6); PG8_BAR;
    } else {
        PG8_STAGE(PG8_SB(0, 0), cB, voffB); PG8_STAGE(PG8_SA(0, 0), cA, voffA); PG8_STAGE(PG8_SB(0, 1), cB + hstep, voffB); PG8_STAGE(PG8_SA(0, 1), cA + hstepA, voffA);
        if (wr == 1) PG8_BAR;
        PG8_WAIT_V(4); PG8_BAR;
        PG8_STAGE(PG8_SB(1, 0), cB + kstep, voffB); PG8_STAGE(PG8_SA(1, 0), cA + kstepA, voffA); PG8_STAGE(PG8_SB(1, 1), cB + hstep + kstep, voffB);
        PG8_WAIT_V(6); PG8_BAR;
    }
    for (;;) {
        const bool has_next = S.next(ui + 1, nxt);
        const char* nA = has_next ? (const char*)g.A + (size_t)nxt.pm * tstep : cA; const char* nB = has_next ? (const char*)g.Bt + (size_t)nxt.pn * tstep : cB;
        for (int t = 0; t < nt; t += 2) {
            const bool last = (t == nt - 2);
            const char* a1 = cA + (size_t)(t + 1) * kstepA;
            const char* a2 = last ? nA : cA + (size_t)(t + 2) * kstepA; const char* b2 = last ? nB : cB + (size_t)(t + 2) * kstep;
            const char* a3 = a2 + kstepA; const char* b3 = b2 + kstep;
            if (last && has_next) S.a_ready(nxt);
            if constexpr (SP2) {
            PG8_LDB(B0, 0, 0); PG8_LDB(B1, 0, 1); PG8_SCHED; PG8_LDA(At, 0, 0); PG8_STAGE(PG8_SA(1, 1), a1 + hstepA, voffA);
            PG8_WAIT_V(8); PG8_WAIT_L(0); PG8_BAR; PG8_MMA(0, 0, At, B0); PG8_MMA(0, 1, At, B1); PG8_BAR; PG8_SCHED;
            PG8_LDA(At, 0, 1); PG8_STAGE(PG8_SB(0, 0), b2, voffB); PG8_STAGE(PG8_SB(0, 1), b2 + hstep, voffB); PG8_STAGE(PG8_SA(0, 0), a2, voffA);
            PG8_WAIT_V(8); PG8_WAIT_L(0); PG8_BAR; PG8_MMA(1, 0, At, B0); PG8_MMA(1, 1, At, B1); PG8_BAR; PG8_SCHED;
            PG8_LDB(B0, 1, 0); PG8_LDB(B1, 1, 1); PG8_SCHED; PG8_LDA(At, 1, 0); PG8_STAGE(PG8_SA(0, 1), a2 + hstepA, voffA);
            PG8_WAIT_V(8); PG8_WAIT_L(0); PG8_BAR; PG8_MMA(0, 0, At, B0); PG8_MMA(0, 1, At, B1); PG8_BAR; PG8_SCHED;
            PG8_LDA(At, 1, 1); PG8_STAGE(PG8_SB(1, 0), b3, voffB); PG8_STAGE(PG8_SB(1, 1), b3 + hstep, voffB); PG8_STAGE(PG8_SA(1, 0), a3, voffA);
            PG8_WAIT_V(8); PG8_WAIT_L(0); PG8_BAR; PG8_MMA(1, 0, At, B0); PG8_MMA(1, 1, At, B1); PG8_BAR; PG8_SCHED;
            } else {
            PG8_LDB(B0, 0, 0); PG8_SCHED; PG8_LDA(At, 0, 0); PG8_STAGE(PG8_SA(1, 1), a1 + hstepA, voffA);
            PG8_WAIT_L(8); PG8_BAR; PG8_WAIT_L(0); PG8_MMA(0, 0, At, B0); PG8_BAR; PG8_SCHED;
            PG8_LDB(B1, 0, 1); PG8_STAGE(PG8_SB(0, 0), b2, voffB);
            PG8_BAR; PG8_WAIT_L(0); PG8_MMA(0, 1, At, B1); PG8_BAR;
            PG8_LDA(At, 0, 1); PG8_STAGE(PG8_SA(0, 0), a2, voffA);
            PG8_BAR; PG8_WAIT_L(0); PG8_MMA(1, 0, At, B0); PG8_BAR; PG8_SCHED;
            PG8_STAGE(PG8_SB(0, 1), b2 + hstep, voffB);
            PG8_WAIT_V(6); PG8_BAR; PG8_MMA(1, 1, At, B1); PG8_BAR;
            PG8_LDB(B0, 1, 0); PG8_SCHED; PG8_LDA(At, 1, 0); PG8_STAGE(PG8_SA(0, 1), a2 + hstepA, voffA);
            PG8_WAIT_L(8); PG8_BAR; PG8_WAIT_L(0); PG8_MMA(0, 0, At, B0); PG8_BAR; PG8_SCHED;
            PG8_LDB(B1, 1, 1); PG8_STAGE(PG8_SB(1, 0), b3, voffB);
            PG8_BAR; PG8_WAIT_L(0); PG8_MMA(0, 1, At, B1); PG8_BAR;
            PG8_LDA(At, 1, 1); PG8_STAGE(PG8_SA(1, 0), a3, voffA);
            PG8_BAR; PG8_WAIT_L(0); PG8_MMA(1, 0, At, B0); PG8_BAR; PG8_SCHED;
            PG8_STAGE(PG8_SB(1, 1), b3 + hstep, voffB);
            PG8_WAIT_V(6); PG8_BAR; PG8_MMA(1, 1, At, B1); PG8_BAR;
            }
        }
        if constexpr (ALIGN_EPI) { if (wr == 0) PG8_BAR; }
        if constexpr (!Epi::AFTER_DRAIN) { E(acc, cur, wr, wc, fr, fq); S.done(cur); }
        if (!has_next) break;
#pragma unroll
        for (int a = 0; a < 2; ++a)
#pragma unroll
            for (int b = 0; b < 2; ++b)
#pragma unroll
                for (int m = 0; m < 4; ++m)
#pragma unroll
                    for (int n = 0; n < 2; ++n) acc[a][b][m][n] = (f32x4){0.f, 0.f, 0.f, 0.f};
        cur = nxt; cA = nA; cB = nB; ++ui;
        if constexpr (ALIGN_EPI) { if (wr == 1) PG8_BAR; }
    }
    PG8_WAIT_V(0);
    if constexpr (!ALIGN_EPI) { if (wr == 0) PG8_BAR; }
    PG8_BAR;
    if constexpr (Epi::AFTER_DRAIN) { E.fused(acc, cur, wr, wc, fr, fq, lds, wid, lane); S.done(cur); }
#undef PG8_SA
#undef PG8_SB
#undef PG8_STAGE
#undef PG8_LDA
#undef PG8_LDB
#undef PG8_MMA
#undef PG8_WAIT_V
#undef PG8_WAIT_L
#undef PG8_BAR
#undef PG8_SCHED
}
}
namespace att {
using bf16 = __hip_bfloat16;
constexpr int D = 128, NW = 8, QBLK = 32, KVBLK = 64; constexpr float SCALE = 0.088388347648318440f; constexpr float THR = 8.f; constexpr int SDEPTH = 2;
constexpr int LDQ = 2048, LDK = 1280, LDO = 3072;
constexpr size_t SHM_V = KVBLK * D * 2, SHM_K = KVBLK * D * 2, SHM_ATTN = 2 * SHM_V + 2 * SHM_K + NW * 64 * 4;
using bf16x8 = __attribute__((ext_vector_type(8))) short;
using s16x4  = __attribute__((ext_vector_type(4))) short;
using f32x16 = __attribute__((ext_vector_type(16))) float;
using f32x8  = __attribute__((ext_vector_type(8))) float;
using u32x4  = __attribute__((ext_vector_type(4))) unsigned;
#define KSWZ(row, colB) ((row) * 256 + ((colB) ^ (((row) & 7) << 4)))
#define SBAR() __builtin_amdgcn_sched_barrier(0)
__device__ __forceinline__ int crow(int r, int hi) { return (r & 3) + 8 * (r >> 2) + 4 * hi; }
__device__ __forceinline__ unsigned cvtpk(float lo, float hi) {
  unsigned r; asm volatile("v_cvt_pk_bf16_f32 %0, %1, %2" : "=v"(r) : "v"(lo), "v"(hi)); return r;
}
template <typename TIn> struct Stage;
template <> struct Stage<bf16>  { using T = bf16x8;
  __device__ static __forceinline__ T ld8(const bf16* p) { return *reinterpret_cast<const bf16x8*>(p); }
  __device__ static __forceinline__ bf16x8 tobf(T x) { return x; } };
template <> struct Stage<float> { using T = f32x8;
  __device__ static __forceinline__ T ld8(const float* p) { return *reinterpret_cast<const f32x8*>(p); }
  __device__ static __forceinline__ bf16x8 tobf(T x) {
    u32x4 w = {cvtpk(x[0], x[1]), cvtpk(x[2], x[3]), cvtpk(x[4], x[5]), cvtpk(x[6], x[7])}; return *reinterpret_cast<bf16x8*>(&w); } };

__device__ __forceinline__ void partialSM(f32x16& p0, f32x16& p1, float& m_reg, float& mn, float& alpha) {
  constexpr float C = SCALE * 1.4426950408889634f;
  float pmax = p0[0]; for (int r = 1; r < 16; ++r) pmax = fmaxf(pmax, p0[r]); for (int r = 0; r < 16; ++r) pmax = fmaxf(pmax, p1[r]);
  { auto rr = __builtin_amdgcn_permlane32_swap(__float_as_uint(pmax), __float_as_uint(pmax), false, false);
    pmax = fmaxf(__uint_as_float(rr[0]), __uint_as_float(rr[1])); }
  if (__builtin_expect(__all(pmax - m_reg <= THR / SCALE), 1)) { mn = m_reg; alpha = 1.f; }
  else { mn = fmaxf(m_reg, pmax); alpha = __builtin_amdgcn_exp2f((m_reg - mn) * C); m_reg = mn; }
  float mnC = -mn * C;
  for (int r = 0; r < 16; ++r) p0[r] = fmaf(p0[r], C, mnC); for (int r = 0; r < 16; ++r) p1[r] = fmaf(p1[r], C, mnC);
  for (int r = 0; r < 16; ++r) p0[r] = __builtin_amdgcn_exp2f(p0[r]);
}
__device__ __forceinline__ void partialSMf(f32x16& p0, f32x16& p1, float& m_reg, float& alpha, bool first) {
  constexpr float THR2 = THR * 1.4426950408889634f;
  float pmax = p0[0]; for (int r = 1; r < 16; ++r) pmax = fmaxf(pmax, p0[r]); for (int r = 0; r < 16; ++r) pmax = fmaxf(pmax, p1[r]);
  { auto rr = __builtin_amdgcn_permlane32_swap(__float_as_uint(pmax), __float_as_uint(pmax), false, false);
    pmax = fmaxf(__uint_as_float(rr[0]), __uint_as_float(rr[1])); }
  alpha = 1.f;
  if (first || !__all(pmax <= THR2)) {
    const float mnew = first ? m_reg + pmax : fmaxf(m_reg, m_reg + pmax);
    const float mt = __uint_as_float(cvtpk(mnew, mnew) << 16);
    const float delta = mt - m_reg; m_reg = mt;
    if (!first) alpha = __builtin_amdgcn_exp2f(-delta);
    for (int r = 0; r < 16; ++r) p0[r] -= delta; for (int r = 0; r < 16; ++r) p1[r] -= delta;
  }
  for (int r = 0; r < 16; ++r) p0[r] = __builtin_amdgcn_exp2f(p0[r]);
}
__device__ __forceinline__ void finishSM(f32x16& p0, f32x16& p1, float alpha, float& l_reg, bf16x8& pa0, bf16x8& pa1, bf16x8& pa2, bf16x8& pa3) {
  for (int r = 0; r < 16; ++r) p1[r] = __builtin_amdgcn_exp2f(p1[r]);
  float ps = 0; for (int r = 0; r < 16; ++r) ps += p0[r]; for (int r = 0; r < 16; ++r) ps += p1[r];
  { auto rr = __builtin_amdgcn_permlane32_swap(__float_as_uint(ps), __float_as_uint(ps), false, false);
    ps = __uint_as_float(rr[0]) + __uint_as_float(rr[1]); }
  l_reg = l_reg * alpha + ps;
#define PK4(P, BASE, OUT) do { unsigned a0 = cvtpk(P[BASE + 0], P[BASE + 1]), a1 = cvtpk(P[BASE + 2], P[BASE + 3]);   \
    unsigned b0 = cvtpk(P[BASE + 4], P[BASE + 5]), b1 = cvtpk(P[BASE + 6], P[BASE + 7]);                              \
    auto r0 = __builtin_amdgcn_permlane32_swap(a0, b0, false, false); auto r1 = __builtin_amdgcn_permlane32_swap(a1, b1, false, false); \
    u32x4 w = {r0[0], r1[0], r0[1], r1[1]}; OUT = *reinterpret_cast<bf16x8*>(&w); } while (0)
  PK4(p0, 0, pa0); PK4(p0, 8, pa1); PK4(p1, 0, pa2); PK4(p1, 8, pa3);
#undef PK4
}
__device__ __forceinline__ void qkt(f32x16& p0, f32x16& p1, const bf16* Ks, const bf16x8* qr, int r32, int hi) {
  p0 = f32x16{}; p1 = f32x16{};
  for (int d0 = 0; d0 < 8; ++d0) { int cb = (d0 * 16 + hi * 8) * 2;
    bf16x8 b0 = *reinterpret_cast<const bf16x8*>((const char*)Ks + KSWZ(r32, cb));
    bf16x8 b1 = *reinterpret_cast<const bf16x8*>((const char*)Ks + KSWZ(32 + r32, cb));
    p0 = __builtin_amdgcn_mfma_f32_32x32x16_bf16(b0, qr[d0], p0, 0, 0, 0);
    p1 = __builtin_amdgcn_mfma_f32_32x32x16_bf16(b1, qr[d0], p1, 0, 0, 0); }
}
__device__ __forceinline__ int v_st(int k, int c) { const int kk = (k & ~0xC) | ((k & 4) << 1) | ((k & 8) >> 1); return ((kk >> 3) * 4 + (c >> 5)) * 512 + ((kk & 7) * 32 + (c & 31)) * 2; }
__device__ __forceinline__ int v_rd_base(int lane) { return ((lane & 3) << 3) | (((lane >> 2) & 3) << 6) | (((lane >> 4) & 1) << 5) | (((lane >> 5) & 1) << 8); }
constexpr int v_rd_off(int d0, int ks, int half) { return d0 * 512 + ks * 4096 + half * 2048; }
template <int OFF> __device__ __forceinline__ s16x4 tr_read(int vb) {
  s16x4 r; asm volatile("ds_read_b64_tr_b16 %0, %1 offset:%2" : "=&v"(r) : "v"(vb), "i"(OFF) : "memory"); return r;
}
template <int D0> __device__ __forceinline__ void pv_one(f32x16& od, int vb, bf16x8 pa0, bf16x8 pa1, bf16x8 pa2, bf16x8 pa3) {
  const s16x4 l0 = tr_read<v_rd_off(D0, 0, 0)>(vb), h0 = tr_read<v_rd_off(D0, 0, 1)>(vb), l1 = tr_read<v_rd_off(D0, 1, 0)>(vb), h1 = tr_read<v_rd_off(D0, 1, 1)>(vb);
  const s16x4 l2 = tr_read<v_rd_off(D0, 2, 0)>(vb), h2 = tr_read<v_rd_off(D0, 2, 1)>(vb), l3 = tr_read<v_rd_off(D0, 3, 0)>(vb), h3 = tr_read<v_rd_off(D0, 3, 1)>(vb);
  asm volatile("s_waitcnt lgkmcnt(0)" ::: "memory"); SBAR();
#define PK(L, H) (bf16x8){L[0], L[1], L[2], L[3], H[0], H[1], H[2], H[3]}
  od = __builtin_amdgcn_mfma_f32_32x32x16_bf16(pa0, PK(l0, h0), od, 0, 0, 0);
  od = __builtin_amdgcn_mfma_f32_32x32x16_bf16(pa1, PK(l1, h1), od, 0, 0, 0);
  od = __builtin_amdgcn_mfma_f32_32x32x16_bf16(pa2, PK(l2, h2), od, 0, 0, 0);
  od = __builtin_amdgcn_mfma_f32_32x32x16_bf16(pa3, PK(l3, h3), od, 0, 0, 0);
#undef PK
}
__device__ __forceinline__ void pv_d0(f32x16* o, int vb, bf16x8 pa0, bf16x8 pa1, bf16x8 pa2, bf16x8 pa3) {
  pv_one<0>(o[0], vb, pa0, pa1, pa2, pa3); pv_one<1>(o[1], vb, pa0, pa1, pa2, pa3); pv_one<2>(o[2], vb, pa0, pa1, pa2, pa3); pv_one<3>(o[3], vb, pa0, pa1, pa2, pa3);
}

template <typename TQ>
__device__ __forceinline__ void attn_dense_body(const TQ* __restrict__ Qb, const bf16* __restrict__ Kh, const bf16* __restrict__ Vh,
                                                unsigned short* __restrict__ Ob, int ldo, int seq, char* lds) {
  using St = Stage<bf16>; using SQ = Stage<TQ>;
  const int tid = threadIdx.x, wid = tid >> 6, lane = tid & 63, r32 = lane & 31, hi = lane >> 5;
  bf16* V_lds = (bf16*)lds; bf16* K_lds = (bf16*)(lds + 2 * SHM_V);
  float* ws = (float*)(lds + 2 * SHM_V + 2 * SHM_K) + wid * 64; float* li_l = ws; float* al_l = ws + 32;
  float m_reg = -1e30f, l_reg = 0; f32x16 o[4] = {}; bf16x8 qr[8];
  const TQ* Qw = Qb + (long)(wid * QBLK + r32) * LDQ + hi * 8;
#pragma unroll
  for (int d0 = 0; d0 < 8; ++d0) qr[d0] = SQ::tobf(SQ::ld8(Qw + d0 * 16));
  const int sr = tid >> 4, sc = (tid & 15) * 8, vst0 = v_st(sr, sc), vst1 = v_st(32 + sr, sc);
  const int vb0 = (int)(uintptr_t)V_lds + v_rd_base(lane);
  struct { typename St::T vs0, vs1, ks0, ks1; } sr_[SDEPTH];
#define SLOAD(i, k0) do { sr_[i].vs0 = St::ld8(&Vh[(long)((k0) + sr) * LDK + sc]); sr_[i].vs1 = St::ld8(&Vh[(long)((k0) + 32 + sr) * LDK + sc]); \
    sr_[i].ks0 = St::ld8(&Kh[(long)((k0) + sr) * LDK + sc]); sr_[i].ks1 = St::ld8(&Kh[(long)((k0) + 32 + sr) * LDK + sc]); } while (0)
#define SWRITE(b, i) do { *(bf16x8*)((char*)V_lds + (b) * SHM_V + vst0) = St::tobf(sr_[i].vs0);          \
    *(bf16x8*)((char*)V_lds + (b) * SHM_V + vst1) = St::tobf(sr_[i].vs1); int kc = sc * 2;               \
    *(bf16x8*)((char*)K_lds + (b) * SHM_K + KSWZ(sr, kc)) = St::tobf(sr_[i].ks0);                       \
    *(bf16x8*)((char*)K_lds + (b) * SHM_K + KSWZ(32 + sr, kc)) = St::tobf(sr_[i].ks1); } while (0)
#define SWAIT() do { if constexpr (SDEPTH == 2) asm volatile("s_waitcnt vmcnt(4)" ::: "memory"); else asm volatile("s_waitcnt vmcnt(0)" ::: "memory"); } while (0)
#define RESC(a) do { if (__any((a) < 1.f)) { if (hi == 0) al_l[r32] = (a); asm volatile("s_waitcnt lgkmcnt(0)" ::: "memory"); \
    for (int d = 0; d < 4; ++d) for (int r = 0; r < 16; ++r) o[d][r] *= al_l[crow(r, hi)]; } } while (0)
  f32x16 pA0, pA1, pB0, pB1; float mnA, mnB, alA, alB; bf16x8 pa0, pa1, pa2, pa3; const int NT = seq / KVBLK;
  constexpr int SE = 0, SO = SDEPTH - 1;
  SLOAD(SE, 0); asm volatile("s_waitcnt vmcnt(0)" ::: "memory"); SWRITE(0, SE); __syncthreads();
  qkt(pA0, pA1, K_lds, qr, r32, hi); partialSM(pA0, pA1, m_reg, mnA, alA);
  SLOAD(SO, KVBLK); if constexpr (SDEPTH == 2) { if (2 < NT) SLOAD(SE, 2 * KVBLK); }
  SWAIT(); SWRITE(1, SO); __syncthreads();
  for (int j = 1; j + 1 < NT; j += 2) {
    SBAR(); qkt(pB0, pB1, (bf16*)((char*)K_lds + SHM_K), qr, r32, hi);
    finishSM(pA0, pA1, alA, l_reg, pa0, pa1, pa2, pa3); SBAR();
    SLOAD(SO, (j + SDEPTH) * KVBLK); SBAR();
    pv_d0(o, vb0, pa0, pa1, pa2, pa3); partialSM(pB0, pB1, m_reg, mnB, alB);
    __syncthreads(); SWAIT(); SWRITE(0, SE);
    RESC(alB); __syncthreads();
    SBAR(); qkt(pA0, pA1, K_lds, qr, r32, hi);
    finishSM(pB0, pB1, alB, l_reg, pa0, pa1, pa2, pa3); SBAR();
    if (SDEPTH == 1 || j + 3 < NT) SLOAD(SE, (j + 1 + SDEPTH) * KVBLK); SBAR();
    pv_d0(o, vb0 + (int)SHM_V, pa0, pa1, pa2, pa3); partialSM(pA0, pA1, m_reg, mnA, alA);
    __syncthreads(); SWAIT(); SWRITE(1, SO);
    RESC(alA); __syncthreads();
  }
  SBAR(); qkt(pB0, pB1, (bf16*)((char*)K_lds + SHM_K), qr, r32, hi);
  finishSM(pA0, pA1, alA, l_reg, pa0, pa1, pa2, pa3); SBAR();
  pv_d0(o, vb0, pa0, pa1, pa2, pa3); partialSM(pB0, pB1, m_reg, mnB, alB);
  __syncthreads(); RESC(alB);
  finishSM(pB0, pB1, alB, l_reg, pa0, pa1, pa2, pa3); SBAR();
  pv_d0(o, vb0 + (int)SHM_V, pa0, pa1, pa2, pa3);
  if (hi == 0) li_l[r32] = l_reg; asm volatile("s_waitcnt lgkmcnt(0)" ::: "memory");
  float rli[16];
#pragma unroll
  for (int r = 0; r < 16; ++r) rli[r] = __builtin_amdgcn_rcpf(li_l[crow(r, hi)]);
  unsigned short* Ow = Ob + (long)(wid * QBLK) * ldo;
#pragma unroll
  for (int r = 0; r < 16; ++r) { int orow = crow(r, hi);
    for (int d0 = 0; d0 < 4; ++d0) Ow[(long)orow * ldo + d0 * 32 + r32] = (unsigned short)f2bf(o[d0][r] * rli[r]); }
#undef SLOAD
#undef SWRITE
#undef SWAIT
#undef RESC
}

template <int NB>
__device__ __forceinline__ void store_o_rows(const f32x16* o, const float* li_l, unsigned short* __restrict__ Ow, int ldo, char* lds, int wid, int lane, int r32, int hi) {
  constexpr int RS = NB * 64, LPR = RS / 16, RPI = 64 / LPR;
  char* st = lds + wid * (32 * RS);
#pragma unroll
  for (int r = 0; r < 16; ++r) { const int orow = crow(r, hi); const float rl = __builtin_amdgcn_rcpf(li_l[orow]);
#pragma unroll
    for (int d0 = 0; d0 < NB; ++d0) { const float v = o[d0][r] * rl; *reinterpret_cast<unsigned short*>(st + orow * RS + (d0 * 32 + r32) * 2) = (unsigned short)cvtpk(v, v); } }
  asm volatile("s_waitcnt lgkmcnt(0)" ::: "memory");
  const int rr = lane / LPR, cb = (lane % LPR) * 16;
#pragma unroll
  for (int i = 0; i < 32 / RPI; ++i) { const int row = i * RPI + rr;
    const u32x4 v = *reinterpret_cast<const u32x4*>(st + row * RS + cb);
    *reinterpret_cast<u32x4*>(reinterpret_cast<char*>(Ow + (long)row * ldo) + cb) = v; }
}
__device__ __forceinline__ void attn_small_body(const bf16* __restrict__ Qb, const bf16* __restrict__ Kh, const bf16* __restrict__ Vh, unsigned short* __restrict__ Ob, int ldo, char* lds) {
  int tid_ = threadIdx.x; asm volatile("" : "+v"(tid_));
  const int tid = tid_, wid = __builtin_amdgcn_readfirstlane(tid >> 6), lane = tid & 63, r32 = lane & 31, hi = lane >> 5;
  char* V_lds = lds; char* K_lds = lds + 4 * SHM_V;
  float* ws = (float*)(lds + 4 * SHM_V + 4 * SHM_K) + wid * 64; float* li_l = ws; float* al_l = ws + 32;
  const int sr = tid >> 4, sc = (tid & 15) * 8, vst0 = v_st(sr, sc), vst1 = v_st(32 + sr, sc);
  bf16x8 kv[4][4];
#pragma unroll
  for (int t = 0; t < 4; ++t) {
    kv[t][0] = *reinterpret_cast<const bf16x8*>(&Kh[(long)(64 * t + sr) * LDK + sc]); kv[t][1] = *reinterpret_cast<const bf16x8*>(&Kh[(long)(64 * t + 32 + sr) * LDK + sc]);
    kv[t][2] = *reinterpret_cast<const bf16x8*>(&Vh[(long)(64 * t + sr) * LDK + sc]); kv[t][3] = *reinterpret_cast<const bf16x8*>(&Vh[(long)(64 * t + 32 + sr) * LDK + sc]); }
  bf16x8 qr[8];
  const bf16* Qw = Qb + (long)(wid * QBLK + r32) * LDQ + hi * 8;
#pragma unroll
  for (int d0 = 0; d0 < 8; ++d0) qr[d0] = *reinterpret_cast<const bf16x8*>(Qw + d0 * 16);
  asm volatile("s_waitcnt vmcnt(0)" ::: "memory");
#pragma unroll
  for (int t = 0; t < 4; ++t) {
    *(bf16x8*)(K_lds + t * SHM_K + KSWZ(sr, sc * 2)) = kv[t][0]; *(bf16x8*)(K_lds + t * SHM_K + KSWZ(32 + sr, sc * 2)) = kv[t][1];
    *(bf16x8*)(V_lds + t * SHM_V + vst0) = kv[t][2]; *(bf16x8*)(V_lds + t * SHM_V + vst1) = kv[t][3]; }
  __syncthreads();
  float m_reg = -1e30f, l_reg = 0; f32x16 o[4] = {};
  const int vb0 = (int)(uintptr_t)V_lds + v_rd_base(lane);
#pragma unroll 1
  for (int t = 0; t < 4; ++t) {
    f32x16 p0, p1; float mn, al; bf16x8 pa0, pa1, pa2, pa3;
    qkt(p0, p1, (const bf16*)(K_lds + t * SHM_K), qr, r32, hi);
    partialSM(p0, p1, m_reg, mn, al);
    if (__any(al < 1.f)) { if (hi == 0) al_l[r32] = al; asm volatile("s_waitcnt lgkmcnt(0)" ::: "memory");
      for (int d = 0; d < 4; ++d) for (int r = 0; r < 16; ++r) o[d][r] *= al_l[crow(r, hi)]; }
    finishSM(p0, p1, al, l_reg, pa0, pa1, pa2, pa3); SBAR();
    pv_d0(o, vb0 + t * (int)SHM_V, pa0, pa1, pa2, pa3);
  }
  if (hi == 0) li_l[r32] = l_reg; asm volatile("s_waitcnt lgkmcnt(0)" ::: "memory");
  __syncthreads();
  store_o_rows<4>(o, li_l, Ob + (long)(wid * QBLK) * ldo, ldo, lds, wid, lane, r32, hi);
  __syncthreads();
}

template <int OFF> __device__ __forceinline__ bf16x8 rd128(int a) { bf16x8 r; asm volatile("ds_read_b128 %0, %1 offset:%2" : "=v"(r) : "v"(a), "i"(OFF) : "memory"); return r; }
#define LGKM(n) asm volatile("s_waitcnt lgkmcnt(" #n ")" ::: "memory")
#define MF(a, b, c) c = __builtin_amdgcn_mfma_f32_32x32x16_bf16(a, b, c, 0, 0, 0)
__device__ __forceinline__ void qkt_p(f32x16& p0, f32x16& p1, int ka0, int ka1, int ka2, int ka3, const bf16x8* qr, bf16x8 kone, bf16x8 qm) {
  bf16x8 a0, b0, a1, b1;
  a0 = rd128<0>(ka0); b0 = rd128<8192>(ka0); a1 = rd128<0>(ka1); b1 = rd128<8192>(ka1);
  p0 = __builtin_amdgcn_mfma_f32_32x32x16_bf16(kone, qm, f32x16{}, 0, 0, 0); p1 = __builtin_amdgcn_mfma_f32_32x32x16_bf16(kone, qm, f32x16{}, 0, 0, 0);
  LGKM(2); SBAR(); MF(a0, qr[0], p0); MF(b0, qr[0], p1); SBAR(); a0 = rd128<0>(ka2);   b0 = rd128<8192>(ka2);
  LGKM(2); SBAR(); MF(a1, qr[1], p0); MF(b1, qr[1], p1); SBAR(); a1 = rd128<0>(ka3);   b1 = rd128<8192>(ka3);
  LGKM(2); SBAR(); MF(a0, qr[2], p0); MF(b0, qr[2], p1); SBAR(); a0 = rd128<128>(ka0); b0 = rd128<8320>(ka0);
  LGKM(2); SBAR(); MF(a1, qr[3], p0); MF(b1, qr[3], p1); SBAR(); a1 = rd128<128>(ka1); b1 = rd128<8320>(ka1);
  LGKM(2); SBAR(); MF(a0, qr[4], p0); MF(b0, qr[4], p1); SBAR(); a0 = rd128<128>(ka2); b0 = rd128<8320>(ka2);
  LGKM(2); SBAR(); MF(a1, qr[5], p0); MF(b1, qr[5], p1); SBAR(); a1 = rd128<128>(ka3); b1 = rd128<8320>(ka3);
  LGKM(2); SBAR(); MF(a0, qr[6], p0); MF(b0, qr[6], p1); SBAR();
  LGKM(0); SBAR(); MF(a1, qr[7], p0); MF(b1, qr[7], p1); SBAR();
}
struct VFrag { s16x4 l0, h0, l1, h1, l2, h2, l3, h3; };
template <int D> __device__ __forceinline__ void pv_rd(VFrag& f, int vb) { constexpr int B = (D >> 2) * 16384;
  f.l0 = tr_read<B + v_rd_off(D & 3, 0, 0)>(vb); f.h0 = tr_read<B + v_rd_off(D & 3, 0, 1)>(vb); f.l1 = tr_read<B + v_rd_off(D & 3, 1, 0)>(vb); f.h1 = tr_read<B + v_rd_off(D & 3, 1, 1)>(vb);
  f.l2 = tr_read<B + v_rd_off(D & 3, 2, 0)>(vb); f.h2 = tr_read<B + v_rd_off(D & 3, 2, 1)>(vb); f.l3 = tr_read<B + v_rd_off(D & 3, 3, 0)>(vb); f.h3 = tr_read<B + v_rd_off(D & 3, 3, 1)>(vb); }
__device__ __forceinline__ void pv_mm(f32x16& od, const VFrag& f, bf16x8 pa0, bf16x8 pa1, bf16x8 pa2, bf16x8 pa3) {
#define PK(L, H) (bf16x8){L[0], L[1], L[2], L[3], H[0], H[1], H[2], H[3]}
  MF(pa0, PK(f.l0, f.h0), od); MF(pa1, PK(f.l1, f.h1), od); MF(pa2, PK(f.l2, f.h2), od); MF(pa3, PK(f.l3, f.h3), od);
#undef PK
}
template <int D, int NB> __device__ __forceinline__ void pv_step(f32x16* o, VFrag& cur, VFrag& nxt, int vb, bf16x8 pa0, bf16x8 pa1, bf16x8 pa2, bf16x8 pa3) {
  if constexpr (D + 1 < NB) { pv_rd<D + 1>(nxt, vb); LGKM(8); } else { LGKM(0); }
  SBAR(); pv_mm(o[D], cur, pa0, pa1, pa2, pa3); SBAR();
  if constexpr (D + 1 < NB) pv_step<D + 1, NB>(o, nxt, cur, vb, pa0, pa1, pa2, pa3);
}
template <int NB> __device__ __forceinline__ void pv_p(f32x16* o, int vb, bf16x8 pa0, bf16x8 pa1, bf16x8 pa2, bf16x8 pa3) {
  VFrag x, y; pv_rd<0>(x, vb); pv_step<0, NB>(o, x, y, vb, pa0, pa1, pa2, pa3);
}
template <int NH>
__device__ __forceinline__ void attn_wide_body(const bf16* __restrict__ Qb, const bf16* __restrict__ Kh, const bf16* __restrict__ Vh, unsigned short* __restrict__ Ob, int ldo, int seq, char* lds) {
  int tid_ = threadIdx.x; asm volatile("" : "+v"(tid_));
  const int tid = tid_, wid = __builtin_amdgcn_readfirstlane(tid >> 6), lane = tid & 63, r32 = lane & 31, hi = lane >> 5;
  constexpr int KB = 16384, VB = NH * 16384, VOFF = 2 * KB;
  float* ws = (float*)(lds + 2 * KB + 3 * VB) + wid * 64; float* li_l = ws; float* al_l = ws + 32;
  bf16x8 qr[8];
  const bf16* Qw = Qb + (long)(wid * QBLK + r32) * LDQ + hi * 8;
#pragma unroll
  for (int d0 = 0; d0 < 8; ++d0) { const bf16x8 qv = *reinterpret_cast<const bf16x8*>(Qw + d0 * 16);
    constexpr float C = SCALE * 1.4426950408889634f; u32x4 w;
#pragma unroll
    for (int e = 0; e < 4; ++e) w[e] = cvtpk(__uint_as_float((unsigned)(unsigned short)qv[2 * e] << 16) * C, __uint_as_float((unsigned)(unsigned short)qv[2 * e + 1] << 16) * C);
    qr[d0] = *reinterpret_cast<bf16x8*>(&w); }
  unsigned kof[2], vof[2];
#pragma unroll
  for (int i = 0; i < 2; ++i) { const int ch = 2 * wid + i;
    const int row = ch * 4 + (lane >> 4); kof[i] = (unsigned)(row * LDK * 2 + (((lane & 15) ^ (row & 7)) << 4));
    const int s = 2 * ch + (lane >> 5), kk = (s >> 2) * 8 + ((lane & 31) >> 2), k = (kk & ~0xC) | ((kk & 4) << 1) | ((kk & 8) >> 1);
    vof[i] = (unsigned)(k * LDK * 2 + ((s & 3) * 32 + (lane & 3) * 8) * 2); }
  PG8_LAS unsigned char* L3 = (PG8_LAS unsigned char*)lds;
  const unsigned pw = (unsigned)wid * 2048u;
#define WDMA_K(t, b) do { const char* kg = (const char*)Kh + (size_t)(t) * (KVBLK * LDK * 2); _Pragma("unroll") for (int _i = 0; _i < 2; ++_i)  \
      __builtin_amdgcn_global_load_lds((const unsigned*)(kg + kof[_i]), (PG8_LAS unsigned*)(L3 + (b) * KB + pw + _i * 1024), 16, 0, 0); } while (0)
#define WDMA_V(t, b) do { const char* vg = (const char*)Vh + (size_t)(t) * (KVBLK * LDK * 2); _Pragma("unroll") for (int _h = 0; _h < NH; ++_h) _Pragma("unroll") for (int _i = 0; _i < 2; ++_i)  \
      __builtin_amdgcn_global_load_lds((const unsigned*)(vg + _h * 256 + vof[_i]), (PG8_LAS unsigned*)(L3 + VOFF + (b) * VB + _h * 16384 + pw + _i * 1024), 16, 0, 0); } while (0)
#define WQS(kb, FIRST_, ISSUE_) do { f32x16 p0, p1; float al; SBAR(); __builtin_amdgcn_s_setprio(1); { const int ko = (kb) * KB; u32x4 qmw = {hi ? 0u : cvtpk(-m_reg, 0.f), 0u, 0u, 0u}; u32x4 konew = {hi ? 0u : 0x3F80u, 0u, 0u, 0u}; const bf16x8 kone = *reinterpret_cast<bf16x8*>(&konew);                          \
      qkt_p(p0, p1, ka0 + ko, ka1 + ko, ka2 + ko, ka3 + ko, qr, kone, *reinterpret_cast<bf16x8*>(&qmw)); } __builtin_amdgcn_s_setprio(0); partialSMf(p0, p1, m_reg, al, (FIRST_)); SBAR(); ISSUE_; SBAR();                       \
    if (__any(al < 1.f)) { if (hi == 0) al_l[r32] = al; asm volatile("s_waitcnt lgkmcnt(0)" ::: "memory");                                                            \
      for (int d = 0; d < 4 * NH; ++d) for (int r = 0; r < 16; ++r) o[d][r] *= al_l[crow(r, hi)]; }                                                                     \
    finishSM(p0, p1, al, l_reg, pa0, pa1, pa2, pa3); SBAR(); } while (0)
#define WPV(vb_) do { SBAR(); __builtin_amdgcn_s_setprio(1); pv_p<4 * NH>(o, vb0 + (vb_) * VB, pa0, pa1, pa2, pa3); __builtin_amdgcn_s_setprio(0); SBAR(); } while (0)
  float m_reg = 0.f, l_reg = 0; f32x16 o[4 * NH] = {};
  const int vb0 = (int)(uintptr_t)lds + VOFF + v_rd_base(lane);
  const int NT = seq / KVBLK; const bool lead = wid < 4;
  const int kx = (hi * 16) ^ ((r32 & 7) << 4), kl = (int)(uintptr_t)lds + r32 * 256;
  const int ka0 = kl + kx, ka1 = kl + (32 ^ kx), ka2 = kl + (64 ^ kx), ka3 = kl + (96 ^ kx);
  bf16x8 pa0, pa1, pa2, pa3;
  WDMA_K(0, 0); WDMA_V(0, 0); asm volatile("s_waitcnt vmcnt(0)" ::: "memory"); __syncthreads();
#define WEND() do { asm volatile("s_waitcnt vmcnt(0)" ::: "memory"); __syncthreads(); } while (0)
#define WROT() do { vj = vj1; vj1 = vj2; vj2 = (vj2 == 2) ? 0 : vj2 + 1; } while (0)
  int vj = 2, vj1 = 0, vj2 = 1;
  if (lead) {
#pragma unroll 1
    for (int j = -1; j + 1 < NT; ++j) { const int k1 = (j + 1) & 1;
      WQS(k1, j == -1, if (j + 2 < NT) { WDMA_K(j + 2, k1 ^ 1); WDMA_V(j + 2, vj2); }); WPV(vj1); WEND(); WROT(); }
    WEND();
  } else {
    if (1 < NT) { WDMA_K(1, 1); WDMA_V(1, 1); }
    WQS(0, true, (void)0); WEND(); WROT();
#pragma unroll 1
    for (int j = 0; j + 1 < NT; ++j) { const int k1 = (j + 1) & 1;
      if (j + 2 < NT) { WDMA_K(j + 2, k1 ^ 1); WDMA_V(j + 2, vj2); }
      WPV(vj); WQS(k1, false, (void)0); WEND(); WROT(); }
    WPV(vj); WEND();
  }
#undef WEND
#undef WROT
#undef WDMA_K
#undef WDMA_V
#undef WQS
#undef WPV
  if (hi == 0) li_l[r32] = l_reg; asm volatile("s_waitcnt lgkmcnt(0)" ::: "memory");
  store_o_rows<4 * NH>(o, li_l, Ob + (long)(wid * QBLK) * ldo, ldo, lds, wid, lane, r32, hi);
  __syncthreads();
}
}
#define ONE_PER_PHASE 0

namespace pg8 {
template <int ACT  > struct EpiStore {
    static constexpr bool PERM = true, AFTER_DRAIN = false, ASCAN = (ACT == 2);
    bf16_t* O; int ldc; const bf16_t* aux;
    __device__ __forceinline__ void operator()(const f32x4 (&acc)[2][2][4][2], const Unit& u, int wr, int wc, int fr, int fq) const {
        const int row0 = u.pm * BM + wr * 64 + fr, col0 = u.pn * BM + wc * 32 + 8 * fq;
#pragma unroll
        for (int ai = 0; ai < 2; ++ai)
#pragma unroll
            for (int m = 0; m < 4; ++m) { const size_t ro = (size_t)(row0 + ai * HALF + m * 16) * ldc + col0;
#pragma unroll
                for (int bj = 0; bj < 2; ++bj) { f32x4 v0 = acc[ai][bj][m][0], v1 = acc[ai][bj][m][1];
                    if (ACT == 1) { v0 = __builtin_elementwise_max(v0, (f32x4){0.f, 0.f, 0.f, 0.f}); v1 = __builtin_elementwise_max(v1, (f32x4){0.f, 0.f, 0.f, 0.f}); v0 = v0 * v0; v1 = v1 * v1; }
                    if (ACT == 2) { const int row_ = row0 + ai * HALF + m * 16, col_ = col0 + bj * HALF;
                        const u32x4 z = *(const u32x4*)(aux + ((size_t)((row_ >> 8) * 128 + (col_ >> 4)) * 256 + (row_ & 255)) * 16 + (col_ & 15));
                        const f32x4 z0 = {__uint_as_float(z.x << 16), __uint_as_float(z.x & 0xffff0000u), __uint_as_float(z.y << 16), __uint_as_float(z.y & 0xffff0000u)};
                        const f32x4 z1 = {__uint_as_float(z.z << 16), __uint_as_float(z.z & 0xffff0000u), __uint_as_float(z.w << 16), __uint_as_float(z.w & 0xffff0000u)};
#pragma unroll
                        for (int e = 0; e < 4; ++e) { v0[e] = z0[e] * __builtin_amdgcn_rcpf(1.f + __builtin_amdgcn_exp2f(-1.4426950408889634f * v0[e])); v1[e] = z1[e] * __builtin_amdgcn_rcpf(1.f + __builtin_amdgcn_exp2f(-1.4426950408889634f * v1[e])); } }
                    u32x4 w; w.x = cvt_pk_bf16(v0[0], v0[1]); w.y = cvt_pk_bf16(v0[2], v0[3]); w.z = cvt_pk_bf16(v1[0], v1[1]); w.w = cvt_pk_bf16(v1[2], v1[3]);
                    if (ACT == 3) { const int row = row0 + ai * HALF + m * 16, col = col0 + bj * HALF;
                        *(u32x4*)(O + ((size_t)((row >> 8) * 128 + (col >> 4)) * 256 + (row & 255)) * 16 + (col & 15)) = w; }
                    else *(u32x4*)(O + ro + bj * HALF) = w; } }
    }
};
}


namespace pg8 {
struct EpiQKV {
    static constexpr bool PERM = true, AFTER_DRAIN = false, ASCAN = false;
    bf16_t* QH; bf16_t* KBf; bf16_t* VBf; float* out; const float* qkn; const float* rope; PG8_LAS float* P;
    __device__ __forceinline__ void operator()(const f32x4 (&acc)[2][2][4][2], const Unit& u, int wr, int wc, int fr, int fq) const {
        const int pn = u.pn, pm = u.pm;
        const bool samp = pm >= 32; const int b = samp ? ((pm - 32) >> 4) : 0, tb = samp ? ((pm - 32) & 15) * 256 : 0;
        const int kind = pn < 4 ? 0 : pn == 4 ? 1 : pn == 5 ? 2 : pn < 10 ? 3 : pn < 14 ? 4 : 5;
        const bool nrm = kind <= 1, rp = samp && kind != 2 && kind != 5;
        const int j0 = wc * 32 + 8 * fq, t4 = 4 * (4 * wc + fq);
        if (nrm) {
#pragma unroll
            for (int ai = 0; ai < 2; ++ai)
#pragma unroll
                for (int m = 0; m < 4; ++m)
#pragma unroll
                    for (int bj = 0; bj < 2; ++bj) { const f32x4 a = acc[ai][bj][m][0], c = acc[ai][bj][m][1];
                        float ss = (a[0] * a[0] + a[1] * a[1]) + (a[2] * a[2] + a[3] * a[3]) + (c[0] * c[0] + c[1] * c[1]) + (c[2] * c[2] + c[3] * c[3]);
                        ss += __shfl_xor(ss, 16); ss += __shfl_xor(ss, 32);
                        if (fq == 0) P[((ai * HALF + wr * 64 + m * 16 + fr) * 2 + bj) * 4 + wc] = ss; }
            asm volatile("s_waitcnt lgkmcnt(0)" ::: "memory"); __builtin_amdgcn_s_barrier(); asm volatile("" ::: "memory");
        }
        f32x4 glo = {1.f, 1.f, 1.f, 1.f}, ghi = glo;
        if (nrm) { glo = *(const f32x4*)(qkn + kind * 128 + t4); ghi = *(const f32x4*)(qkn + kind * 128 + 64 + t4); }
#pragma unroll
        for (int ai = 0; ai < 2; ++ai)
#pragma unroll
            for (int m = 0; m < 4; ++m) {
                const int rl = ai * HALF + wr * 64 + m * 16 + fr, row = pm * BM + rl, tok = tb + rl;
                const size_t kvrow = samp ? (size_t)(8192 + b * 4352 + tok) : (size_t)row;
                f32x4 cs0 = {1.f, 0.f, 1.f, 0.f}, cs1 = cs0;
                if (rp) { cs0 = *(const f32x4*)(rope + ((size_t)tok * 64 + t4) * 2); cs1 = *(const f32x4*)(rope + ((size_t)tok * 64 + t4) * 2 + 4); }
#pragma unroll
                for (int bj = 0; bj < 2; ++bj) {
                    f32x4 v0 = acc[ai][bj][m][0], v1 = acc[ai][bj][m][1];
                    if (nrm) { const f32x4 q = *(const PG8_LAS f32x4*)(P + (rl * 2 + bj) * 4); const float r = 1.0f / sqrtf(((q[0] + q[1]) + (q[2] + q[3])) * (1.f / 128.f) + 1e-6f);
                        v0 = (f32x4){v0[0] * r * glo[0], v0[1] * r * ghi[0], v0[2] * r * glo[1], v0[3] * r * ghi[1]};
                        v1 = (f32x4){v1[0] * r * glo[2], v1[1] * r * ghi[2], v1[2] * r * glo[3], v1[3] * r * ghi[3]}; }
                    if (rp) {
                        v0 = (f32x4){v0[0] * cs0[0] - v0[1] * cs0[1], v0[0] * cs0[1] + v0[1] * cs0[0], v0[2] * cs0[2] - v0[3] * cs0[3], v0[2] * cs0[3] + v0[3] * cs0[2]};
                        v1 = (f32x4){v1[0] * cs1[0] - v1[1] * cs1[1], v1[0] * cs1[1] + v1[1] * cs1[0], v1[2] * cs1[2] - v1[3] * cs1[3], v1[2] * cs1[3] + v1[3] * cs1[2]}; }
                    u32x4 w; w.x = cvt_pk_bf16(v0[0], v0[1]); w.y = cvt_pk_bf16(v0[2], v0[3]); w.z = cvt_pk_bf16(v1[0], v1[1]); w.w = cvt_pk_bf16(v1[2], v1[3]);
                    if (kind == 0) *(u32x4*)(QH + (size_t)row * 2048 + (2 * pn + bj) * 128 + j0) = w;
                    else if (kind == 3) *(u32x4*)(QH + (size_t)row * 2048 + 1024 + (2 * (pn - 6) + bj) * 128 + j0) = w;
                    else if (kind == 1 || kind == 4) {
                        const int hb = (kind == 1) ? bj * 128 : 256 + (2 * (pn - 10) + bj) * 128;
                        *(u32x4*)(KBf + kvrow * 1280 + hb + j0) = w;
                        if (!samp) { float* o = (kind == 1) ? out + 35651584 - 2097152 + (size_t)row * 256 + bj * 128 : out + 37748736 + (size_t)row * 1024 + (2 * (pn - 10) + bj) * 128;
                            *(f32x4*)(o + t4) = (f32x4){v0[0], v0[2], v1[0], v1[2]}; *(f32x4*)(o + 64 + t4) = (f32x4){v0[1], v0[3], v1[1], v1[3]}; }
                    } else {
                        const int hb = (kind == 2) ? bj * 128 : 256 + (pn - 14) * 256 + bj * 128;
                        *(u32x4*)(VBf + kvrow * 1280 + hb + j0) = w;
                        if (!samp) { float* o = (kind == 2) ? out + 35651584 + (size_t)row * 256 + bj * 128 : out + 46137344 + (size_t)row * 1024 + (pn - 14) * 256 + bj * 128;
                            *(f32x4*)(o + j0) = v0; *(f32x4*)(o + j0 + 4) = v1; }
                    }
                }
            }
    }
};
}

#define LAS __attribute__((address_space(3)))
#define GAS __attribute__((address_space(1)))
constexpr int NWAVES = 8;
constexpr int RING_OFF = 0, RING_BYTES = 139264, LDSCTL_OFF = RING_BYTES, MISC_OFF = LDSCTL_OFF + 320, LDS_BYTES = 147456;
constexpr size_t WO_QKV = 0, WO_AO = 18 * MiB, WO_W1 = 26 * MiB, WO_W2 = 90 * MiB, WO_SI = 154 * MiB, WO_GL = 162 * MiB, WO_SO = 170 * MiB;
constexpr int CW_BAR = 4096, CW_ATTQ = 2048;

#define XB_TMO      128
#define XB_XCNT(j)  (256  + 64 * (j))
#define XB_XSUB(j)  (1280 + 64 * (j))
#define XB_XGEN(j)  (2304 + 64 * (j))
#define XB_TOP      3328
#define XB_TOPGEN   3392
#define XCD_BAR_WORDS 3456
#define XB_SPIN_CAP (1u << 18)
__device__ __forceinline__ unsigned xb_ld(unsigned* p)              { return __hip_atomic_load(p, __ATOMIC_RELAXED, __HIP_MEMORY_SCOPE_AGENT); }
__device__ __forceinline__ unsigned xb_add(unsigned* p, unsigned v) { return __hip_atomic_fetch_add(p, v, __ATOMIC_RELAXED, __HIP_MEMORY_SCOPE_AGENT); }
__device__ __forceinline__ unsigned xb_xcc_id() { return (unsigned)__builtin_amdgcn_s_getreg((3 << 11) | 20) & 0xFu; }
#define XB_SPIN(cond, bar) do { unsigned _sp = 0; while (cond) { __builtin_amdgcn_s_sleep(1); \
    if ((++_sp & 255u) == 0u) { if (xb_ld(&(bar)[XB_TMO])) break; if (_sp > XB_SPIN_CAP) { atomicAdd(&(bar)[XB_TMO], 1u); break; } } } } while (0)
struct XcdBarrier { unsigned* bar; unsigned x; volatile LAS unsigned* st; };
__device__ __forceinline__ XcdBarrier xcd_barrier_post(unsigned* bar, volatile LAS unsigned* st) {
    XcdBarrier b; b.bar = bar; b.x = xb_xcc_id(); b.st = st;
    if (threadIdx.x == 0) (void)xb_add(&bar[XB_XCNT(b.x)], 1u);
    return b;
}
__device__ __forceinline__ void xcd_barrier_complete(unsigned* bar, unsigned x, unsigned& nloc, unsigned& nx) {
    const unsigned G = gridDim.x * gridDim.y * gridDim.z;
    unsigned sum, cnt, mine, sp = 0u;
    for (;;) {
        sum = 0u; cnt = 0u; mine = 0u;
#pragma unroll
        for (unsigned j = 0; j < 16; ++j) { const unsigned c = xb_ld(&bar[XB_XCNT(j)]); sum += c; cnt += (c > 0u) ? 1u : 0u; mine = (j == x) ? c : mine; }
        if (sum == G) break;
        __builtin_amdgcn_s_sleep(1);
        if ((++sp & 255u) == 0u) { if (xb_ld(&bar[XB_TMO])) break; if (sp > XB_SPIN_CAP) { atomicAdd(&bar[XB_TMO], 1u); break; } }
    }
    nloc = mine > 0u ? mine : 1u; nx = cnt > 0u ? cnt : 1u;
}
__device__ __forceinline__ void xcd_barrier(const XcdBarrier& b) {
    asm volatile("s_waitcnt vmcnt(0)" ::: "memory");
    __syncthreads();
    if (threadIdx.x == 0) {
        unsigned* bar = b.bar;
        __builtin_amdgcn_s_waitcnt(0);
        unsigned nloc = b.st[0], nx = b.st[1];
        if (nloc == 0u) { xcd_barrier_complete(bar, b.x, nloc, nx); b.st[0] = nloc; b.st[1] = nx; }
        const unsigned old = xb_add(&bar[XB_XSUB(b.x)], 1u);
        const unsigned gen = old / nloc;
        if (old + 1u == (gen + 1u) * nloc) {
            __builtin_amdgcn_fence(__ATOMIC_RELEASE, "agent");
            asm volatile("s_waitcnt vmcnt(0)" ::: "memory");
            const unsigned og = xb_add(&bar[XB_TOP], 1u);
            const unsigned tg = og / nx;
            if (og + 1u == (tg + 1u) * nx) xb_add(&bar[XB_TOPGEN], 1u);
            else XB_SPIN(xb_ld(&bar[XB_TOPGEN]) == tg, bar);
            __builtin_amdgcn_fence(__ATOMIC_ACQUIRE, "agent");
            xb_add(&bar[XB_XGEN(b.x)], 1u);
            asm volatile("s_waitcnt vmcnt(0)" ::: "memory");
        } else {
            XB_SPIN(xb_ld(&bar[XB_XGEN(b.x)]) == gen, bar);
            __builtin_amdgcn_fence(__ATOMIC_ACQUIRE, "agent");
            asm volatile("s_waitcnt vmcnt(0)" ::: "memory");
        }
    }
    __syncthreads();
}

struct TItem { const float* src; bf16_t* dst; int N, K, n0, k0, qperm; };
__device__ __forceinline__ TItem titem_decode(const CP& p, int first, int it) {
    constexpr int I_QKV = (D / 64) * (NQKV / 32), I_SQ = (D / 64) * (D / 32), I_W1 = (D / 64) * (DFF / 32), I_W2 = (DFF / 64) * (D / 32);
    unsigned char* wb = p.ws + WS_W; TItem t; int r = it; t.qperm = 0;
    if (first == 0) {
        if (r < I_QKV) { t.src = p.attn_w_in; t.dst = (bf16_t*)(wb + WO_QKV); t.N = NQKV; t.K = D; t.qperm = 1; }
        else if ((r -= I_QKV) < I_SQ) { t.src = p.attn_w_out; t.dst = (bf16_t*)(wb + WO_AO); t.N = D; t.K = D; }
        else if ((r -= I_SQ) < I_W1) { t.src = p.mlp_w1; t.dst = (bf16_t*)(wb + WO_W1); t.N = DFF; t.K = D; }
        else { r -= I_W1; t.src = p.mlp_w2; t.dst = (bf16_t*)(wb + WO_W2); t.N = D; t.K = DFF; }
    } else {
        if (r < I_SQ) { t.src = p.ssm_w_in; t.dst = (bf16_t*)(wb + WO_SI); t.N = D; t.K = D; }
        else if ((r -= I_SQ) < I_SQ) { t.src = p.ssm_glu_w; t.dst = (bf16_t*)(wb + WO_GL); t.N = D; t.K = D; }
        else if ((r -= I_SQ) < I_SQ) { t.src = p.ssm_w_out; t.dst = (bf16_t*)(wb + WO_SO); t.N = D; t.K = D; }
        else if ((r -= I_SQ) < I_W1) { t.src = p.mlp_w1 + (size_t)D * DFF; t.dst = (bf16_t*)(wb + WO_W1 + 32 * MiB); t.N = DFF; t.K = D; }
        else { r -= I_W1; t.src = p.mlp_w2 + (size_t)DFF * D; t.dst = (bf16_t*)(wb + WO_W2 + 32 * MiB); t.N = D; t.K = DFF; }
    }
    const int nblk = t.N / 32, kb = r / nblk, nb = r % nblk; t.k0 = 64 * kb; t.n0 = 32 * nb;
    return t;
}
__device__ __forceinline__ int qkv_pos(int c) {
    const bool isv = (c >= 1280 && c < 1536) || c >= 3584; if (isv) return c;
    const int cl = c & 127, i = cl & 63, s = cl >> 6; return (c & ~127) + 8 * (i >> 2) + 2 * (i & 3) + s;
}
__device__ __forceinline__ void titem_load(float (&wv)[32], const TItem& t, int lane) {
    const float* s = t.src + (size_t)(t.k0 + (lane >> 3)) * t.N + t.n0 + (lane & 7) * 4;
#pragma unroll
    for (int i = 0; i < 8; ++i) { const f32x4 v = *(const f32x4*)(s + (size_t)(8 * i) * t.N); wv[4 * i] = v[0]; wv[4 * i + 1] = v[1]; wv[4 * i + 2] = v[2]; wv[4 * i + 3] = v[3]; }
}
__device__ __forceinline__ void titem_store(const float (&wv)[32], const TItem& t, LAS float* scr, int lane) {
#pragma unroll
    for (int i = 0; i < 8; ++i) { LAS float* d = scr + ((lane >> 3) + 8 * i) * 33 + (lane & 7) * 4; d[0] = wv[4 * i]; d[1] = wv[4 * i + 1]; d[2] = wv[4 * i + 2]; d[3] = wv[4 * i + 3]; }
    asm volatile("s_waitcnt lgkmcnt(0)" ::: "memory");
    const int c = lane & 7;
#pragma unroll
    for (int j = 0; j < 4; ++j) { const int n = (lane >> 3) + 8 * j; const LAS float* s = scr + (8 * c) * 33 + n;
        u32x4 o; o.x = pk2(s[0 * 33], s[1 * 33]); o.y = pk2(s[2 * 33], s[3 * 33]); o.z = pk2(s[4 * 33], s[5 * 33]); o.w = pk2(s[6 * 33], s[7 * 33]);
        const int row = t.qperm ? qkv_pos(t.n0 + n) : t.n0 + n;
        *(u32x4*)(t.dst + (size_t)row * t.K + t.k0 + 8 * c) = o; }
    asm volatile("s_waitcnt lgkmcnt(0)" ::: "memory");
}
__device__ __forceinline__ void transpose_run(const CP& p, LAS float* scr, int lane, int first, int start, int stride, int end) {
    if (start >= end) return;
    float wa[32], wb[32]; TItem ta = titem_decode(p, first, start), tb = ta;
    titem_load(wa, ta, lane);
    int it = start;
    for (;;) {
        const int i1 = it + stride; const bool h1 = i1 < end;
        if (h1) { tb = titem_decode(p, first, i1); titem_load(wb, tb, lane); }
        asm volatile("" ::: "memory");
        titem_store(wa, ta, scr, lane);
        if (!h1) break;
        const int i2 = i1 + stride; const bool h2 = i2 < end;
        if (h2) { ta = titem_decode(p, first, i2); titem_load(wa, ta, lane); }
        asm volatile("" ::: "memory");
        titem_store(wb, tb, scr, lane);
        if (!h2) break;
        it = i2;
    }
}
__device__ __forceinline__ void ph_prologue(const CP& p, LAS unsigned char* L, int lane, int wave) {
    const int gw = blockIdx.x * NWAVES + wave, NGW = gridDim.x * NWAVES;
    LAS float* sl = (LAS float*)(L + RING_OFF + 8 * 8704);
    for (int j = threadIdx.x; j < 3 * D; j += NWAVES * 64) { const int cls = j / D, k = j - cls * D; const float c0 = (cls == 0) ? p.c_ctx[k] : p.c[(cls - 1) * D + k]; sl[j] = c0 / (1.f + expf(-c0)); }
    __syncthreads();
    for (int it = gw; it < 2 * KCH * 48; it += NGW) {
        const int cb = it % 48, kc = (it / 48) % KCH, l = it / (48 * KCH);
        const float* w = p.ada_w + ((size_t)l * D + kc * 128) * NMOD + cb * 256 + lane * 4;
        f32x4 a0 = {0, 0, 0, 0}, a1 = a0, a2 = a0;
#pragma unroll 16
        for (int kk = 0; kk < 128; ++kk) {
            const int k = kc * 128 + kk;
            const float s0 = sl[k], s1 = sl[D + k], s2 = sl[2 * D + k];
            const f32x4 wv = *(const f32x4*)(w + (size_t)kk * NMOD);
            a0 += wv * s0; a1 += wv * s1; a2 += wv * s2;
        }
        float* o = (float*)(p.ws + WS_MODP) + ((size_t)(l * KCH + kc) * 3) * NMOD + cb * 256 + lane * 4;
        *(f32x4*)(o) = a0; *(f32x4*)(o + NMOD) = a1; *(f32x4*)(o + 2 * NMOD) = a2;
    }
    {
        LAS float* scr = (LAS float*)(L + RING_OFF + wave * 8704);
        constexpr int I_QKV = (D / 64) * (NQKV / 32), I_SQ = (D / 64) * (D / 32), I_W1 = (D / 64) * (DFF / 32), I_W2 = (DFF / 64) * (D / 32);
        constexpr int NITEMS0 = I_QKV + I_SQ + I_W1 + I_W2, NGEMV = 2 * KCH * 48;
        const int ng = NGW < NGEMV ? NGW : NGEMV;
        const int split = (NGW > ng) ? 8 * ng : NITEMS0;
        if (gw < ng) transpose_run(p, scr, lane, 0, gw, ng, split);
        else transpose_run(p, scr, lane, 0, split + (gw - ng), NGW - ng, NITEMS0);
    }
    for (int i = gw * 64 + lane; i < LQ * 64; i += NGW * 64) {
        const int t = i >> 6, j = i & 63;
        const float inv = powf(10000.f, -(float)(j & 31) / 32.f);
        const float pos = (j < 32) ? (float)(t >> 6) : (float)(t & 63);
        const float ang = pos * inv;
        ((f32x2*)(p.ws + WS_ROPE))[i] = (f32x2){cosf(ang), sinf(ang)};
    }
    for (int i2 = gw * 64 + lane; i2 < 2 * 128 * 64 * 16; i2 += NGW * 64) {
        const int c = i2 & 15, i = i2 >> 4, n = i & 63, kg = i >> 6;
        const float are = p.ssm_a_re[i], aim = p.ssm_a_im[i], dt = expf(p.ssm_log_dt[kg]);
        const float er = expf(are * dt), abr = er * cosf(aim * dt), abi = er * sinf(aim * dt);
        const float nr = abr - 1.f, ni = abi, den = are * are + aim * aim; const float cr = (nr * are + ni * aim) / den, ci = (ni * are - nr * aim) / den;
        if (c == 0) {
            ((f32x2*)(p.ws + WS_ABAR))[i] = (f32x2){abr, abi};
            float pr = abr, pi_ = abi;
#pragma unroll
            for (int s = 0; s < 8; ++s) { const float t = pr * pr - pi_ * pi_; pi_ = 2.f * pr * pi_; pr = t; }
            ((f32x2*)(p.ws + WS_A256))[i] = (f32x2){pr, pi_};
        }
        bf16_t* bbar = (bf16_t*)(p.ws + WS_BBAR) + (size_t)kg * 4 * 512; bf16_t* cmat = (bf16_t*)(p.ws + WS_CMAT) + (size_t)kg * 4 * 512;
        const int nn = n & 31, nh = n >> 5;
        const float br = p.ssm_b_re[(size_t)i * 16 + c], bi = p.ssm_b_im[(size_t)i * 16 + c];
        const int ln = (c >> 3) * 32 + nn, j = c & 7;
        bbar[(nh) * 512 + ln * 8 + j] = (bf16_t)f2bf(cr * br - ci * bi);
        bbar[(2 + nh) * 512 + ln * 8 + j] = (bf16_t)f2bf(cr * bi + ci * br);
        {
          const float vr = cr * br - ci * bi, vi = cr * bi + ci * br; float pr = 1.f, pi_ = 0.f;
#pragma unroll
          for (int e = 0; e < 4; ++e) {
              bf16_t* b4 = (bf16_t*)(p.ws + WS_BB4) + ((size_t)(3 - e) * 256 + kg) * 4 * 512;
              b4[(nh) * 512 + ln * 8 + j] = (bf16_t)f2bf(pr * vr - pi_ * vi); b4[(2 + nh) * 512 + ln * 8 + j] = (bf16_t)f2bf(pr * vi + pi_ * vr);
              const float t = pr * abr - pi_ * abi; pi_ = pr * abi + pi_ * abr; pr = t; }
          if (c == 0) ((f32x2*)(p.ws + WS_A4))[i] = (f32x2){pr, pi_}; }
        const float c_re = p.ssm_c_re[((size_t)kg * 16 + c) * 64 + n], c_im = p.ssm_c_im[((size_t)kg * 16 + c) * 64 + n];
        const int K0 = 4 * nn + 2 * nh;
        { const int K = K0, s = K >> 5, l2 = c + 16 * ((K & 31) >> 3), jj = K & 7; cmat[s * 512 + l2 * 8 + jj] = (bf16_t)f2bf(c_re); }
        { const int K = K0 + 1, s = K >> 5, l2 = c + 16 * ((K & 31) >> 3), jj = K & 7; cmat[s * 512 + l2 * 8 + jj] = (bf16_t)f2bf(-c_im); }
    }
    bf16_t* KBf = (bf16_t*)(p.ws + WS_KB); bf16_t* VBf = (bf16_t*)(p.ws + WS_VB);
    for (int r = gw; r < 512; r += NGW) {
        const int b = r >> 8, t = r & 255; const size_t kr = (size_t)(MP + b * LKV + LQ + t) * KVW;
        for (int c = lane * 2; c < 256; c += 128) { const size_t s = ((size_t)(b * 256 + t)) * 256 + c;
            KBf[kr + qkv_pos(c)] = (bf16_t)f2bf(p.cache_a_k[s]); KBf[kr + qkv_pos(c + 1)] = (bf16_t)f2bf(p.cache_a_k[s + 1]); *(unsigned*)(VBf + kr + c) = pk2(p.cache_a_v[s], p.cache_a_v[s + 1]); }
        for (int c = lane * 2; c < 1024; c += 128) { const size_t s = ((size_t)(b * 256 + t)) * 1024 + c;
            KBf[kr + 256 + qkv_pos(c)] = (bf16_t)f2bf(p.cache_b_k[s]); KBf[kr + 256 + qkv_pos(c + 1)] = (bf16_t)f2bf(p.cache_b_k[s + 1]); *(unsigned*)(VBf + kr + 256 + c) = pk2(p.cache_b_v[s], p.cache_b_v[s + 1]); }
    }
}


__device__ __forceinline__ void ph_late_weights(const CP& p, LAS unsigned char* L, int lane, int wave, int widx, int nw) {
    LAS float* scr = (LAS float*)(L + RING_OFF + wave * 8704);
    constexpr int I_SQ = (D / 64) * (D / 32), I_W1 = (D / 64) * (DFF / 32), I_W2 = (DFF / 64) * (D / 32);
    transpose_run(p, scr, lane, 1, widx, nw, 3 * I_SQ + I_W1 + I_W2);
}

template <bool FINAL>
__device__ __forceinline__ void ld_mod(const CP& p, LAS float* dst, int l, int cls, int idx, int tid) {
    for (int j = tid; j < D; j += NWAVES * 64) {
        if (FINAL) { dst[j] = ((const float*)(p.ws + WS_MOD))[((size_t)(l * 3 + cls) * 6 + idx) * D + j]; }
        else {
            float s = p.ada_b[l * NMOD + idx * D + j];
            const float* mp = (const float*)(p.ws + WS_MODP) + ((size_t)(l * KCH) * 3 + cls) * NMOD + idx * D + j;
#pragma unroll
            for (int kc = 0; kc < KCH; ++kc) s += mp[(size_t)kc * 3 * NMOD];
            dst[j] = s;
        }
    }
}
__device__ __forceinline__ void mod_finish(const CP& p, int tid) {
    const int per = (2 * 3 * NMOD + (int)gridDim.x - 1) / (int)gridDim.x;
    for (int i = (int)blockIdx.x * per + tid; i < ((int)blockIdx.x + 1) * per && i < 2 * 3 * NMOD; i += NWAVES * 64) {
        const int j = i % NMOD, cls = (i / NMOD) % 3, l = i / (3 * NMOD);
        float s = p.ada_b[l * NMOD + j];
        const float* mp = (const float*)(p.ws + WS_MODP) + ((size_t)(l * KCH) * 3 + cls) * NMOD + j;
#pragma unroll
        for (int kc = 0; kc < KCH; ++kc) s += mp[(size_t)kc * 3 * NMOD];
        ((float*)(p.ws + WS_MOD))[i] = s;
    }
}
struct RowIn { f32x4 xf[8]; u32x2 xh[8]; u32x2 ow[8]; };
template <bool BR, bool XIN16>
__device__ __forceinline__ void row_load(RowIn& in, int m, int lane, const float* xin_row, const bf16_t* xin16, const bf16_t* o) {
    if (XIN16) {
#pragma unroll
        for (int j = 0; j < 8; ++j) in.xh[j] = *(const u32x2*)(xin16 + (size_t)m * D + j * 256 + lane * 4);
    } else {
#pragma unroll
        for (int j = 0; j < 8; ++j) in.xf[j] = *(const f32x4*)(xin_row + j * 256 + lane * 4);
    }
    if (BR) {
#pragma unroll
        for (int j = 0; j < 8; ++j) in.ow[j] = *(const u32x2*)(o + (size_t)m * D + j * 256 + lane * 4);
    }
}
template <bool BR, bool NX, bool XIN16, bool XOUT16>
__device__ __forceinline__ void row_compute(const CP& p, const RowIn& in, int m, int lane, bf16_t* xout16, bf16_t* xn,
                                            const LAS float* gate, const float* gp, const LAS float* sh, const LAS float* sc, const float* gn) {
    f32x4 x[8];
#pragma unroll
    for (int j = 0; j < 8; ++j) {
        if (XIN16) { const u32x2 w = in.xh[j]; x[j] = (f32x4){__uint_as_float(w.x << 16), __uint_as_float(w.x & 0xffff0000u), __uint_as_float(w.y << 16), __uint_as_float(w.y & 0xffff0000u)}; }
        else x[j] = in.xf[j];
    }
    if (BR) {
        f32x4 ov[8]; float ss = 0.f;
#pragma unroll
        for (int j = 0; j < 8; ++j) { const u32x2 w = in.ow[j];
            ov[j] = (f32x4){__uint_as_float(w.x << 16), __uint_as_float(w.x & 0xffff0000u), __uint_as_float(w.y << 16), __uint_as_float(w.y & 0xffff0000u)};
            ss += ov[j].x * ov[j].x + ov[j].y * ov[j].y + ov[j].z * ov[j].z + ov[j].w * ov[j].w; }
        const float r = 1.0f / sqrtf(wave_sum(ss) * (1.f / D) + EPS);
        float* xo = p.out + OUT_Y + (size_t)m * D;
#pragma unroll
        for (int j = 0; j < 8; ++j) { const f32x4 g4 = *(const LAS f32x4*)(gate + j * 256 + lane * 4);
            x[j] = x[j] + g4 * (ov[j] * r);
            if (XOUT16) { u32x2 w; w.x = pk2(x[j].x, x[j].y); w.y = pk2(x[j].z, x[j].w); *(u32x2*)(xout16 + (size_t)m * D + j * 256 + lane * 4) = w; }
            else *(f32x4*)(xo + j * 256 + lane * 4) = x[j]; }
    }
    if (NX) {
        float ss = 0.f;
#pragma unroll
        for (int j = 0; j < 8; ++j) ss += x[j].x * x[j].x + x[j].y * x[j].y + x[j].z * x[j].z + x[j].w * x[j].w;
        const float r = 1.0f / sqrtf(wave_sum(ss) * (1.f / D) + EPS);
#pragma unroll
        for (int j = 0; j < 8; ++j) { const f32x4 s4 = *(const LAS f32x4*)(sh + j * 256 + lane * 4), c4 = *(const LAS f32x4*)(sc + j * 256 + lane * 4);
            const f32x4 v = (x[j] * r) * c4 + s4;
            u32x2 w; w.x = pk2(v.x, v.y); w.y = pk2(v.z, v.w); *(u32x2*)(xn + (size_t)m * D + j * 256 + lane * 4) = w; }
    }
}
template <bool BR, bool NX, bool XIN16, bool XOUT16>
__device__ __forceinline__ void rows8(const CP& p, int mbase, int lane, const bf16_t* xin16, bf16_t* xout16, const bf16_t* o, bf16_t* xn,
                                      const LAS float* gate, const float* gp, const LAS float* sh, const LAS float* sc, const float* gn) {
#define ROW_LD(R, mm) row_load<BR, XIN16>(R, (mm), lane, XIN16 ? nullptr : x_row(p, (mm)), xin16, o); asm volatile("" ::: "memory")
#define ROW_DO(R, mm) row_compute<BR, NX, XIN16, XOUT16>(p, R, (mm), lane, xout16, xn, gate, gp, sh, sc, gn)
    RowIn A, B; ROW_LD(A, mbase);
#pragma unroll 1
    for (int i = 0; i < 6; i += 2) {
        ROW_LD(B, mbase + i + 1); ROW_DO(A, mbase + i);
        ROW_LD(A, mbase + i + 2); ROW_DO(B, mbase + i + 1);
    }
    ROW_LD(B, mbase + 7); ROW_DO(A, mbase + 6); ROW_DO(B, mbase + 7);
#undef ROW_LD
#undef ROW_DO
}
template <int MODE>
__device__ __forceinline__ void ph_rowop(const CP& p, LAS unsigned char* L, int tid, int lane, int wave, int l, const bf16_t* o, bf16_t* xn) {
    LAS float* vg = (LAS float*)(L + RING_OFF); LAS float* vs = vg + D; LAS float* vc = vs + D;
    constexpr bool BR = MODE != 0, NX = MODE != 3;
    const int lb = l, ib = (MODE == 1) ? 0 : 3, ln = (MODE == 2) ? l + 1 : l, in_ = (MODE == 1) ? 3 : 0;
    int cur = -1;
    const bool own = gridDim.x == 256;
    for (int mb_ = blockIdx.x * 64; mb_ < M; mb_ += gridDim.x * 64) {
        const int c_ = (int)blockIdx.x, m0 = own ? (8 * (c_ % 8) + (c_ / 8) % 8) * 256 + 64 * (c_ / 64) : mb_;
        const int cls = row_class(m0);
        if (cls != cur) {
            __syncthreads();
            const float* gp = p.norm_g + (size_t)(lb * 4 + (ib == 0 ? 1 : 3)) * D; const float* gn = p.norm_g + (size_t)(ln * 4 + (in_ == 0 ? 0 : 2)) * D;
            if (BR) ld_mod<MODE != 0>(p, vg, lb, cls, ib + 2, tid);
            if (NX) { ld_mod<MODE != 0>(p, vs, ln, cls, in_, tid); ld_mod<MODE != 0>(p, vc, ln, cls, in_ + 1, tid); }
            for (int j = tid; j < D; j += NWAVES * 64) {
                if (BR) vg[j] = vg[j] * gp[j];
                if (NX) vc[j] = (vc[j] + 1.0f) * gn[j]; }
            __syncthreads(); cur = cls;
        }
        const float* gp = nullptr; const float* gn = nullptr;
        { const int mb = m0 + wave * 8;
            bf16_t* XR = (bf16_t*)(p.ws + WS_QH);
            if (MODE == 0) rows8<BR, NX, false, true>(p, mb, lane, nullptr, nullptr, o, xn, vg, gp, vs, vc, gn);
            else if (MODE == 1 && l == 0) rows8<BR, NX, false, true>(p, mb, lane, nullptr, XR, o, xn, vg, gp, vs, vc, gn);
            else if (MODE == 3) rows8<BR, NX, true, false>(p, mb, lane, XR, nullptr, o, xn, vg, gp, vs, vc, gn);
            else rows8<BR, NX, true, true>(p, mb, lane, XR, XR, o, xn, vg, gp, vs, vc, gn); }
    }
    if (MODE == 0) mod_finish(p, tid);
    __syncthreads();
}

__device__ __forceinline__ void ph_combine(const CP& p, int lane, int wave, bf16_t* OC) {
    const int gw = blockIdx.x * NWAVES + wave, NGW = gridDim.x * NWAVES;
    const bf16_t* O = (const bf16_t*)(p.ws + WS_O);
    const float* lp = p.diff_lambda;
    const float s1 = wave_sum(lp[2 * lane] * lp[128 + 2 * lane] + lp[2 * lane + 1] * lp[128 + 2 * lane + 1]);
    const float s2 = wave_sum(lp[256 + 2 * lane] * lp[384 + 2 * lane] + lp[256 + 2 * lane + 1] * lp[384 + 2 * lane + 1]);
    const float lam_init = 0.2f, lam = expf(s1) - expf(s2) + lam_init;
    for (int m = gw; m < M; m += NGW) {
        const bf16_t* orow = O + (size_t)m * D - 1024; bf16_t* oc = OC + (size_t)m * D;
#pragma unroll
        for (int h = 0; h < 4; ++h) {
            float v[2][2]; float ss = 0.f;
#pragma unroll
            for (int vh = 0; vh < 2; ++vh) {
                const unsigned w0 = *(const unsigned*)(orow + 1024 + (4 * h + vh) * 128 + 2 * lane), w1 = *(const unsigned*)(orow + 1024 + (4 * h + 2 + vh) * 128 + 2 * lane);
                v[vh][0] = __uint_as_float(w0 << 16) - lam * __uint_as_float(w1 << 16); v[vh][1] = __uint_as_float(w0 & 0xffff0000u) - lam * __uint_as_float(w1 & 0xffff0000u);
                ss += v[vh][0] * v[vh][0] + v[vh][1] * v[vh][1];
            }
            const float r = (1.0f / sqrtf(wave_sum(ss) * (1.f / 256.f) + EPS)) * (1.f - lam_init);
#pragma unroll
            for (int vh = 0; vh < 2; ++vh) { const float* g = p.diff_subln + vh * 128 + 2 * lane;
                *(unsigned*)(oc + 1024 + h * 256 + vh * 128 + 2 * lane) = pk2(v[vh][0] * r * g[0], v[vh][1] * r * g[1]); }
        }
    }
}

template <int ACT>
__device__ __forceinline__ void ph_gemm(LAS unsigned char* L, const bf16_t* A, const bf16_t* Bt, int N, int K, bf16_t* C, const bf16_t* aux, int wgm = pg8::WGM) {
    pg8::Gemm g{A, Bt, M, N, K}; pg8::StaticOrder S; S.init(M, N, (int)gridDim.x, (int)blockIdx.x, wgm);
    pg8::EpiStore<ACT> E{C, N, aux};
    pg8::gemm_phase<pg8::EpiStore<ACT>, pg8::StaticOrder, true, true>(L + RING_OFF, g, S, E);
}


__device__ __forceinline__ void ph_gemm_qkv(const CP& p, LAS unsigned char* L, const bf16_t* A, const bf16_t* Bt, int lane, int wave) {
    pg8::Gemm g{A, Bt, M, NQKV, D}; pg8::StaticOrder S; S.init(M, NQKV, (int)gridDim.x, (int)blockIdx.x);
    pg8::EpiQKV E{(bf16_t*)(p.ws + WS_QH), (bf16_t*)(p.ws + WS_KB), (bf16_t*)(p.ws + WS_VB), p.out, p.qk_norm, (const float*)(p.ws + WS_ROPE), (LAS float*)(L + 131072)};
    pg8::gemm_phase<pg8::EpiQKV, pg8::StaticOrder, true, true>(L + RING_OFF, g, S, E);
    const int G = (int)gridDim.x, nfull = 1152 / G, first_idle = 1152 - nfull * G;
    if ((int)blockIdx.x >= first_idle) ph_late_weights(p, L, lane, wave, ((int)blockIdx.x - first_idle) * NWAVES + wave, (G - first_idle) * NWAVES);
}

__device__ __forceinline__ void ph_attn(const CP& p, unsigned char* lds, bf16_t* OC) {
    const int G = gridDim.x, bx = blockIdx.x;
    const int vcu = (G % 8 == 0) ? (bx % 8) * (G / 8) + bx / 8 : bx;
    const bf16_t* QH = (const bf16_t*)(p.ws + WS_QH); const bf16_t* KBf = (const bf16_t*)(p.ws + WS_KB); const bf16_t* VBf = (const bf16_t*)(p.ws + WS_VB);
    bf16_t* O = (bf16_t*)(p.ws + WS_O);
    for (int U = vcu; U < 256; U += G) {
        const int b = U >> 7, hm = (U >> 4) & 7, qb = U & 15, qrow0 = MP + b * LQ + qb * 256, krow0 = MP + b * LKV;
        int seq = LKV; asm volatile("" : "+s"(seq));
        att::attn_wide_body<2>((const att::bf16*)(QH + (size_t)qrow0 * D + 1024 + hm * 128), (const att::bf16*)(KBf + (size_t)krow0 * KVW + 256 + hm * 128),
                            (const att::bf16*)(VBf + (size_t)krow0 * KVW + 256 + (hm >> 1) * 256), O + (size_t)qrow0 * D + hm * 256, D, seq, (char*)lds);
    }
    for (int U = vcu; U < 256; U += G) {
        const int b = U >> 7, inst = (U >> 4) & 7, qb = U & 15, qrow0 = MP + b * LQ + qb * 256, krow0 = MP + b * LKV;
        int seq = LKV; asm volatile("" : "+s"(seq));
        const int koff = (inst >> 2) * 128;
        att::attn_wide_body<1>((const att::bf16*)(QH + (size_t)qrow0 * D + inst * 128), (const att::bf16*)(KBf + (size_t)krow0 * KVW + koff),
                               (const att::bf16*)(VBf + (size_t)krow0 * KVW + koff), OC + (size_t)qrow0 * D + inst * 128, D, seq, (char*)lds);
    }
    __syncthreads();
    for (int t = vcu; t < 768; t += G) {
        const int b = (int)t / 24, inst = (int)t % 24, qrow0 = b * 256, krow0 = b * 256;
        int qoff, koff, voff, ooff;
        if (inst < 8) { qoff = inst * 128; koff = (inst >> 2) * 128; voff = koff; ooff = inst * 128; }
        else { const int i2 = inst - 8, hm = i2 >> 1, vh = i2 & 1; qoff = 1024 + hm * 128; koff = 256 + hm * 128; voff = 256 + (hm >> 1) * 256 + vh * 128; ooff = 1024 + i2 * 128; }
        bf16_t* op = (inst < 8) ? OC + (size_t)qrow0 * D + ooff : O + (size_t)qrow0 * D + (ooff - 1024);
        att::attn_small_body((const att::bf16*)(QH + (size_t)qrow0 * D + qoff), (const att::bf16*)(KBf + (size_t)krow0 * KVW + koff),
                             (const att::bf16*)(VBf + (size_t)krow0 * KVW + voff), op, D, (char*)lds);
    }
}


typedef short s16x8 __attribute__((ext_vector_type(8)));
typedef float f32x16 __attribute__((ext_vector_type(16)));
constexpr int SSM_IMG_ROW = 272, SSM_IMG = 16 * SSM_IMG_ROW, SSM_YBUF = 8192, SSM_WAVE_LDS = 2 * SSM_IMG + SSM_YBUF;
__device__ __forceinline__ float gelu_fast(float v) { const float u = 0.7978845608028654f * (v + 0.044715f * v * v * v); return v * __builtin_amdgcn_rcpf(1.f + __builtin_amdgcn_exp2f(-2.8853900817779268f * u)); }
struct SsmItem {
    f32x2 alo, ahi; const s16x8* BB; const s16x8* CM; unsigned fo; f32x4 dd4; unsigned uo; int ustep; const bf16_t* U; bf16_t* Z; int t0, g, hh;
    LAS unsigned char* img; LAS unsigned char* ybuf; int nn, half, ti, cq;
};
template <int MODE>
__device__ __forceinline__ void ssm_tile(const SsmItem& S, int tau, f32x16 (&acur)[4], f32x16 (&anxt)[4], const s16x8& ux, s16x8& uy, f32x2& hlo, f32x2& hhi, u32x2& uf4n, u32x2& ub4n, s16x8 (&bfw)[4], s16x8 (&bbw)[4]) {
    const u32x2 uf4 = uf4n, ub4 = ub4n;
    if (tau + 2 < 16) uy = *(const s16x8*)(S.U + (unsigned)((int)S.uo + (tau + 2) * S.ustep));
    if (MODE == 1 && tau >= 7 && tau < 15) {
        uf4n = *(const u32x2*)(S.U + (unsigned)((S.t0 + 16 * (tau + 1) + S.ti) * D + 16 * S.g + 4 * S.cq));
        ub4n = *(const u32x2*)(S.U + (unsigned)((S.t0 + 255 - 16 * (tau + 1) - S.ti) * D + 16 * S.g + 4 * S.cq)); }
    if (tau + 1 < 16) {
        const s16x8 z8 = {0, 0, 0, 0, 0, 0, 0, 0};
        const s16x8 uf = S.hh ? z8 : ux, ub = S.hh ? ux : z8;
#pragma unroll
        for (int q = 0; q < 4; ++q) { anxt[q] = __builtin_amdgcn_mfma_f32_32x32x16_bf16(uf, bfw[q], (f32x16){0.f}, 0, 0, 0); anxt[q] = __builtin_amdgcn_mfma_f32_32x32x16_bf16(ub, bbw[q], anxt[q], 0, 0, 0); }
    }
    const f32x2 alo = S.alo, ahi = S.ahi;
    s16x8 cfw[4], cbw[4];
#pragma unroll
    for (int i = 0; i < 16; ++i) {
        float lr = __builtin_fmaf(alo.x, hlo.x, __builtin_fmaf(-alo.y, hlo.y, acur[0][i])); asm volatile("" : "+v"(lr));
        float li = __builtin_fmaf(alo.x, hlo.y, __builtin_fmaf(alo.y, hlo.x, acur[2][i])); asm volatile("" : "+v"(li));
        float hr = __builtin_fmaf(ahi.x, hhi.x, __builtin_fmaf(-ahi.y, hhi.y, acur[1][i])); asm volatile("" : "+v"(hr));
        float hi2 = __builtin_fmaf(ahi.x, hhi.y, __builtin_fmaf(ahi.y, hhi.x, acur[3][i])); asm volatile("" : "+v"(hi2));
        hlo = (f32x2){lr, li}; hhi = (f32x2){hr, hi2};
        if (MODE == 1) { u32x2 w; w.x = pk2(lr, li); w.y = pk2(hr, hi2); *(LAS u32x2*)(S.img + S.half * SSM_IMG + i * SSM_IMG_ROW + S.nn * 8) = w; }
        if (MODE == 1 && i == 11 && tau + 2 < 16) {
            asm volatile("" ::: "memory");
#pragma unroll
            for (int q = 0; q < 4; ++q) { bfw[q] = S.BB[S.fo + q * 64]; bbw[q] = S.BB[S.fo + 32768u + q * 64]; }
        }
        if (MODE == 1 && i == 7) {
            asm volatile("" ::: "memory");
#pragma unroll
            for (int q = 0; q < 4; ++q) { cfw[q] = S.CM[S.fo + q * 64]; cbw[q] = S.CM[S.fo + 32768u + q * 64]; }
        }
    }
    if (MODE == 1) {
        const int ti = S.ti, cq = S.cq, g = S.g, t0 = S.t0;
        asm volatile("" ::: "memory");
        f32x4 y0 = {0.f, 0.f, 0.f, 0.f}, y1 = {0.f, 0.f, 0.f, 0.f};
#pragma unroll
        for (int s = 0; s < 4; ++s) {
            const s16x8 b0 = *(const LAS s16x8*)(S.img + ti * SSM_IMG_ROW + 64 * s + 16 * cq), b1 = *(const LAS s16x8*)(S.img + SSM_IMG + ti * SSM_IMG_ROW + 64 * s + 16 * cq);
            y0 = __builtin_amdgcn_mfma_f32_16x16x32_bf16(cfw[s], b0, y0, 0, 0, 0); y1 = __builtin_amdgcn_mfma_f32_16x16x32_bf16(cbw[s], b1, y1, 0, 0, 0);
        }
        asm volatile("s_nop 15\n\ts_nop 7" : "+v"(y0), "+v"(y1) :: "memory");
        LAS unsigned char* af = S.ybuf + tau * 512 + ti * 32 + 8 * cq; LAS unsigned char* ab = S.ybuf + (15 - tau) * 512 + (15 - ti) * 32 + 8 * cq;
        if (tau < 8) {
            u32x2 w; w.x = pk2(y0[0], y0[1]); w.y = pk2(y0[2], y0[3]); *(LAS u32x2*)af = w;
            w.x = pk2(y1[0], y1[1]); w.y = pk2(y1[2], y1[3]); *(LAS u32x2*)ab = w;
        } else {
            const u32x2 sf = *(const LAS u32x2*)af, sb = *(const LAS u32x2*)ab;
            const unsigned tokf = (unsigned)(t0 + 16 * tau + ti), tokb = (unsigned)(t0 + 255 - 16 * tau - ti);
            f32x4 tf = y0 + (f32x4){__uint_as_float(sf.x << 16), __uint_as_float(sf.x & 0xffff0000u), __uint_as_float(sf.y << 16), __uint_as_float(sf.y & 0xffff0000u)};
            f32x4 tb = y1 + (f32x4){__uint_as_float(sb.x << 16), __uint_as_float(sb.x & 0xffff0000u), __uint_as_float(sb.y << 16), __uint_as_float(sb.y & 0xffff0000u)};
            tf = tf + S.dd4 * (f32x4){__uint_as_float(uf4.x << 16), __uint_as_float(uf4.x & 0xffff0000u), __uint_as_float(uf4.y << 16), __uint_as_float(uf4.y & 0xffff0000u)};
            tb = tb + S.dd4 * (f32x4){__uint_as_float(ub4.x << 16), __uint_as_float(ub4.x & 0xffff0000u), __uint_as_float(ub4.y << 16), __uint_as_float(ub4.y & 0xffff0000u)};
            u32x2 w; w.x = pk2(gelu_fast(tf[0]), gelu_fast(tf[1])); w.y = pk2(gelu_fast(tf[2]), gelu_fast(tf[3])); *(u32x2*)(S.Z + (tokf * D + 16 * g + 4 * cq)) = w;
            w.x = pk2(gelu_fast(tb[0]), gelu_fast(tb[1])); w.y = pk2(gelu_fast(tb[2]), gelu_fast(tb[3])); *(u32x2*)(S.Z + (tokb * D + 16 * g + 4 * cq)) = w;
        }
        asm volatile("" ::: "memory");
    }
}
template <int MODE  >
__device__ __forceinline__ void ph_ssm_scan(const CP& p, LAS unsigned char* L, int lane, int wave, const bf16_t* U, bf16_t* Z) {
    const int gw = blockIdx.x * NWAVES + wave, NGW = gridDim.x * NWAVES;
    const f32x2* ABAR = (const f32x2*)(p.ws + WS_ABAR); const f32x2* SST = (const f32x2*)(p.ws + WS_SST);
    const s16x8* BBAR = (const s16x8*)(p.ws + WS_BBAR); const s16x8* CMAT = (const s16x8*)(p.ws + WS_CMAT);
    constexpr int NITEMS = (MODE == 0 ? 32 : 64) * 128;
    SsmItem S;
    S.img = L + RING_OFF + wave * SSM_WAVE_LDS; S.ybuf = S.img + 2 * SSM_IMG;
    S.nn = lane & 31; S.half = lane >> 5; S.ti = lane & 15; S.cq = lane >> 4; S.U = U; S.Z = Z;
    const int nn = S.nn, half = S.half;
#pragma unroll 1
    for (int it = gw; it < NITEMS; it += NGW) {
        const int g = it & 127, ci = it >> 7;
        const bool samp = (MODE == 0) || ci >= 32; const int sc = (MODE == 0) ? ci : ci - 32;
        const int t0 = samp ? MP + sc * 256 : ci * 256;
        const int pidx = (half * 128 + g) * 64;
        S.g = g; S.t0 = t0;
        S.alo = ABAR[pidx + nn]; S.ahi = ABAR[pidx + nn + 32];
        S.BB = BBAR; S.CM = CMAT; S.fo = (unsigned)(g * 256 + lane);
        s16x8 bfw[4], bbw[4];
#pragma unroll
        for (int q = 0; q < 4; ++q) { bfw[q] = BBAR[S.fo + q * 64]; bbw[q] = BBAR[S.fo + 32768u + q * 64]; }
        f32x2 hlo = {0.f, 0.f}, hhi = {0.f, 0.f};
        if (MODE == 1 && samp) {
            const int bq = sc >> 4, cq2 = sc & 15; const f32x2* A256 = (const f32x2*)(p.ws + WS_A256);
            const f32x2 qlo = A256[pidx + nn], qhi = A256[pidx + nn + 32];
            const float* st = p.state_ssm + ((size_t)(bq * 2 + half) * 128 + g) * 128;
            hlo = (f32x2){st[2 * nn], st[2 * nn + 1]}; hhi = (f32x2){st[2 * nn + 64], st[2 * nn + 65]};
            const int nst = half ? 15 - cq2 : cq2;
            f32x2 s0[15], s1[15];
#pragma unroll
            for (int k = 0; k < 15; ++k) { const int j = half ? 15 - k : k; const size_t o = ((size_t)((bq * 16 + j) * 2 + half) * 128 + g) * 64; s0[k] = SST[o + nn]; s1[k] = SST[o + nn + 32]; }
#pragma unroll
            for (int k = 0; k < 15; ++k) {
                const f32x2 nl = {qlo.x * hlo.x - qlo.y * hlo.y + s0[k].x, qlo.x * hlo.y + qlo.y * hlo.x + s0[k].y};
                const f32x2 nh = {qhi.x * hhi.x - qhi.y * hhi.y + s1[k].x, qhi.x * hhi.y + qhi.y * hhi.x + s1[k].y};
                hlo = (k < nst) ? nl : hlo; hhi = (k < nst) ? nh : hhi;
            }
        }
        const int r = lane & 31, hh = (r >> 2) & 1, si = 4 * (r >> 3) + (r & 3);
        S.hh = hh;
        S.uo = (unsigned)((hh ? t0 + 255 - si : t0 + si) * D + 16 * g + 8 * (lane >> 5));
        S.ustep = hh ? -16 * D : 16 * D;
        S.dd4 = *(const f32x4*)(p.ssm_d + 16 * g + 4 * S.cq);
        const s16x8 u0 = *(const s16x8*)(U + S.uo); s16x8 uX = *(const s16x8*)(U + (unsigned)((int)S.uo + S.ustep)), uY = uX;
        u32x2 uf4n = {0u, 0u}, ub4n = {0u, 0u};
        f32x16 accA[4], accB[4];
        { const s16x8 z8 = {0, 0, 0, 0, 0, 0, 0, 0}; const s16x8 uf = hh ? z8 : u0, ub = hh ? u0 : z8;
#pragma unroll
          for (int q = 0; q < 4; ++q) { accA[q] = __builtin_amdgcn_mfma_f32_32x32x16_bf16(uf, bfw[q], (f32x16){0.f}, 0, 0, 0); accA[q] = __builtin_amdgcn_mfma_f32_32x32x16_bf16(ub, bbw[q], accA[q], 0, 0, 0); } }
#pragma unroll 1
        for (int tau = 0; tau < 16; tau += 2) {
            ssm_tile<MODE>(S, tau, accA, accB, uX, uY, hlo, hhi, uf4n, ub4n, bfw, bbw);
            ssm_tile<MODE>(S, tau + 1, accB, accA, uY, uX, hlo, hhi, uf4n, ub4n, bfw, bbw);
        }
        if (MODE == 0) { f32x2* o = (f32x2*)(p.ws + WS_SST) + ((size_t)(sc * 2 + half) * 128 + g) * 64; o[nn] = hlo; o[nn + 32] = hhi; }
        else if (!samp) { f32x2* o = (f32x2*)(p.out + OUT_ST) + ((size_t)(ci * 2 + half) * 128 + g) * 64; o[nn] = hlo; o[nn + 32] = hhi; }
    }
}
__device__ __forceinline__ void ph_ssm_state4(const CP& p, int lane, int wave, const bf16_t* U) {
    const int gw = blockIdx.x * NWAVES + wave, NGW = gridDim.x * NWAVES;
    const int nn = lane & 31, half = lane >> 5;
    const f32x2* A4 = (const f32x2*)(p.ws + WS_A4); const s16x8* BB4 = (const s16x8*)(p.ws + WS_BB4);
    const int r = lane & 31, hh = (r >> 2) & 1, sg = 4 * (r >> 3) + (r & 3);
    int gcur = -1; s16x8 bf4[4][4], bb4[4][4]; f32x2 alo = {0.f, 0.f}, ahi = {0.f, 0.f};
#pragma unroll 1
    for (int it = gw; it < 32 * 128; it += NGW) {
        const int g = it & 127, sc = it >> 7, t0 = MP + sc * 256;
        if (g != gcur) {
#pragma unroll
            for (int j = 0; j < 4; ++j)
#pragma unroll
                for (int q = 0; q < 4; ++q) { bf4[j][q] = BB4[((size_t)(j * 256 + g) * 4 + q) * 64 + lane]; bb4[j][q] = BB4[((size_t)(j * 256 + 128 + g) * 4 + q) * 64 + lane]; }
            const int pidx = (half * 128 + g) * 64; alo = A4[pidx + nn]; ahi = A4[pidx + nn + 32]; gcur = g;
        }
        const bf16_t* ua = U + ((size_t)(t0 >> 8) * 128 + g) * 4096 + (hh ? 255 - 4 * sg : 4 * sg) * 16 + 8 * (lane >> 5);
        const long js = hh ? -16L : 16L;
        s16x8 u[4];
#pragma unroll
        for (int j = 0; j < 4; ++j) u[j] = *(const s16x8*)(ua + j * js);
        f32x2 hlo = {0.f, 0.f}, hhi = {0.f, 0.f};
#pragma unroll 1
        for (int m = 0; m < 4; ++m) {
            f32x16 acc[4]; const s16x8 z8 = {0, 0, 0, 0, 0, 0, 0, 0};
#pragma unroll
            for (int j = 0; j < 4; ++j) { const s16x8 uf = hh ? z8 : u[j], ub = hh ? u[j] : z8;
#pragma unroll
                for (int q = 0; q < 4; ++q) {
                    if (j == 0) acc[q] = __builtin_amdgcn_mfma_f32_32x32x16_bf16(uf, bf4[j][q], (f32x16){0.f}, 0, 0, 0); else acc[q] = __builtin_amdgcn_mfma_f32_32x32x16_bf16(uf, bf4[j][q], acc[q], 0, 0, 0);
                    acc[q] = __builtin_amdgcn_mfma_f32_32x32x16_bf16(ub, bb4[j][q], acc[q], 0, 0, 0); } }
            const long mo = (long)(m + 1 < 4 ? m + 1 : 3) * 64 * js;
#pragma unroll
            for (int j = 0; j < 4; ++j) u[j] = *(const s16x8*)(ua + mo + j * js);
#pragma unroll
            for (int i = 0; i < 16; ++i) {
                float lr = __builtin_fmaf(alo.x, hlo.x, __builtin_fmaf(-alo.y, hlo.y, acc[0][i])); asm volatile("" : "+v"(lr));
                float li = __builtin_fmaf(alo.x, hlo.y, __builtin_fmaf(alo.y, hlo.x, acc[2][i])); asm volatile("" : "+v"(li));
                float hr = __builtin_fmaf(ahi.x, hhi.x, __builtin_fmaf(-ahi.y, hhi.y, acc[1][i])); asm volatile("" : "+v"(hr));
                float hi2 = __builtin_fmaf(ahi.x, hhi.y, __builtin_fmaf(ahi.y, hhi.x, acc[3][i])); asm volatile("" : "+v"(hi2));
                hlo = (f32x2){lr, li}; hhi = (f32x2){hr, hi2};
            }
        }
        f32x2* o = (f32x2*)(p.ws + WS_SST) + ((size_t)(sc * 2 + half) * 128 + g) * 64; o[nn] = hlo; o[nn + 32] = hhi;
    }
}
template <int MODE  >
__device__ __forceinline__ void ph_ssm_scan_np(const CP& p, LAS unsigned char* L, int lane, int wave, const bf16_t* U, bf16_t* Z) {
    const int gw = blockIdx.x * NWAVES + wave, NGW = gridDim.x * NWAVES;
    LAS unsigned char* img = L + RING_OFF + wave * SSM_WAVE_LDS;
    LAS unsigned char* ybuf = img + 2 * SSM_IMG;
    const int nn = lane & 31, half = lane >> 5, ti = lane & 15, cq = lane >> 4;
    const f32x2* ABAR = (const f32x2*)(p.ws + WS_ABAR); const f32x2* SST = (const f32x2*)(p.ws + WS_SST);
    const s16x8* BBAR = (const s16x8*)(p.ws + WS_BBAR); const s16x8* CMAT = (const s16x8*)(p.ws + WS_CMAT);
    constexpr int NITEMS = (MODE == 0 ? 32 : 64) * 128;
#pragma unroll 1
    for (int it = gw; it < NITEMS; it += NGW) {
        const int g = it & 127, ci = it >> 7;
        const bool samp = (MODE == 0) || ci >= 32; const int sc = (MODE == 0) ? ci : ci - 32;
        const int t0 = samp ? MP + sc * 256 : ci * 256;
        const int pidx = (half * 128 + g) * 64;
        const f32x2 alo = ABAR[pidx + nn], ahi = ABAR[pidx + nn + 32];
        s16x8 bfw[4], bbw[4], cfw[4], cbw[4];
#pragma unroll
        for (int q = 0; q < 4; ++q) { bfw[q] = BBAR[((size_t)(0 * 128 + g) * 4 + q) * 64 + lane]; bbw[q] = BBAR[((size_t)(1 * 128 + g) * 4 + q) * 64 + lane]; }
        if (MODE == 1) {
#pragma unroll
            for (int q = 0; q < 4; ++q) { cfw[q] = CMAT[((size_t)(0 * 128 + g) * 4 + q) * 64 + lane]; cbw[q] = CMAT[((size_t)(1 * 128 + g) * 4 + q) * 64 + lane]; }
        }
        f32x2 hlo = {0.f, 0.f}, hhi = {0.f, 0.f};
        if (MODE == 1 && samp) {
            const int bq = sc >> 4, cq2 = sc & 15; const f32x2* A256 = (const f32x2*)(p.ws + WS_A256);
            const f32x2 qlo = A256[pidx + nn], qhi = A256[pidx + nn + 32];
            const float* st = p.state_ssm + ((size_t)(bq * 2 + half) * 128 + g) * 128;
            hlo = (f32x2){st[2 * nn], st[2 * nn + 1]}; hhi = (f32x2){st[2 * nn + 64], st[2 * nn + 65]};
            const int nst = half ? 15 - cq2 : cq2;
            f32x2 s0[15], s1[15];
#pragma unroll
            for (int k = 0; k < 15; ++k) { const int j = half ? 15 - k : k; const size_t o = ((size_t)((bq * 16 + j) * 2 + half) * 128 + g) * 64; s0[k] = SST[o + nn]; s1[k] = SST[o + nn + 32]; }
#pragma unroll
            for (int k = 0; k < 15; ++k) {
                const f32x2 nl = {qlo.x * hlo.x - qlo.y * hlo.y + s0[k].x, qlo.x * hlo.y + qlo.y * hlo.x + s0[k].y};
                const f32x2 nh = {qhi.x * hhi.x - qhi.y * hhi.y + s1[k].x, qhi.x * hhi.y + qhi.y * hhi.x + s1[k].y};
                hlo = (k < nst) ? nl : hlo; hhi = (k < nst) ? nh : hhi;
            }
        }
        const int r = lane & 31, hh = (r >> 2) & 1, si = 4 * (r >> 3) + (r & 3);
        bf16_t* zg = Z + ((size_t)(t0 >> 8) * 128 + g) * 4096;
        const bf16_t* ug = U + ((size_t)(t0 >> 8) * 128 + g) * 4096;
        const bf16_t* ua = ug + (hh ? 255 - si : si) * 16 + 8 * (lane >> 5);
        const long ustep = hh ? -256L : 256L;
        const f32x4 dd4 = *(const f32x4*)(p.ssm_d + 16 * g + 4 * cq);
        const s16x8 z8 = {0, 0, 0, 0, 0, 0, 0, 0};
        s16x8 un = *(const s16x8*)(ua + ustep);
        u32x2 uf4n = {0u, 0u}, ub4n = {0u, 0u};
        f32x16 acc[4];
        { const s16x8 u0 = *(const s16x8*)ua; const s16x8 uf = hh ? z8 : u0, ub = hh ? u0 : z8;
#pragma unroll
          for (int q = 0; q < 4; ++q) { acc[q] = __builtin_amdgcn_mfma_f32_32x32x16_bf16(uf, bfw[q], (f32x16){0.f}, 0, 0, 0); acc[q] = __builtin_amdgcn_mfma_f32_32x32x16_bf16(ub, bbw[q], acc[q], 0, 0, 0); } }
#define SSM_NP_TILE(FIN_) do { \
            const s16x8 uc = un; const u32x2 uf4 = uf4n, ub4 = ub4n; \
            un = *(const s16x8*)(ua + (long)(tau + 2 < 16 ? tau + 2 : 15) * ustep); \
            if (MODE == 1) { const int tn_ = FIN_ ? (tau + 1 < 16 ? tau + 1 : 15) : 8; \
                uf4n = *(const u32x2*)(ug + (16 * tn_ + ti) * 16 + 4 * cq); \
                ub4n = *(const u32x2*)(ug + (255 - 16 * tn_ - ti) * 16 + 4 * cq); } \
_Pragma("unroll") \
            for (int i = 0; i < 16; ++i) { \
                float lr = __builtin_fmaf(alo.x, hlo.x, __builtin_fmaf(-alo.y, hlo.y, acc[0][i])); asm volatile("" : "+v"(lr)); \
                float li = __builtin_fmaf(alo.x, hlo.y, __builtin_fmaf(alo.y, hlo.x, acc[2][i])); asm volatile("" : "+v"(li)); \
                float hr = __builtin_fmaf(ahi.x, hhi.x, __builtin_fmaf(-ahi.y, hhi.y, acc[1][i])); asm volatile("" : "+v"(hr)); \
                float hi2 = __builtin_fmaf(ahi.x, hhi.y, __builtin_fmaf(ahi.y, hhi.x, acc[3][i])); asm volatile("" : "+v"(hi2)); \
                hlo = (f32x2){lr, li}; hhi = (f32x2){hr, hi2}; \
                if (MODE == 1) { u32x2 w; w.x = pk2(lr, li); w.y = pk2(hr, hi2); *(LAS u32x2*)(img + half * SSM_IMG + i * SSM_IMG_ROW + nn * 8) = w; } \
            } \
            if (!FIN_ || tau < 15) { \
                const s16x8 uf = hh ? z8 : uc, ub = hh ? uc : z8; \
_Pragma("unroll") \
                for (int q = 0; q < 4; ++q) { acc[q] = __builtin_amdgcn_mfma_f32_32x32x16_bf16(uf, bfw[q], (f32x16){0.f}, 0, 0, 0); acc[q] = __builtin_amdgcn_mfma_f32_32x32x16_bf16(ub, bbw[q], acc[q], 0, 0, 0); } \
            } \
            if (MODE == 1) { \
                asm volatile("" ::: "memory"); \
                f32x4 y0 = {0.f, 0.f, 0.f, 0.f}, y1 = {0.f, 0.f, 0.f, 0.f}; \
_Pragma("unroll") \
                for (int s = 0; s < 4; ++s) { \
                    const s16x8 b0 = *(const LAS s16x8*)(img + ti * SSM_IMG_ROW + 64 * s + 16 * cq), b1 = *(const LAS s16x8*)(img + SSM_IMG + ti * SSM_IMG_ROW + 64 * s + 16 * cq); \
                    y0 = __builtin_amdgcn_mfma_f32_16x16x32_bf16(cfw[s], b0, y0, 0, 0, 0); y1 = __builtin_amdgcn_mfma_f32_16x16x32_bf16(cbw[s], b1, y1, 0, 0, 0); \
                } \
                asm volatile("s_nop 15\n\ts_nop 7" : "+v"(y0), "+v"(y1) :: "memory"); \
                LAS unsigned char* af = ybuf + tau * 512 + ti * 32 + 8 * cq; LAS unsigned char* ab = ybuf + (15 - tau) * 512 + (15 - ti) * 32 + 8 * cq; \
                if (!FIN_) { \
                    u32x2 w; w.x = pk2(y0[0], y0[1]); w.y = pk2(y0[2], y0[3]); *(LAS u32x2*)af = w; \
                    w.x = pk2(y1[0], y1[1]); w.y = pk2(y1[2], y1[3]); *(LAS u32x2*)ab = w; \
                } else { \
                    const u32x2 sf = *(const LAS u32x2*)af, sb = *(const LAS u32x2*)ab; \
                    const size_t tokf = (size_t)(t0 + 16 * tau + ti), tokb = (size_t)(t0 + 255 - 16 * tau - ti); \
                    f32x4 tf = y0 + (f32x4){__uint_as_float(sf.x << 16), __uint_as_float(sf.x & 0xffff0000u), __uint_as_float(sf.y << 16), __uint_as_float(sf.y & 0xffff0000u)}; \
                    f32x4 tb = y1 + (f32x4){__uint_as_float(sb.x << 16), __uint_as_float(sb.x & 0xffff0000u), __uint_as_float(sb.y << 16), __uint_as_float(sb.y & 0xffff0000u)}; \
                    tf = tf + dd4 * (f32x4){__uint_as_float(uf4.x << 16), __uint_as_float(uf4.x & 0xffff0000u), __uint_as_float(uf4.y << 16), __uint_as_float(uf4.y & 0xffff0000u)}; \
                    tb = tb + dd4 * (f32x4){__uint_as_float(ub4.x << 16), __uint_as_float(ub4.x & 0xffff0000u), __uint_as_float(ub4.y << 16), __uint_as_float(ub4.y & 0xffff0000u)}; \
                    u32x2 w; w.x = pk2(gelu_fast(tf[0]), gelu_fast(tf[1])); w.y = pk2(gelu_fast(tf[2]), gelu_fast(tf[3])); *(u32x2*)(zg + (16 * tau + ti) * 16 + 4 * cq) = w; \
                    w.x = pk2(gelu_fast(tb[0]), gelu_fast(tb[1])); w.y = pk2(gelu_fast(tb[2]), gelu_fast(tb[3])); *(u32x2*)(zg + (255 - 16 * tau - ti) * 16 + 4 * cq) = w; \
                } \
                asm volatile("" ::: "memory"); \
            } \
        } while (0)
#pragma unroll 1
        for (int tau = 0; tau < 8; ++tau) SSM_NP_TILE(false);
#pragma unroll 1
        for (int tau = 8; tau < 16; ++tau) SSM_NP_TILE(true);
#undef SSM_NP_TILE
        if (MODE == 0) { f32x2* o = (f32x2*)(p.ws + WS_SST) + ((size_t)(sc * 2 + half) * 128 + g) * 64; o[nn] = hlo; o[nn + 32] = hhi; }
        else if (!samp) { f32x2* o = (f32x2*)(p.out + OUT_ST) + ((size_t)(ci * 2 + half) * 128 + g) * 64; o[nn] = hlo; o[nn + 32] = hhi; }
    }
}

#ifndef UP_WGM
#define UP_WGM 4
#endif
enum Phase { PH_PRO = 0, PH_XN0, PH_QKV, PH_ATTN, PH_COMBINE, PH_AO, PH_ROW1_0, PH_UP0, PH_DOWN0, PH_ROW2_0, PH_SSMIN, PH_SSMA, PH_SSM, PH_GLU, PH_SO, PH_ROW1_1, PH_UP1, PH_DOWN1, PH_ROW3, PH_N };
__global__ void __launch_bounds__(NWAVES * 64, 2) mk_fwd(Params p_, int ph_lo, int ph_hi, int li) {
    const CP& p = *(const CP*)__builtin_amdgcn_kernarg_segment_ptr();
    extern __shared__ __attribute__((aligned(16))) unsigned char lds[];
    LAS unsigned char* L = (LAS unsigned char*)lds;
    volatile LAS unsigned* MISC = (volatile LAS unsigned*)(L + MISC_OFF);
    const int tid = threadIdx.x, lane = tid & 63, wave = __builtin_amdgcn_readfirstlane(tid >> 6);
    for (int u = tid; u < (LDS_BYTES - LDSCTL_OFF) / 4; u += NWAVES * 64) ((LAS unsigned*)(L + LDSCTL_OFF))[u] = 0u;
    __syncthreads();
    XcdBarrier bar = xcd_barrier_post((unsigned*)(p.ws + WS_CTL) + CW_BAR + li * XCD_BAR_WORDS, MISC + 8);
    unsigned char* ws = p.ws; unsigned char* wb = ws + WS_W;
    bf16_t* A1 = (bf16_t*)(ws + WS_A1); bf16_t* A2 = (bf16_t*)(ws + WS_A2); bf16_t* BIG = (bf16_t*)(ws + WS_BIG);
#define IN(k) (ph_lo <= (k) && (k) < ph_hi)
#define SEAM(k) do { if (IN(k) && IN((k) + 1)) xcd_barrier(bar); } while (0)
    if (IN(PH_PRO)) { ph_prologue(p, L, lane, wave); } SEAM(PH_PRO);
    if (IN(PH_XN0)) { ph_rowop<0>(p, L, tid, lane, wave, 0, nullptr, A1); } SEAM(PH_XN0);
    if (IN(PH_QKV)) { ph_gemm_qkv(p, L, A1, (const bf16_t*)(wb + WO_QKV), lane, wave); } SEAM(PH_QKV);
    if (IN(PH_ATTN)) { ph_attn(p, lds, A1); }
    SEAM(PH_ATTN);
    if (IN(PH_COMBINE)) { ph_combine(p, lane, wave, A1); } SEAM(PH_COMBINE);
    if (IN(PH_AO)) { ph_gemm<0>(L, A1, (const bf16_t*)(wb + WO_AO), D, D, A2, nullptr); } SEAM(PH_AO);
    if (IN(PH_ROW1_0)) { ph_rowop<1>(p, L, tid, lane, wave, 0, A2, A1); } SEAM(PH_ROW1_0);
    if (IN(PH_UP0)) { ph_gemm<1>(L, A1, (const bf16_t*)(wb + WO_W1), DFF, D, BIG, nullptr, UP_WGM); } SEAM(PH_UP0);
    if (IN(PH_DOWN0)) { ph_gemm<0>(L, BIG, (const bf16_t*)(wb + WO_W2), D, DFF, A2, nullptr); } SEAM(PH_DOWN0);
    if (IN(PH_ROW2_0)) { ph_rowop<2>(p, L, tid, lane, wave, 0, A2, A1); } SEAM(PH_ROW2_0);
    if (IN(PH_SSMIN)) { ph_gemm<3>(L, A1, (const bf16_t*)(wb + WO_SI), D, D, A2, nullptr); } SEAM(PH_SSMIN);
    if (IN(PH_SSMA)) { ph_ssm_state4(p, lane, wave, A2); } SEAM(PH_SSMA);
    if (IN(PH_SSM)) { ph_ssm_scan_np<1>(p, L, lane, wave, A2, A1); }
    SEAM(PH_SSM);
    if (IN(PH_GLU)) { ph_gemm<2>(L, A1, (const bf16_t*)(wb + WO_GL), D, D, A2, A1); } SEAM(PH_GLU);
    if (IN(PH_SO)) { ph_gemm<0>(L, A2, (const bf16_t*)(wb + WO_SO), D, D, A1, nullptr); } SEAM(PH_SO);
    if (IN(PH_ROW1_1)) { ph_rowop<1>(p, L, tid, lane, wave, 1, A1, A2); } SEAM(PH_ROW1_1);
    if (IN(PH_UP1)) { ph_gemm<1>(L, A2, (const bf16_t*)(wb + WO_W1 + 32 * MiB), DFF, D, BIG, nullptr, UP_WGM); } SEAM(PH_UP1);
    if (IN(PH_DOWN1)) { ph_gemm<0>(L, BIG, (const bf16_t*)(wb + WO_W2 + 32 * MiB), D, DFF, A1, nullptr); } SEAM(PH_DOWN1);
    if (IN(PH_ROW3)) { ph_rowop<3>(p, L, tid, lane, wave, 1, A1, nullptr); }
#undef IN
#undef SEAM
}

extern "C" void kernel_launch(void* const* d_in, const int* in_sizes, int n_in, void* d_out, int out_size, void* d_ws, size_t ws_size, hipStream_t stream) {
    static int grid = 0;
    if (grid == 0) {
        if (n_in != 30 || out_size != (int)OUT_END || ws_size < WS_END) { fprintf(stderr, "kernel_launch: unexpected shapes: n_in %d out %d ws %zu (need %zu)\n", n_in, out_size, ws_size, (size_t)WS_END); grid = -1; return; }
        int dev = 0, cus = 0;
        if (hipGetDevice(&dev) != hipSuccess || hipDeviceGetAttribute(&cus, hipDeviceAttributeMultiprocessorCount, dev) != hipSuccess) { grid = -1; return; }
        if (hipFuncSetAttribute((const void*)mk_fwd, hipFuncAttributeMaxDynamicSharedMemorySize, LDS_BYTES) != hipSuccess) { fprintf(stderr, "kernel_launch: hipFuncSetAttribute failed\n"); grid = -1; return; }
        int per_cu = 0;
        if (hipOccupancyMaxActiveBlocksPerMultiprocessor(&per_cu, (const void*)mk_fwd, NWAVES * 64, LDS_BYTES) != hipSuccess || per_cu < 1) fprintf(stderr, "kernel_launch: occupancy query reports %d\n", per_cu);
        (void)hipGetLastError();
        grid = cus;
    }
    if (grid < 0) return;
    Params p{};
    const float** pp = (const float**)&p;
    for (int i = 0; i < 30; ++i) pp[i] = (const float*)d_in[i];
    p.out = (float*)d_out; p.ws = (unsigned char*)d_ws;
    unsigned char* ws = p.ws;
    bf16_t* A1 = (bf16_t*)(ws + WS_A1); bf16_t* A2 = (bf16_t*)(ws + WS_A2); bf16_t* BIG = (bf16_t*)(ws + WS_BIG);
    (void)hipMemsetAsync(ws + WS_CTL, 0, 1 * MiB, stream);
    int li = 0;
#if ONE_PER_PHASE
    for (int ph = PH_PRO; ph < PH_N; ++ph) hipLaunchKernelGGL(mk_fwd, dim3(grid), dim3(NWAVES * 64), LDS_BYTES, stream, p, ph, ph + 1, li++);
#else
    hipLaunchKernelGGL(mk_fwd, dim3(grid), dim3(NWAVES * 64), LDS_BYTES, stream, p, (int)PH_PRO, (int)PH_N, li++);
#endif
    const hipError_t le = hipPeekAtLastError();
    if (le != hipSuccess) fprintf(stderr, "kernel_launch: launch failed: %s\n", hipGetErrorName(le));
}
```

```cpp
#include <hip/hip_runtime.h>
#include <hip/hip_bf16.h>
#include <cstdio>
#include <cstdint>

typedef unsigned short bf16_t;
typedef float f32x4 __attribute__((ext_vector_type(4)));
typedef float f32x2 __attribute__((ext_vector_type(2)));
typedef unsigned u32x4 __attribute__((ext_vector_type(4)));
typedef unsigned u32x2 __attribute__((ext_vector_type(2)));

constexpr int D = 2048, MP = 8192, MS = 8192, M = MP + MS, NQKV = 4608, DFF = 8192;
constexpr int LQ = 4096, LKV = 4352, NMOD = 12288;
constexpr int KB_ROWS = MP + 2 * LKV;
constexpr int KVW = 1280;
constexpr int OW = 3072;
constexpr float EPS = 1e-6f;
constexpr int KCH = 16;

constexpr size_t OUT_Y = 0, OUT_AK = 33554432, OUT_AV = 35651584, OUT_BK = 37748736, OUT_BV = 46137344, OUT_ST = 54525952, OUT_END = 55574528;

constexpr size_t MiB = 1u << 20;
constexpr size_t WS_CTL = 0, WS_MODP = 1 * MiB, WS_MOD = 6 * MiB, WS_ABAR = 7 * MiB, WS_A256 = 7 * MiB + 512 * 1024, WS_BBAR = 8 * MiB, WS_CMAT = 9 * MiB,
                 WS_ROPE = 10 * MiB, WS_SST = 12 * MiB, WS_HIN = 16 * MiB, WS_W = 20 * MiB, WS_A1 = 200 * MiB, WS_A2 = 264 * MiB, WS_BIG = 328 * MiB,
                 WS_QH = 584 * MiB, WS_KB = 648 * MiB, WS_VB = 690 * MiB, WS_END = 732 * MiB;
constexpr size_t WS_BB4 = 16 * MiB, WS_A4 = 7 * MiB + 768 * 1024;
constexpr size_t WS_CJ = WS_KB, WS_KC = WS_KB + 4 * MiB, WS_PARK = WS_KB + 8 * MiB;
constexpr size_t WS_O = WS_BIG + 144 * MiB;

struct Params {
    const float *x_prompt, *x_sample, *c, *cache_a_k, *cache_a_v, *cache_b_k, *cache_b_v, *state_ssm, *c_ctx, *ada_w, *ada_b, *norm_g, *mlp_w1, *mlp_w2,
        *attn_w_in, *attn_w_out, *qk_norm, *diff_lambda, *diff_subln, *ssm_w_in, *ssm_a_re, *ssm_a_im, *ssm_log_dt, *ssm_b_re, *ssm_b_im, *ssm_c_re, *ssm_c_im,
        *ssm_d, *ssm_glu_w, *ssm_w_out;
    float* out; unsigned char* ws;
};

__device__ __forceinline__ float bf2f(bf16_t v) { return __uint_as_float((unsigned)v << 16); }
__device__ __forceinline__ unsigned f2bf(float f) { unsigned u = __float_as_uint(f); return (u + 0x7fffu + ((u >> 16) & 1u)) >> 16; }
__device__ __forceinline__ unsigned pk2(float lo, float hi) { unsigned r; asm("v_cvt_pk_bf16_f32 %0, %1, %2" : "=v"(r) : "v"(lo), "v"(hi)); return r; }
__device__ __forceinline__ float wave_sum(float v) {
#pragma unroll
    for (int o = 1; o < 64; o <<= 1) v += __shfl_xor(v, o);
    return v;
}
__device__ __forceinline__ int row_class(int m) { return m < MP ? 0 : 1 + ((m - MP) >> 12); }
template <class P> __device__ __forceinline__ const float* x_row(const P& p, int m) { return m < MP ? p.x_prompt + (size_t)m * D : p.x_sample + (size_t)(m - MP) * D; }

typedef const __attribute__((address_space(4))) Params CP;

namespace pg8 {
#define PG8_LAS __attribute__((address_space(3)))
typedef unsigned short bf16_t;
typedef short bf16x8 __attribute__((ext_vector_type(8)));
typedef float f32x4 __attribute__((ext_vector_type(4)));
typedef unsigned u32x4 __attribute__((ext_vector_type(4)));
constexpr int BM = 256, BK = 64, HALF = 128, HTB = HALF * BK * 2  , STAGE_BYTES = 8 * HTB, NXCD = 8, WGM = 4;

__host__ __device__ __forceinline__ int lds_byte(int r, int c) { const int st = (r >> 4) * 2 + (c >> 5), rr = r & 15, cc = c & 31, ob = rr * 64 + cc * 2; return st * 1024 + (ob ^ (((ob >> 9) & 1) << 5)); }
__host__ __device__ __forceinline__ void stage_rc(int b, int& R, int& C) { const int st = b / 1024, sb = b % 1024, swz = sb ^ (((sb >> 9) & 1) << 5); R = (st >> 1) * 16 + swz / 64; C = (st & 1) * 32 + (swz % 64) / 2; }
__host__ __device__ __forceinline__ int perm32(int rho) { const int n = rho >> 4, i = rho & 15; return 8 * (i >> 2) + 4 * n + (i & 3); }

struct Unit { int pm, pn; };
struct Gemm { const bf16_t* A; const bf16_t* Bt; int M, N, K; };

struct StaticOrder {
    int nM, nN, nwg, G, c, wgm;
    __host__ __device__ void init(int M, int N, int G_, int c_, int wgm_ = WGM) { nM = M / BM; nN = N / BM; nwg = nM * nN; G = G_; c = c_; wgm = wgm_; }
    __host__ __device__ bool next(int i, Unit& u) const {
        const long L = (long)i * G + c; if (L >= nwg) return false;
        int wgid = (int)L; { const int q = nwg / NXCD, r = nwg % NXCD, xcd = wgid % NXCD, off = wgid / NXCD; wgid = (xcd < r ? xcd * (q + 1) : r * (q + 1) + (xcd - r) * q) + off; }
        const int nig = wgm * nN, gid = wgid / nig, fm = gid * wgm, gsz = (nM - fm) < wgm ? (nM - fm) : wgm;
        u.pm = fm + ((wgid % nig) % gsz); u.pn = (wgid % nig) / gsz; return true;
    }
    __device__ __forceinline__ void a_ready(const Unit&) const {}
    __device__ __forceinline__ void done(const Unit&) const {}
};

__device__ __forceinline__ unsigned cvt_pk_bf16(float lo, float hi) { unsigned r; asm volatile("v_cvt_pk_bf16_f32 %0, %1, %2" : "=v"(r) : "v"(lo), "v"(hi)); return r; }
typedef float f32x2 __attribute__((ext_vector_type(2)));
template <class Epi, class Sched, bool ALIGN_EPI = false, bool SP2 = false>
__device__ __forceinline__ void gemm_phase(PG8_LAS unsigned char* lds, const Gemm g, const Sched& S, const Epi& E) {
    const int tid = threadIdx.x, wid = __builtin_amdgcn_readfirstlane(tid >> 6), lane = tid & 63, wr = wid >> 2, wc = wid & 3, fr = lane & 15, fq = lane >> 4;
    const int K = g.K, nt = K / BK;
    unsigned voffA[2], voffB[2];
#pragma unroll
    for (int i = 0; i < 2; ++i) { int R, C; stage_rc(tid * 16 + i * 8192, R, C); const int Rb = Epi::PERM ? ((R & ~31) + perm32(R & 31)) : R;
        voffA[i] = Epi::ASCAN ? (unsigned)(((C >> 4) * 256 + R) * 16 + (C & 15)) * 2u : (unsigned)(R * K + C) * 2u; voffB[i] = (unsigned)(Rb * K + C) * 2u; }
    const size_t kstep = (size_t)(BK * 2);
    const size_t hstep = (size_t)HALF * K * 2;
    const size_t tstep = 2 * hstep;
    const size_t kstepA = Epi::ASCAN ? (size_t)32768 : kstep, hstepA = Epi::ASCAN ? (size_t)4096 : hstep;
    const unsigned ldsw = (unsigned)wid * 1024u;
    const int aoff = lds_byte(wr * 64 + fr, fq * 8), boff = lds_byte(wc * 32 + fr, fq * 8);
#define PG8_SA(b, h) (((b) * 2 + (h)) * HTB)
#define PG8_SB(b, h) ((4 + (b) * 2 + (h)) * HTB)
#define PG8_STAGE(bufoff, gbase, voff) do { _Pragma("unroll") for (int _i = 0; _i < 2; ++_i) \
        __builtin_amdgcn_global_load_lds((const unsigned*)((const char*)(gbase) + (voff)[_i]), (PG8_LAS unsigned*)(lds + (bufoff) + ldsw + _i * 8192), 16, 0, 0); } while (0)
#define PG8_LDA(dst, b, h) do { _Pragma("unroll") for (int m = 0; m < 4; ++m) _Pragma("unroll") for (int k = 0; k < 2; ++k) dst[m][k] = *(const PG8_LAS bf16x8*)(lds + PG8_SA(b, h) + aoff + m * 2048 + k * 1024); } while (0)
#define PG8_LDB(dst, b, h) do { _Pragma("unroll") for (int n = 0; n < 2; ++n) _Pragma("unroll") for (int k = 0; k < 2; ++k) dst[n][k] = *(const PG8_LAS bf16x8*)(lds + PG8_SB(b, h) + boff + n * 2048 + k * 1024); } while (0)
#define PG8_MMA(ai, bj, At, Bt) do { __builtin_amdgcn_s_setprio(1); _Pragma("unroll") for (int m = 0; m < 4; ++m) _Pragma("unroll") for (int n = 0; n < 2; ++n) _Pragma("unroll") for (int k = 0; k < 2; ++k) \
        acc[ai][bj][m][n] = __builtin_amdgcn_mfma_f32_16x16x32_bf16(Bt[n][k], At[m][k], acc[ai][bj][m][n], 0, 0, 0); __builtin_amdgcn_s_setprio(0); } while (0)
#define PG8_WAIT_V(n) asm volatile("s_waitcnt vmcnt(" #n ")" ::: "memory")
#define PG8_WAIT_L(n) asm volatile("s_waitcnt lgkmcnt(" #n ")" ::: "memory")
#define PG8_BAR __builtin_amdgcn_s_barrier()
#define PG8_SCHED __builtin_amdgcn_sched_barrier(0)
    Unit cur, nxt; int ui = 0;
    if (!S.next(0, cur)) return;
    f32x4 acc[2][2][4][2];
#pragma unroll
    for (int a = 0; a < 2; ++a)
#pragma unroll
        for (int b = 0; b < 2; ++b)
#pragma unroll
            for (int m = 0; m < 4; ++m)
#pragma unroll
                for (int n = 0; n < 2; ++n) acc[a][b][m][n] = (f32x4){0.f, 0.f, 0.f, 0.f};
    bf16x8 At[4][2], B0[2][2], B1[2][2];
    const char* cA = (const char*)g.A + (size_t)cur.pm * tstep; const char* cB = (const char*)g.Bt + (size_t)cur.pn * tstep;
    S.a_ready(cur);
    if constexpr (SP2) {
        PG8_STAGE(PG8_SB(0, 0), cB, voffB); PG8_STAGE(PG8_SB(0, 1), cB + hstep, voffB); PG8_STAGE(PG8_SA(0, 0), cA, voffA); PG8_STAGE(PG8_SA(0, 1), cA + hstepA, voffA);
        if (wr == 1) PG8_BAR;
        PG8_WAIT_V(2); PG8_BAR;
        PG8_STAGE(PG8_SB(1, 0), cB + kstep, voffB); PG8_STAGE(PG8_SA(1, 0), cA + kstepA, voffA); PG8_STAGE(PG8_SB(1, 1), cB + hstep + kstep, voffB);
        PG8_WAIT_V(6); PG8_BAR;
    } else {
        PG8_STAGE(PG8_SB(0, 0), cB, voffB); PG8_STAGE(PG8_SA(0, 0), cA, voffA); PG8_STAGE(PG8_SB(0, 1), cB + hstep, voffB); PG8_STAGE(PG8_SA(0, 1), cA + hstepA, voffA);
        if (wr == 1) PG8_BAR;
        PG8_WAIT_V(4); PG8_BAR;
        PG8_STAGE(PG8_SB(1, 0), cB + kstep, voffB); PG8_STAGE(PG8_SA(1, 0), cA + kstepA, voffA); PG8_STAGE(PG8_SB(1, 1), cB + hstep + kstep, voffB);
        PG8_WAIT_V(6); PG8_BAR;
    }
    for (;;) {
        const bool has_next = S.next(ui + 1, nxt);
        const char* nA = has_next ? (const char*)g.A + (size_t)nxt.pm * tstep : cA; const char* nB = has_next ? (const char*)g.Bt + (size_t)nxt.pn * tstep : cB;
        for (int t = 0; t < nt; t += 2) {
            const bool last = (t == nt - 2);
            const char* a1 = cA + (size_t)(t + 1) * kstepA;
            const char* a2 = last ? nA : cA + (size_t)(t + 2) * kstepA; const char* b2 = last ? nB : cB + (size_t)(t + 2) * kstep;
            const char* a3 = a2 + kstepA; const char* b3 = b2 + kstep;
            if (last && has_next) S.a_ready(nxt);
            if constexpr (SP2) {
            PG8_LDB(B0, 0, 0); PG8_LDB(B1, 0, 1); PG8_SCHED; PG8_LDA(At, 0, 0); PG8_STAGE(PG8_SA(1, 1), a1 + hstepA, voffA);
            PG8_WAIT_V(8); PG8_WAIT_L(0); PG8_BAR; PG8_MMA(0, 0, At, B0); PG8_MMA(0, 1, At, B1); PG8_BAR; PG8_SCHED;
            PG8_LDA(At, 0, 1); PG8_STAGE(PG8_SB(0, 0), b2, voffB); PG8_STAGE(PG8_SB(0, 1), b2 + hstep, voffB); PG8_STAGE(PG8_SA(0, 0), a2, voffA);
            PG8_WAIT_V(8); PG8_WAIT_L(0); PG8_BAR; PG8_MMA(1, 0, At, B0); PG8_MMA(1, 1, At, B1); PG8_BAR; PG8_SCHED;
            PG8_LDB(B0, 1, 0); PG8_LDB(B1, 1, 1); PG8_SCHED; PG8_LDA(At, 1, 0); PG8_STAGE(PG8_SA(0, 1), a2 + hstepA, voffA);
            PG8_WAIT_V(8); PG8_WAIT_L(0); PG8_BAR; PG8_MMA(0, 0, At, B0); PG8_MMA(0, 1, At, B1); PG8_BAR; PG8_SCHED;
            PG8_LDA(At, 1, 1); PG8_STAGE(PG8_SB(1, 0), b3, voffB); PG8_STAGE(PG8_SB(1, 1), b3 + hstep, voffB); PG8_STAGE(PG8_SA(1, 0), a3, voffA);
            PG8_WAIT_V(8); PG8_WAIT_L(0); PG8_BAR; PG8_MMA(1, 0, At, B0); PG8_MMA(1, 1, At, B1); PG8_BAR; PG8_SCHED;
            } else {
            PG8_LDB(B0, 0, 0); PG8_SCHED; PG8_LDA(At, 0, 0); PG8_STAGE(PG8_SA(1, 1), a1 + hstepA, voffA);
            PG8_WAIT_L(8); PG8_BAR; PG8_WAIT_L(0); PG8_MMA(0, 0, At, B0); PG8_BAR; PG8_SCHED;
            PG8_LDB(B1, 0, 1); PG8_STAGE(PG8_SB(0, 0), b2, voffB);
            PG8_BAR; PG8_WAIT_L(0); PG8_MMA(0, 1, At, B1); PG8_BAR;
            PG8_LDA(At, 0, 1); PG8_STAGE(PG8_SA(0, 0), a2, voffA);
            PG8_BAR; PG8_WAIT_L(0); PG8_MMA(1, 0, At, B0); PG8_BAR; PG8_SCHED;
            PG8_STAGE(PG8_SB(0, 1), b2 + hstep, voffB);
            PG8_WAIT_V(6); PG8_BAR; PG8_MMA(1, 1, At, B1); PG8_BAR;
            PG8_LDB(B0, 1, 0); PG8_SCHED; PG8_LDA(At, 1, 0); PG8_STAGE(PG8_SA(0, 1), a2 + hstepA, voffA);
            PG8_WAIT_L(8); PG8_BAR; PG8_WAIT_L(0); PG8_MMA(0, 0, At, B0); PG8_BAR; PG8_SCHED;
            PG8_LDB(B1, 1, 1); PG8_STAGE(PG8_SB(1, 0), b3, voffB);
            PG8_BAR; PG8_WAIT_L(0); PG8_MMA(0, 1, At, B1); PG8_BAR;
            PG8_LDA(At, 1, 1); PG8_STAGE(PG8_SA(1, 0), a3, voffA);
            PG8_BAR; PG8_WAIT_L(0); PG8_MMA(1, 0, At, B0); PG8_BAR; PG8_SCHED;
            PG8_STAGE(PG8_SB(1, 1), b3 + hstep, voffB);
            PG8_WAIT_V(6); PG8_BAR; PG8_MMA(1, 1, At, B1); PG8_BAR;
            }
        }
        if constexpr (ALIGN_EPI) { if (wr == 0) PG8_BAR; }
        if constexpr (!Epi::AFTER_DRAIN) { E(acc, cur, wr, wc, fr, fq); S.done(cur); }
        if (!has_next) break;
#pragma unroll
        for (int a = 0; a < 2; ++a)
#pragma unroll
            for (int b = 0; b < 2; ++b)
#pragma unroll
                for (int m = 0; m < 4; ++m)
#pragma unroll
                    for (int n = 0; n < 2; ++n) acc[a][b][m][n] = (f32x4){0.f, 0.f, 0.f, 0.f};
        cur = nxt; cA = nA; cB = nB; ++ui;
        if constexpr (ALIGN_EPI) { if (wr == 1) PG8_BAR; }
    }
    PG8_WAIT_V(0);
    if constexpr (!ALIGN_EPI) { if (wr == 0) PG8_BAR; }
    PG8_BAR;
    if constexpr (Epi::AFTER_DRAIN) { E.fused(acc, cur, wr, wc, fr, fq, lds, wid, lane); S.done(cur); }
#undef PG8_SA
#undef PG8_SB
#undef PG8_STAGE
#undef PG8_LDA
#undef PG8_LDB
#undef PG8_MMA
#undef PG8_WAIT_V
#undef PG8_WAIT_L
#undef PG8_BAR
#undef PG8_SCHED
}
}
namespace att {
using bf16 = __hip_bfloat16;
constexpr int D = 128, NW = 8, QBLK = 32, KVBLK = 64; constexpr float SCALE = 0.088388347648318440f; constexpr float THR = 8.f; constexpr int SDEPTH = 2;
constexpr int LDQ = 2048, LDK = 1280, LDO = 3072;
constexpr size_t SHM_V = KVBLK * D * 2, SHM_K = KVBLK * D * 2, SHM_ATTN = 2 * SHM_V + 2 * SHM_K + NW * 64 * 4;
using bf16x8 = __attribute__((ext_vector_type(8))) short;
using s16x4  = __attribute__((ext_vector_type(4))) short;
using f32x16 = __attribute__((ext_vector_type(16))) float;
using f32x8  = __attribute__((ext_vector_type(8))) float;
using u32x4  = __attribute__((ext_vector_type(4))) unsigned;
#define KSWZ(row, colB) ((row) * 256 + ((colB) ^ (((row) & 7) << 4)))
#define SBAR() __builtin_amdgcn_sched_barrier(0)
__device__ __forceinline__ int crow(int r, int hi) { return (r & 3) + 8 * (r >> 2) + 4 * hi; }
__device__ __forceinline__ unsigned cvtpk(float lo, float hi) {
  unsigned r; asm volatile("v_cvt_pk_bf16_f32 %0, %1, %2" : "=v"(r) : "v"(lo), "v"(hi)); return r;
}
template <typename TIn> struct Stage;
template <> struct Stage<bf16>  { using T = bf16x8;
  __device__ static __forceinline__ T ld8(const bf16* p) { return *reinterpret_cast<const bf16x8*>(p); }
  __device__ static __forceinline__ bf16x8 tobf(T x) { return x; } };
template <> struct Stage<float> { using T = f32x8;
  __device__ static __forceinline__ T ld8(const float* p) { return *reinterpret_cast<const f32x8*>(p); }
  __device__ static __forceinline__ bf16x8 tobf(T x) {
    u32x4 w = {cvtpk(x[0], x[1]), cvtpk(x[2], x[3]), cvtpk(x[4], x[5]), cvtpk(x[6], x[7])}; return *reinterpret_cast<bf16x8*>(&w); } };

__device__ __forceinline__ void partialSM(f32x16& p0, f32x16& p1, float& m_reg, float& mn, float& alpha) {
  constexpr float C = SCALE * 1.4426950408889634f;
  float pmax = p0[0]; for (int r = 1; r < 16; ++r) pmax = fmaxf(pmax, p0[r]); for (int r = 0; r < 16; ++r) pmax = fmaxf(pmax, p1[r]);
  { auto rr = __builtin_amdgcn_permlane32_swap(__float_as_uint(pmax), __float_as_uint(pmax), false, false);
    pmax = fmaxf(__uint_as_float(rr[0]), __uint_as_float(rr[1])); }
  if (__builtin_expect(__all(pmax - m_reg <= THR / SCALE), 1)) { mn = m_reg; alpha = 1.f; }
  else { mn = fmaxf(m_reg, pmax); alpha = __builtin_amdgcn_exp2f((m_reg - mn) * C); m_reg = mn; }
  float mnC = -mn * C;
  for (int r = 0; r < 16; ++r) p0[r] = fmaf(p0[r], C, mnC); for (int r = 0; r < 16; ++r) p1[r] = fmaf(p1[r], C, mnC);
  for (int r = 0; r < 16; ++r) p0[r] = __builtin_amdgcn_exp2f(p0[r]);
}
__device__ __forceinline__ void partialSMf(f32x16& p0, f32x16& p1, float& m_reg, float& alpha, bool first) {
  constexpr float THR2 = THR * 1.4426950408889634f;
  float pmax = p0[0]; for (int r = 1; r < 16; ++r) pmax = fmaxf(pmax, p0[r]); for (int r = 0; r < 16; ++r) pmax = fmaxf(pmax, p1[r]);
  { auto rr = __builtin_amdgcn_permlane32_swap(__float_as_uint(pmax), __float_as_uint(pmax), false, false);
    pmax = fmaxf(__uint_as_float(rr[0]), __uint_as_float(rr[1])); }
  alpha = 1.f;
  if (first || !__all(pmax <= THR2)) {
    const float mnew = first ? m_reg + pmax : fmaxf(m_reg, m_reg + pmax);
    const float mt = __uint_as_float(cvtpk(mnew, mnew) << 16);
    const float delta = mt - m_reg; m_reg = mt;
    if (!first) alpha = __builtin_amdgcn_exp2f(-delta);
    for (int r = 0; r < 16; ++r) p0[r] -= delta; for (int r = 0; r < 16; ++r) p1[r] -= delta;
  }
  for (int r = 0; r < 16; ++r) p0[r] = __builtin_amdgcn_exp2f(p0[r]);
}
__device__ __forceinline__ void finishSM(f32x16& p0, f32x16& p1, float alpha, float& l_reg, bf16x8& pa0, bf16x8& pa1, bf16x8& pa2, bf16x8& pa3) {
  for (int r = 0; r < 16; ++r) p1[r] = __builtin_amdgcn_exp2f(p1[r]);
  float ps = 0; for (int r = 0; r < 16; ++r) ps += p0[r]; for (int r = 0; r < 16; ++r) ps += p1[r];
  { auto rr = __builtin_amdgcn_permlane32_swap(__float_as_uint(ps), __float_as_uint(ps), false, false);
    ps = __uint_as_float(rr[0]) + __uint_as_float(rr[1]); }
  l_reg = l_reg * alpha + ps;
#define PK4(P, BASE, OUT) do { unsigned a0 = cvtpk(P[BASE + 0], P[BASE + 1]), a1 = cvtpk(P[BASE + 2], P[BASE + 3]);   \
    unsigned b0 = cvtpk(P[BASE + 4], P[BASE + 5]), b1 = cvtpk(P[BASE + 6], P[BASE + 7]);                              \
    auto r0 = __builtin_amdgcn_permlane32_swap(a0, b0, false, false); auto r1 = __builtin_amdgcn_permlane32_swap(a1, b1, false, false); \
    u32x4 w = {r0[0], r1[0], r0[1], r1[1]}; OUT = *reinterpret_cast<bf16x8*>(&w); } while (0)
  PK4(p0, 0, pa0); PK4(p0, 8, pa1); PK4(p1, 0, pa2); PK4(p1, 8, pa3);
#undef PK4
}
__device__ __forceinline__ void qkt(f32x16& p0, f32x16& p1, const bf16* Ks, const bf16x8* qr, int r32, int hi) {
  p0 = f32x16{}; p1 = f32x16{};
  for (int d0 = 0; d0 < 8; ++d0) { int cb = (d0 * 16 + hi * 8) * 2;
    bf16x8 b0 = *reinterpret_cast<const bf16x8*>((const char*)Ks + KSWZ(r32, cb));
    bf16x8 b1 = *reinterpret_cast<const bf16x8*>((const char*)Ks + KSWZ(32 + r32, cb));
    p0 = __builtin_amdgcn_mfma_f32_32x32x16_bf16(b0, qr[d0], p0, 0, 0, 0);
    p1 = __builtin_amdgcn_mfma_f32_32x32x16_bf16(b1, qr[d0], p1, 0, 0, 0); }
}
__device__ __forceinline__ int v_st(int k, int c) { const int kk = (k & ~0xC) | ((k & 4) << 1) | ((k & 8) >> 1); return ((kk >> 3) * 4 + (c >> 5)) * 512 + ((kk & 7) * 32 + (c & 31)) * 2; }
__device__ __forceinline__ int v_rd_base(int lane) { return ((lane & 3) << 3) | (((lane >> 2) & 3) << 6) | (((lane >> 4) & 1) << 5) | (((lane >> 5) & 1) << 8); }
constexpr int v_rd_off(int d0, int ks, int half) { return d0 * 512 + ks * 4096 + half * 2048; }
template <int OFF> __device__ __forceinline__ s16x4 tr_read(int vb) {
  s16x4 r; asm volatile("ds_read_b64_tr_b16 %0, %1 offset:%2" : "=&v"(r) : "v"(vb), "i"(OFF) : "memory"); return r;
}
template <int D0> __device__ __forceinline__ void pv_one(f32x16& od, int vb, bf16x8 pa0, bf16x8 pa1, bf16x8 pa2, bf16x8 pa3) {
  const s16x4 l0 = tr_read<v_rd_off(D0, 0, 0)>(vb), h0 = tr_read<v_rd_off(D0, 0, 1)>(vb), l1 = tr_read<v_rd_off(D0, 1, 0)>(vb), h1 = tr_read<v_rd_off(D0, 1, 1)>(vb);
  const s16x4 l2 = tr_read<v_rd_off(D0, 2, 0)>(vb), h2 = tr_read<v_rd_off(D0, 2, 1)>(vb), l3 = tr_read<v_rd_off(D0, 3, 0)>(vb), h3 = tr_read<v_rd_off(D0, 3, 1)>(vb);
  asm volatile("s_waitcnt lgkmcnt(0)" ::: "memory"); SBAR();
#define PK(L, H) (bf16x8){L[0], L[1], L[2], L[3], H[0], H[1], H[2], H[3]}
  od = __builtin_amdgcn_mfma_f32_32x32x16_bf16(pa0, PK(l0, h0), od, 0, 0, 0);
  od = __builtin_amdgcn_mfma_f32_32x32x16_bf16(pa1, PK(l1, h1), od, 0, 0, 0);
  od = __builtin_amdgcn_mfma_f32_32x32x16_bf16(pa2, PK(l2, h2), od, 0, 0, 0);
  od = __builtin_amdgcn_mfma_f32_32x32x16_bf16(pa3, PK(l3, h3), od, 0, 0, 0);
#undef PK
}
__device__ __forceinline__ void pv_d0(f32x16* o, int vb, bf16x8 pa0, bf16x8 pa1, bf16x8 pa2, bf16x8 pa3) {
  pv_one<0>(o[0], vb, pa0, pa1, pa2, pa3); pv_one<1>(o[1], vb, pa0, pa1, pa2, pa3); pv_one<2>(o[2], vb, pa0, pa1, pa2, pa3); pv_one<3>(o[3], vb, pa0, pa1, pa2, pa3);
}

template <typename TQ>
__device__ __forceinline__ void attn_dense_body(const TQ* __restrict__ Qb, const bf16* __restrict__ Kh, const bf16* __restrict__ Vh,
                                                unsigned short* __restrict__ Ob, int ldo, int seq, char* lds) {
  using St = Stage<bf16>; using SQ = Stage<TQ>;
  const int tid = threadIdx.x, wid = tid >> 6, lane = tid & 63, r32 = lane & 31, hi = lane >> 5;
  bf16* V_lds = (bf16*)lds; bf16* K_lds = (bf16*)(lds + 2 * SHM_V);
  float* ws = (float*)(lds + 2 * SHM_V + 2 * SHM_K) + wid * 64; float* li_l = ws; float* al_l = ws + 32;
  float m_reg = -1e30f, l_reg = 0; f32x16 o[4] = {}; bf16x8 qr[8];
  const TQ* Qw = Qb + (long)(wid * QBLK + r32) * LDQ + hi * 8;
#pragma unroll
  for (int d0 = 0; d0 < 8; ++d0) qr[d0] = SQ::tobf(SQ::ld8(Qw + d0 * 16));
  const int sr = tid >> 4, sc = (tid & 15) * 8, vst0 = v_st(sr, sc), vst1 = v_st(32 + sr, sc);
  const int vb0 = (int)(uintptr_t)V_lds + v_rd_base(lane);
  struct { typename St::T vs0, vs1, ks0, ks1; } sr_[SDEPTH];
#define SLOAD(i, k0) do { sr_[i].vs0 = St::ld8(&Vh[(long)((k0) + sr) * LDK + sc]); sr_[i].vs1 = St::ld8(&Vh[(long)((k0) + 32 + sr) * LDK + sc]); \
    sr_[i].ks0 = St::ld8(&Kh[(long)((k0) + sr) * LDK + sc]); sr_[i].ks1 = St::ld8(&Kh[(long)((k0) + 32 + sr) * LDK + sc]); } while (0)
#define SWRITE(b, i) do { *(bf16x8*)((char*)V_lds + (b) * SHM_V + vst0) = St::tobf(sr_[i].vs0);          \
    *(bf16x8*)((char*)V_lds + (b) * SHM_V + vst1) = St::tobf(sr_[i].vs1); int kc = sc * 2;               \
    *(bf16x8*)((char*)K_lds + (b) * SHM_K + KSWZ(sr, kc)) = St::tobf(sr_[i].ks0);                       \
    *(bf16x8*)((char*)K_lds + (b) * SHM_K + KSWZ(32 + sr, kc)) = St::tobf(sr_[i].ks1); } while (0)
#define SWAIT() do { if constexpr (SDEPTH == 2) asm volatile("s_waitcnt vmcnt(4)" ::: "memory"); else asm volatile("s_waitcnt vmcnt(0)" ::: "memory"); } while (0)
#define RESC(a) do { if (__any((a) < 1.f)) { if (hi == 0) al_l[r32] = (a); asm volatile("s_waitcnt lgkmcnt(0)" ::: "memory"); \
    for (int d = 0; d < 4; ++d) for (int r = 0; r < 16; ++r) o[d][r] *= al_l[crow(r, hi)]; } } while (0)
  f32x16 pA0, pA1, pB0, pB1; float mnA, mnB, alA, alB; bf16x8 pa0, pa1, pa2, pa3; const int NT = seq / KVBLK;
  constexpr int SE = 0, SO = SDEPTH - 1;
  SLOAD(SE, 0); asm volatile("s_waitcnt vmcnt(0)" ::: "memory"); SWRITE(0, SE); __syncthreads();
  qkt(pA0, pA1, K_lds, qr, r32, hi); partialSM(pA0, pA1, m_reg, mnA, alA);
  SLOAD(SO, KVBLK); if constexpr (SDEPTH == 2) { if (2 < NT) SLOAD(SE, 2 * KVBLK); }
  SWAIT(); SWRITE(1, SO); __syncthreads();
  for (int j = 1; j + 1 < NT; j += 2) {
    SBAR(); qkt(pB0, pB1, (bf16*)((char*)K_lds + SHM_K), qr, r32, hi);
    finishSM(pA0, pA1, alA, l_reg, pa0, pa1, pa2, pa3); SBAR();
    SLOAD(SO, (j + SDEPTH) * KVBLK); SBAR();
    pv_d0(o, vb0, pa0, pa1, pa2, pa3); partialSM(pB0, pB1, m_reg, mnB, alB);
    __syncthreads(); SWAIT(); SWRITE(0, SE);
    RESC(alB); __syncthreads();
    SBAR(); qkt(pA0, pA1, K_lds, qr, r32, hi);
    finishSM(pB0, pB1, alB, l_reg, pa0, pa1, pa2, pa3); SBAR();
    if (SDEPTH == 1 || j + 3 < NT) SLOAD(SE, (j + 1 + SDEPTH) * KVBLK); SBAR();
    pv_d0(o, vb0 + (int)SHM_V, pa0, pa1, pa2, pa3); partialSM(pA0, pA1, m_reg, mnA, alA);
    __syncthreads(); SWAIT(); SWRITE(1, SO);
    RESC(alA); __syncthreads();
  }
  SBAR(); qkt(pB0, pB1, (bf16*)((char*)K_lds + SHM_K), qr, r32, hi);
  finishSM(pA0, pA1, alA, l_reg, pa0, pa1, pa2, pa3); SBAR();
  pv_d0(o, vb0, pa0, pa1, pa2, pa3); partialSM(pB0, pB1, m_reg, mnB, alB);
  __syncthreads(); RESC(alB);
  finishSM(pB0, pB1, alB, l_reg, pa0, pa1, pa2, pa3); SBAR();
  pv_d0(o, vb0 + (int)SHM_V, pa0, pa1, pa2, pa3);
  if (hi == 0) li_l[r32] = l_reg; asm volatile("s_waitcnt lgkmcnt(0)" ::: "memory");
  float rli[16];
#pragma unroll
  for (int r = 0; r < 16; ++r) rli[r] = __builtin_amdgcn_rcpf(li_l[crow(r, hi)]);
  unsigned short* Ow = Ob + (long)(wid * QBLK) * ldo;
#pragma unroll
  for (int r = 0; r < 16; ++r) { int orow = crow(r, hi);
    for (int d0 = 0; d0 < 4; ++d0) Ow[(long)orow * ldo + d0 * 32 + r32] = (unsigned short)f2bf(o[d0][r] * rli[r]); }
#undef SLOAD
#undef SWRITE
#undef SWAIT
#undef RESC
}

template <int NB>
__device__ __forceinline__ void store_o_rows(const f32x16* o, const float* li_l, unsigned short* __restrict__ Ow, int ldo, char* lds, int wid, int lane, int r32, int hi) {
  constexpr int RS = NB * 64, LPR = RS / 16, RPI = 64 / LPR;
  char* st = lds + wid * (32 * RS);
#pragma unroll
  for (int r = 0; r < 16; ++r) { const int orow = crow(r, hi); const float rl = __builtin_amdgcn_rcpf(li_l[orow]);
#pragma unroll
    for (int d0 = 0; d0 < NB; ++d0) { const float v = o[d0][r] * rl; *reinterpret_cast<unsigned short*>(st + orow * RS + (d0 * 32 + r32) * 2) = (unsigned short)cvtpk(v, v); } }
  asm volatile("s_waitcnt lgkmcnt(0)" ::: "memory");
  const int rr = lane / LPR, cb = (lane % LPR) * 16;
#pragma unroll
  for (int i = 0; i < 32 / RPI; ++i) { const int row = i * RPI + rr;
    const u32x4 v = *reinterpret_cast<const u32x4*>(st + row * RS + cb);
    *reinterpret_cast<u32x4*>(reinterpret_cast<char*>(Ow + (long)row * ldo) + cb) = v; }
}
__device__ __forceinline__ void attn_small_body(const bf16* __restrict__ Qb, const bf16* __restrict__ Kh, const bf16* __restrict__ Vh, unsigned short* __restrict__ Ob, int ldo, char* lds) {
  int tid_ = threadIdx.x; asm volatile("" : "+v"(tid_));
  const int tid = tid_, wid = __builtin_amdgcn_readfirstlane(tid >> 6), lane = tid & 63, r32 = lane & 31, hi = lane >> 5;
  char* V_lds = lds; char* K_lds = lds + 4 * SHM_V;
  float* ws = (float*)(lds + 4 * SHM_V + 4 * SHM_K) + wid * 64; float* li_l = ws; float* al_l = ws + 32;
  const int sr = tid >> 4, sc = (tid & 15) * 8, vst0 = v_st(sr, sc), vst1 = v_st(32 + sr, sc);
  bf16x8 kv[4][4];
#pragma unroll
  for (int t = 0; t < 4; ++t) {
    kv[t][0] = *reinterpret_cast<const bf16x8*>(&Kh[(long)(64 * t + sr) * LDK + sc]); kv[t][1] = *reinterpret_cast<const bf16x8*>(&Kh[(long)(64 * t + 32 + sr) * LDK + sc]);
    kv[t][2] = *reinterpret_cast<const bf16x8*>(&Vh[(long)(64 * t + sr) * LDK + sc]); kv[t][3] = *reinterpret_cast<const bf16x8*>(&Vh[(long)(64 * t + 32 + sr) * LDK + sc]); }
  bf16x8 qr[8];
  const bf16* Qw = Qb + (long)(wid * QBLK + r32) * LDQ + hi * 8;
#pragma unroll
  for (int d0 = 0; d0 < 8; ++d0) qr[d0] = *reinterpret_cast<const bf16x8*>(Qw + d0 * 16);
  asm volatile("s_waitcnt vmcnt(0)" ::: "memory");
#pragma unroll
  for (int t = 0; t < 4; ++t) {
    *(bf16x8*)(K_lds + t * SHM_K + KSWZ(sr, sc * 2)) = kv[t][0]; *(bf16x8*)(K_lds + t * SHM_K + KSWZ(32 + sr, sc * 2)) = kv[t][1];
    *(bf16x8*)(V_lds + t * SHM_V + vst0) = kv[t][2]; *(bf16x8*)(V_lds + t * SHM_V + vst1) = kv[t][3]; }
  __syncthreads();
  float m_reg = -1e30f, l_reg = 0; f32x16 o[4] = {};
  const int vb0 = (int)(uintptr_t)V_lds + v_rd_base(lane);
#pragma unroll 1
  for (int t = 0; t < 4; ++t) {
    f32x16 p0, p1; float mn, al; bf16x8 pa0, pa1, pa2, pa3;
    qkt(p0, p1, (const bf16*)(K_lds + t * SHM_K), qr, r32, hi);
    partialSM(p0, p1, m_reg, mn, al);
    if (__any(al < 1.f)) { if (hi == 0) al_l[r32] = al; asm volatile("s_waitcnt lgkmcnt(0)" ::: "memory");
      for (int d = 0; d < 4; ++d) for (int r = 0; r < 16; ++r) o[d][r] *= al_l[crow(r, hi)]; }
    finishSM(p0, p1, al, l_reg, pa0, pa1, pa2, pa3); SBAR();
    pv_d0(o, vb0 + t * (int)SHM_V, pa0, pa1, pa2, pa3);
  }
  if (hi == 0) li_l[r32] = l_reg; asm volatile("s_waitcnt lgkmcnt(0)" ::: "memory");
  __syncthreads();
  store_o_rows<4>(o, li_l, Ob + (long)(wid * QBLK) * ldo, ldo, lds, wid, lane, r32, hi);
  __syncthreads();
}

template <int OFF> __device__ __forceinline__ bf16x8 rd128(int a) { bf16x8 r; asm volatile("ds_read_b128 %0, %1 offset:%2" : "=v"(r) : "v"(a), "i"(OFF) : "memory"); return r; }
#define LGKM(n) asm volatile("s_waitcnt lgkmcnt(" #n ")" ::: "memory")
#define MF(a, b, c) c = __builtin_amdgcn_mfma_f32_32x32x16_bf16(a, b, c, 0, 0, 0)
__device__ __forceinline__ void qkt_p(f32x16& p0, f32x16& p1, int ka0, int ka1, int ka2, int ka3, const bf16x8* qr, bf16x8 kone, bf16x8 qm) {
  bf16x8 a0, b0, a1, b1;
  a0 = rd128<0>(ka0); b0 = rd128<8192>(ka0); a1 = rd128<0>(ka1); b1 = rd128<8192>(ka1);
  p0 = __builtin_amdgcn_mfma_f32_32x32x16_bf16(kone, qm, f32x16{}, 0, 0, 0); p1 = __builtin_amdgcn_mfma_f32_32x32x16_bf16(kone, qm, f32x16{}, 0, 0, 0);
  LGKM(2); SBAR(); MF(a0, qr[0], p0); MF(b0, qr[0], p1); SBAR(); a0 = rd128<0>(ka2);   b0 = rd128<8192>(ka2);
  LGKM(2); SBAR(); MF(a1, qr[1], p0); MF(b1, qr[1], p1); SBAR(); a1 = rd128<0>(ka3);   b1 = rd128<8192>(ka3);
  LGKM(2); SBAR(); MF(a0, qr[2], p0); MF(b0, qr[2], p1); SBAR(); a0 = rd128<128>(ka0); b0 = rd128<8320>(ka0);
  LGKM(2); SBAR(); MF(a1, qr[3], p0); MF(b1, qr[3], p1); SBAR(); a1 = rd128<128>(ka1); b1 = rd128<8320>(ka1);
  LGKM(2); SBAR(); MF(a0, qr[4], p0); MF(b0, qr[4], p1); SBAR(); a0 = rd128<128>(ka2); b0 = rd128<8320>(ka2);
  LGKM(2); SBAR(); MF(a1, qr[5], p0); MF(b1, qr[5], p1); SBAR(); a1 = rd128<128>(ka3); b1 = rd128<8320>(ka3);
  LGKM(2); SBAR(); MF(a0, qr[6], p0); MF(b0, qr[6], p1); SBAR();
  LGKM(0); SBAR(); MF(a1, qr[7], p0); MF(b1, qr[7], p1); SBAR();
}
struct VFrag { s16x4 l0, h0, l1, h1, l2, h2, l3, h3; };
template <int D> __device__ __forceinline__ void pv_rd(VFrag& f, int vb) { constexpr int B = (D >> 2) * 16384;
  f.l0 = tr_read<B + v_rd_off(D & 3, 0, 0)>(vb); f.h0 = tr_read<B + v_rd_off(D & 3, 0, 1)>(vb); f.l1 = tr_read<B + v_rd_off(D & 3, 1, 0)>(vb); f.h1 = tr_read<B + v_rd_off(D & 3, 1, 1)>(vb);
  f.l2 = tr_read<B + v_rd_off(D & 3, 2, 0)>(vb); f.h2 = tr_read<B + v_rd_off(D & 3, 2, 1)>(vb); f.l3 = tr_read<B + v_rd_off(D & 3, 3, 0)>(vb); f.h3 = tr_read<B + v_rd_off(D & 3, 3, 1)>(vb); }
__device__ __forceinline__ void pv_mm(f32x16& od, const VFrag& f, bf16x8 pa0, bf16x8 pa1, bf16x8 pa2, bf16x8 pa3) {
#define PK(L, H) (bf16x8){L[0], L[1], L[2], L[3], H[0], H[1], H[2], H[3]}
  MF(pa0, PK(f.l0, f.h0), od); MF(pa1, PK(f.l1, f.h1), od); MF(pa2, PK(f.l2, f.h2), od); MF(pa3, PK(f.l3, f.h3), od);
#undef PK
}
template <int D, int NB> __device__ __forceinline__ void pv_step(f32x16* o, VFrag& cur, VFrag& nxt, int vb, bf16x8 pa0, bf16x8 pa1, bf16x8 pa2, bf16x8 pa3) {
  if constexpr (D + 1 < NB) { pv_rd<D + 1>(nxt, vb); LGKM(8); } else { LGKM(0); }
  SBAR(); pv_mm(o[D], cur, pa0, pa1, pa2, pa3); SBAR();
  if constexpr (D + 1 < NB) pv_step<D + 1, NB>(o, nxt, cur, vb, pa0, pa1, pa2, pa3);
}
template <int NB> __device__ __forceinline__ void pv_p(f32x16* o, int vb, bf16x8 pa0, bf16x8 pa1, bf16x8 pa2, bf16x8 pa3) {
  VFrag x, y; pv_rd<0>(x, vb); pv_step<0, NB>(o, x, y, vb, pa0, pa1, pa2, pa3);
}
template <int NH>
__device__ __forceinline__ void attn_wide_body(const bf16* __restrict__ Qb, const bf16* __restrict__ Kh, const bf16* __restrict__ Vh, unsigned short* __restrict__ Ob, int ldo, int seq, char* lds) {
  int tid_ = threadIdx.x; asm volatile("" : "+v"(tid_));
  const int tid = tid_, wid = __builtin_amdgcn_readfirstlane(tid >> 6), lane = tid & 63, r32 = lane & 31, hi = lane >> 5;
  constexpr int KB = 16384, VB = NH * 16384, VOFF = 2 * KB;
  float* ws = (float*)(lds + 2 * KB + 3 * VB) + wid * 64; float* li_l = ws; float* al_l = ws + 32;
  bf16x8 qr[8];
  const bf16* Qw = Qb + (long)(wid * QBLK + r32) * LDQ + hi * 8;
#pragma unroll
  for (int d0 = 0; d0 < 8; ++d0) { const bf16x8 qv = *reinterpret_cast<const bf16x8*>(Qw + d0 * 16);
    constexpr float C = SCALE * 1.4426950408889634f; u32x4 w;
#pragma unroll
    for (int e = 0; e < 4; ++e) w[e] = cvtpk(__uint_as_float((unsigned)(unsigned short)qv[2 * e] << 16) * C, __uint_as_float((unsigned)(unsigned short)qv[2 * e + 1] << 16) * C);
    qr[d0] = *reinterpret_cast<bf16x8*>(&w); }
  unsigned kof[2], vof[2];
#pragma unroll
  for (int i = 0; i < 2; ++i) { const int ch = 2 * wid + i;
    const int row = ch * 4 + (lane >> 4); kof[i] = (unsigned)(row * LDK * 2 + (((lane & 15) ^ (row & 7)) << 4));
    const int s = 2 * ch + (lane >> 5), kk = (s >> 2) * 8 + ((lane & 31) >> 2), k = (kk & ~0xC) | ((kk & 4) << 1) | ((kk & 8) >> 1);
    vof[i] = (unsigned)(k * LDK * 2 + ((s & 3) * 32 + (lane & 3) * 8) * 2); }
  PG8_LAS unsigned char* L3 = (PG8_LAS unsigned char*)lds;
  const unsigned pw = (unsigned)wid * 2048u;
#define WDMA_K(t, b) do { const char* kg = (const char*)Kh + (size_t)(t) * (KVBLK * LDK * 2); _Pragma("unroll") for (int _i = 0; _i < 2; ++_i)  \
      __builtin_amdgcn_global_load_lds((const unsigned*)(kg + kof[_i]), (PG8_LAS unsigned*)(L3 + (b) * KB + pw + _i * 1024), 16, 0, 0); } while (0)
#define WDMA_V(t, b) do { const char* vg = (const char*)Vh + (size_t)(t) * (KVBLK * LDK * 2); _Pragma("unroll") for (int _h = 0; _h < NH; ++_h) _Pragma("unroll") for (int _i = 0; _i < 2; ++_i)  \
      __builtin_amdgcn_global_load_lds((const unsigned*)(vg + _h * 256 + vof[_i]), (PG8_LAS unsigned*)(L3 + VOFF + (b) * VB + _h * 16384 + pw + _i * 1024), 16, 0, 0); } while (0)
#define WQS(kb, FIRST_, ISSUE_) do { f32x16 p0, p1; float al; SBAR(); __builtin_amdgcn_s_setprio(1); { const int ko = (kb) * KB; u32x4 qmw = {hi ? 0u : cvtpk(-m_reg, 0.f), 0u, 0u, 0u}; u32x4 konew = {hi ? 0u : 0x3F80u, 0u, 0u, 0u}; const bf16x8 kone = *reinterpret_cast<bf16x8*>(&konew);                          \
      qkt_p(p0, p1, ka0 + ko, ka1 + ko, ka2 + ko, ka3 + ko, qr, kone, *reinterpret_cast<bf16x8*>(&qmw)); } __builtin_amdgcn_s_setprio(0); partialSMf(p0, p1, m_reg, al, (FIRST_)); SBAR(); ISSUE_; SBAR();                       \
    if (__any(al < 1.f)) { if (hi == 0) al_l[r32] = al; asm volatile("s_waitcnt lgkmcnt(0)" ::: "memory");                                                            \
      for (int d = 0; d < 4 * NH; ++d) for (int r = 0; r < 16; ++r) o[d][r] *= al_l[crow(r, hi)]; }                                                                     \
    finishSM(p0, p1, al, l_reg, pa0, pa1, pa2, pa3); SBAR(); } while (0)
#define WPV(vb_) do { SBAR(); __builtin_amdgcn_s_setprio(1); pv_p<4 * NH>(o, vb0 + (vb_) * VB, pa0, pa1, pa2, pa3); __builtin_amdgcn_s_setprio(0); SBAR(); } while (0)
  float m_reg = 0.f, l_reg = 0; f32x16 o[4 * NH] = {};
  const int vb0 = (int)(uintptr_t)lds + VOFF + v_rd_base(lane);
  const int NT = seq / KVBLK; const bool lead = wid < 4;
  const int kx = (hi * 16) ^ ((r32 & 7) << 4), kl = (int)(uintptr_t)lds + r32 * 256;
  const int ka0 = kl + kx, ka1 = kl + (32 ^ kx), ka2 = kl + (64 ^ kx), ka3 = kl + (96 ^ kx);
  bf16x8 pa0, pa1, pa2, pa3;
  WDMA_K(0, 0); WDMA_V(0, 0); asm volatile("s_waitcnt vmcnt(0)" ::: "memory"); __syncthreads();
#define WEND() do { asm volatile("s_waitcnt vmcnt(0)" ::: "memory"); __syncthreads(); } while (0)
#define WROT() do { vj = vj1; vj1 = vj2; vj2 = (vj2 == 2) ? 0 : vj2 + 1; } while (0)
  int vj = 2, vj1 = 0, vj2 = 1;
  if (lead) {
#pragma unroll 1
    for (int j = -1; j + 1 < NT; ++j) { const int k1 = (j + 1) & 1;
      WQS(k1, j == -1, if (j + 2 < NT) { WDMA_K(j + 2, k1 ^ 1); WDMA_V(j + 2, vj2); }); WPV(vj1); WEND(); WROT(); }
    WEND();
  } else {
    if (1 < NT) { WDMA_K(1, 1); WDMA_V(1, 1); }
    WQS(0, true, (void)0); WEND(); WROT();
#pragma unroll 1
    for (int j = 0; j + 1 < NT; ++j) { const int k1 = (j + 1) & 1;
      if (j + 2 < NT) { WDMA_K(j + 2, k1 ^ 1); WDMA_V(j + 2, vj2); }
      WPV(vj); WQS(k1, false, (void)0); WEND(); WROT(); }
    WPV(vj); WEND();
  }
#undef WEND
#undef WROT
#undef WDMA_K
#undef WDMA_V
#undef WQS
#undef WPV
  if (hi == 0) li_l[r32] = l_reg; asm volatile("s_waitcnt lgkmcnt(0)" ::: "memory");
  store_o_rows<4 * NH>(o, li_l, Ob + (long)(wid * QBLK) * ldo, ldo, lds, wid, lane, r32, hi);
  __syncthreads();
}
}
#define ONE_PER_PHASE 0

namespace pg8 {
template <int ACT  > struct EpiStore {
    static constexpr bool PERM = true, AFTER_DRAIN = false, ASCAN = (ACT == 2);
    bf16_t* O; int ldc; const bf16_t* aux;
    __device__ __forceinline__ void operator()(const f32x4 (&acc)[2][2][4][2], const Unit& u, int wr, int wc, int fr, int fq) const {
        const int row0 = u.pm * BM + wr * 64 + fr, col0 = u.pn * BM + wc * 32 + 8 * fq;
#pragma unroll
        for (int ai = 0; ai < 2; ++ai)
#pragma unroll
            for (int m = 0; m < 4; ++m) { const size_t ro = (size_t)(row0 + ai * HALF + m * 16) * ldc + col0;
#pragma unroll
                for (int bj = 0; bj < 2; ++bj) { f32x4 v0 = acc[ai][bj][m][0], v1 = acc[ai][bj][m][1];
                    if (ACT == 1) { v0 = __builtin_elementwise_max(v0, (f32x4){0.f, 0.f, 0.f, 0.f}); v1 = __builtin_elementwise_max(v1, (f32x4){0.f, 0.f, 0.f, 0.f}); v0 = v0 * v0; v1 = v1 * v1; }
                    if (ACT == 2) { const int row_ = row0 + ai * HALF + m * 16, col_ = col0 + bj * HALF;
                        const u32x4 z = *(const u32x4*)(aux + ((size_t)((row_ >> 8) * 128 + (col_ >> 4)) * 256 + (row_ & 255)) * 16 + (col_ & 15));
                        const f32x4 z0 = {__uint_as_float(z.x << 16), __uint_as_float(z.x & 0xffff0000u), __uint_as_float(z.y << 16), __uint_as_float(z.y & 0xffff0000u)};
                        const f32x4 z1 = {__uint_as_float(z.z << 16), __uint_as_float(z.z & 0xffff0000u), __uint_as_float(z.w << 16), __uint_as_float(z.w & 0xffff0000u)};
#pragma unroll
                        for (int e = 0; e < 4; ++e) { v0[e] = z0[e] * __builtin_amdgcn_rcpf(1.f + __builtin_amdgcn_exp2f(-1.4426950408889634f * v0[e])); v1[e] = z1[e] * __builtin_amdgcn_rcpf(1.f + __builtin_amdgcn_exp2f(-1.4426950408889634f * v1[e])); } }
                    u32x4 w; w.x = cvt_pk_bf16(v0[0], v0[1]); w.y = cvt_pk_bf16(v0[2], v0[3]); w.z = cvt_pk_bf16(v1[0], v1[1]); w.w = cvt_pk_bf16(v1[2], v1[3]);
                    if (ACT == 3) { const int row = row0 + ai * HALF + m * 16, col = col0 + bj * HALF;
                        *(u32x4*)(O + ((size_t)((row >> 8) * 128 + (col >> 4)) * 256 + (row & 255)) * 16 + (col & 15)) = w; }
                    else *(u32x4*)(O + ro + bj * HALF) = w; } }
    }
};
}


namespace pg8 {
struct EpiQKV {
    static constexpr bool PERM = true, AFTER_DRAIN = false, ASCAN = false;
    bf16_t* QH; bf16_t* KBf; bf16_t* VBf; float* out; const float* qkn; const float* rope; PG8_LAS float* P;
    __device__ __forceinline__ void operator()(const f32x4 (&acc)[2][2][4][2], const Unit& u, int wr, int wc, int fr, int fq) const {
        const int pn = u.pn, pm = u.pm;
        const bool samp = pm >= 32; const int b = samp ? ((pm - 32) >> 4) : 0, tb = samp ? ((pm - 32) & 15) * 256 : 0;
        const int kind = pn < 4 ? 0 : pn == 4 ? 1 : pn == 5 ? 2 : pn < 10 ? 3 : pn < 14 ? 4 : 5;
        const bool nrm = kind <= 1, rp = samp && kind != 2 && kind != 5;
        const int j0 = wc * 32 + 8 * fq, t4 = 4 * (4 * wc + fq);
        if (nrm) {
#pragma unroll
            for (int ai = 0; ai < 2; ++ai)
#pragma unroll
                for (int m = 0; m < 4; ++m)
#pragma unroll
                    for (int bj = 0; bj < 2; ++bj) { const f32x4 a = acc[ai][bj][m][0], c = acc[ai][bj][m][1];
                        float ss = (a[0] * a[0] + a[1] * a[1]) + (a[2] * a[2] + a[3] * a[3]) + (c[0] * c[0] + c[1] * c[1]) + (c[2] * c[2] + c[3] * c[3]);
                        ss += __shfl_xor(ss, 16); ss += __shfl_xor(ss, 32);
                        if (fq == 0) P[((ai * HALF + wr * 64 + m * 16 + fr) * 2 + bj) * 4 + wc] = ss; }
            asm volatile("s_waitcnt lgkmcnt(0)" ::: "memory"); __builtin_amdgcn_s_barrier(); asm volatile("" ::: "memory");
        }
        f32x4 glo = {1.f, 1.f, 1.f, 1.f}, ghi = glo;
        if (nrm) { glo = *(const f32x4*)(qkn + kind * 128 + t4); ghi = *(const f32x4*)(qkn + kind * 128 + 64 + t4); }
#pragma unroll
        for (int ai = 0; ai < 2; ++ai)
#pragma unroll
            for (int m = 0; m < 4; ++m) {
                const int rl = ai * HALF + wr * 64 + m * 16 + fr, row = pm * BM + rl, tok = tb + rl;
                const size_t kvrow = samp ? (size_t)(8192 + b * 4352 + tok) : (size_t)row;
                f32x4 cs0 = {1.f, 0.f, 1.f, 0.f}, cs1 = cs0;
                if (rp) { cs0 = *(const f32x4*)(rope + ((size_t)tok * 64 + t4) * 2); cs1 = *(const f32x4*)(rope + ((size_t)tok * 64 + t4) * 2 + 4); }
#pragma unroll
                for (int bj = 0; bj < 2; ++bj) {
                    f32x4 v0 = acc[ai][bj][m][0], v1 = acc[ai][bj][m][1];
                    if (nrm) { const f32x4 q = *(const PG8_LAS f32x4*)(P + (rl * 2 + bj) * 4); const float r = 1.0f / sqrtf(((q[0] + q[1]) + (q[2] + q[3])) * (1.f / 128.f) + 1e-6f);
                        v0 = (f32x4){v0[0] * r * glo[0], v0[1] * r * ghi[0], v0[2] * r * glo[1], v0[3] * r * ghi[1]};
                        v1 = (f32x4){v1[0] * r * glo[2], v1[1] * r * ghi[2], v1[2] * r * glo[3], v1[3] * r * ghi[3]}; }
                    if (rp) {
                        v0 = (f32x4){v0[0] * cs0[0] - v0[1] * cs0[1], v0[0] * cs0[1] + v0[1] * cs0[0], v0[2] * cs0[2] - v0[3] * cs0[3], v0[2] * cs0[3] + v0[3] * cs0[2]};
                        v1 = (f32x4){v1[0] * cs1[0] - v1[1] * cs1[1], v1[0] * cs1[1] + v1[1] * cs1[0], v1[2] * cs1[2] - v1[3] * cs1[3], v1[2] * cs1[3] + v1[3] * cs1[2]}; }
                    u32x4 w; w.x = cvt_pk_bf16(v0[0], v0[1]); w.y = cvt_pk_bf16(v0[2], v0[3]); w.z = cvt_pk_bf16(v1[0], v1[1]); w.w = cvt_pk_bf16(v1[2], v1[3]);
                    if (kind == 0) *(u32x4*)(QH + (size_t)row * 2048 + (2 * pn + bj) * 128 + j0) = w;
                    else if (kind == 3) *(u32x4*)(QH + (size_t)row * 2048 + 1024 + (2 * (pn - 6) + bj) * 128 + j0) = w;
                    else if (kind == 1 || kind == 4) {
                        const int hb = (kind == 1) ? bj * 128 : 256 + (2 * (pn - 10) + bj) * 128;
                        *(u32x4*)(KBf + kvrow * 1280 + hb + j0) = w;
                        if (!samp) { float* o = (kind == 1) ? out + 35651584 - 2097152 + (size_t)row * 256 + bj * 128 : out + 37748736 + (size_t)row * 1024 + (2 * (pn - 10) + bj) * 128;
                            *(f32x4*)(o + t4) = (f32x4){v0[0], v0[2], v1[0], v1[2]}; *(f32x4*)(o + 64 + t4) = (f32x4){v0[1], v0[3], v1[1], v1[3]}; }
                    } else {
                        const int hb = (kind == 2) ? bj * 128 : 256 + (pn - 14) * 256 + bj * 128;
                        *(u32x4*)(VBf + kvrow * 1280 + hb + j0) = w;
                        if (!samp) { float* o = (kind == 2) ? out + 35651584 + (size_t)row * 256 + bj * 128 : out + 46137344 + (size_t)row * 1024 + (pn - 14) * 256 + bj * 128;
                            *(f32x4*)(o + j0) = v0; *(f32x4*)(o + j0 + 4) = v1; }
                    }
                }
            }
    }
};
}

#define LAS __attribute__((address_space(3)))
#define GAS __attribute__((address_space(1)))
constexpr int NWAVES = 8;
constexpr int RING_OFF = 0, RING_BYTES = 143360, LDSCTL_OFF = RING_BYTES, MISC_OFF = LDSCTL_OFF + 320, LDS_BYTES = RING_BYTES + 8192;
constexpr size_t WO_QKV = 0, WO_AO = 18 * MiB, WO_W1 = 26 * MiB, WO_W2 = 90 * MiB, WO_SI = 154 * MiB, WO_GL = 162 * MiB, WO_SO = 170 * MiB;
constexpr int CW_BAR = 4096, CW_ATTQ = 2048;

#define XB_TMO      128
#define XB_XCNT(j)  (256  + 64 * (j))
#define XB_XSUB(j)  (1280 + 64 * (j))
#define XB_XGEN(j)  (2304 + 64 * (j))
#define XB_TOP      3328
#define XB_TOPGEN   3392
#define XCD_BAR_WORDS 3456
#define XB_SPIN_CAP (1u << 18)
__device__ __forceinline__ unsigned xb_ld(unsigned* p)              { return __hip_atomic_load(p, __ATOMIC_RELAXED, __HIP_MEMORY_SCOPE_AGENT); }
__device__ __forceinline__ unsigned xb_add(unsigned* p, unsigned v) { return __hip_atomic_fetch_add(p, v, __ATOMIC_RELAXED, __HIP_MEMORY_SCOPE_AGENT); }
__device__ __forceinline__ unsigned xb_xcc_id() { return (unsigned)__builtin_amdgcn_s_getreg((3 << 11) | 20) & 0xFu; }
#define XB_SPIN(cond, bar) do { unsigned _sp = 0; while (cond) { __builtin_amdgcn_s_sleep(1); \
    if ((++_sp & 255u) == 0u) { if (xb_ld(&(bar)[XB_TMO])) break; if (_sp > XB_SPIN_CAP) { atomicAdd(&(bar)[XB_TMO], 1u); break; } } } } while (0)
struct XcdBarrier { unsigned* bar; unsigned x; volatile LAS unsigned* st; };
__device__ __forceinline__ XcdBarrier xcd_barrier_post(unsigned* bar, volatile LAS unsigned* st) {
    XcdBarrier b; b.bar = bar; b.x = xb_xcc_id(); b.st = st;
    if (threadIdx.x == 0) (void)xb_add(&bar[XB_XCNT(b.x)], 1u);
    return b;
}
__device__ __forceinline__ void xcd_barrier_complete(unsigned* bar, unsigned x, unsigned& nloc, unsigned& nx) {
    const unsigned G = gridDim.x * gridDim.y * gridDim.z;
    unsigned sum, cnt, mine, sp = 0u;
    for (;;) {
        sum = 0u; cnt = 0u; mine = 0u;
#pragma unroll
        for (unsigned j = 0; j < 16; ++j) { const unsigned c = xb_ld(&bar[XB_XCNT(j)]); sum += c; cnt += (c > 0u) ? 1u : 0u; mine = (j == x) ? c : mine; }
        if (sum == G) break;
        __builtin_amdgcn_s_sleep(1);
        if ((++sp & 255u) == 0u) { if (xb_ld(&bar[XB_TMO])) break; if (sp > XB_SPIN_CAP) { atomicAdd(&bar[XB_TMO], 1u); break; } }
    }
    nloc = mine > 0u ? mine : 1u; nx = cnt > 0u ? cnt : 1u;
}
__device__ __forceinline__ void xcd_barrier(const XcdBarrier& b) {
    asm volatile("s_waitcnt vmcnt(0)" ::: "memory");
    __syncthreads();
    if (threadIdx.x == 0) {
        unsigned* bar = b.bar;
        __builtin_amdgcn_s_waitcnt(0);
        unsigned nloc = b.st[0], nx = b.st[1];
        if (nloc == 0u) { xcd_barrier_complete(bar, b.x, nloc, nx); b.st[0] = nloc; b.st[1] = nx; }
        const unsigned old = xb_add(&bar[XB_XSUB(b.x)], 1u);
        const unsigned gen = old / nloc;
        if (old + 1u == (gen + 1u) * nloc) {
            __builtin_amdgcn_fence(__ATOMIC_RELEASE, "agent");
            asm volatile("s_waitcnt vmcnt(0)" ::: "memory");
            const unsigned og = xb_add(&bar[XB_TOP], 1u);
            const unsigned tg = og / nx;
            if (og + 1u == (tg + 1u) * nx) xb_add(&bar[XB_TOPGEN], 1u);
            else XB_SPIN(xb_ld(&bar[XB_TOPGEN]) == tg, bar);
            __builtin_amdgcn_fence(__ATOMIC_ACQUIRE, "agent");
            xb_add(&bar[XB_XGEN(b.x)], 1u);
            asm volatile("s_waitcnt vmcnt(0)" ::: "memory");
        } else {
            XB_SPIN(xb_ld(&bar[XB_XGEN(b.x)]) == gen, bar);
            __builtin_amdgcn_fence(__ATOMIC_ACQUIRE, "agent");
            asm volatile("s_waitcnt vmcnt(0)" ::: "memory");
        }
    }
    __syncthreads();
}

struct TItem { const float* src; bf16_t* dst; int N, K, n0, k0, qperm; };
__device__ __forceinline__ TItem titem_decode(const CP& p, int first, int it) {
    constexpr int I_QKV = (D / 64) * (NQKV / 32), I_SQ = (D / 64) * (D / 32), I_W1 = (D / 64) * (DFF / 32), I_W2 = (DFF / 64) * (D / 32);
    unsigned char* wb = p.ws + WS_W; TItem t; int r = it; t.qperm = 0;
    if (first == 0) {
        if (r < I_QKV) { t.src = p.attn_w_in; t.dst = (bf16_t*)(wb + WO_QKV); t.N = NQKV; t.K = D; t.qperm = 1; }
        else if ((r -= I_QKV) < I_SQ) { t.src = p.attn_w_out; t.dst = (bf16_t*)(wb + WO_AO); t.N = D; t.K = D; }
        else if ((r -= I_SQ) < I_W1) { t.src = p.mlp_w1; t.dst = (bf16_t*)(wb + WO_W1); t.N = DFF; t.K = D; }
        else { r -= I_W1; t.src = p.mlp_w2; t.dst = (bf16_t*)(wb + WO_W2); t.N = D; t.K = DFF; }
    } else {
        if (r < I_SQ) { t.src = p.ssm_w_in; t.dst = (bf16_t*)(wb + WO_SI); t.N = D; t.K = D; }
        else if ((r -= I_SQ) < I_SQ) { t.src = p.ssm_glu_w; t.dst = (bf16_t*)(wb + WO_GL); t.N = D; t.K = D; }
        else if ((r -= I_SQ) < I_SQ) { t.src = p.ssm_w_out; t.dst = (bf16_t*)(wb + WO_SO); t.N = D; t.K = D; }
        else if ((r -= I_SQ) < I_W1) { t.src = p.mlp_w1 + (size_t)D * DFF; t.dst = (bf16_t*)(wb + WO_W1 + 32 * MiB); t.N = DFF; t.K = D; }
        else { r -= I_W1; t.src = p.mlp_w2 + (size_t)DFF * D; t.dst = (bf16_t*)(wb + WO_W2 + 32 * MiB); t.N = D; t.K = DFF; }
    }
    const int nblk = t.N / 32, kb = r / nblk, nb = r % nblk; t.k0 = 64 * kb; t.n0 = 32 * nb;
    return t;
}
__device__ __forceinline__ int qkv_pos(int c) {
    const bool isv = (c >= 1280 && c < 1536) || c >= 3584; if (isv) return c;
    const int cl = c & 127, i = cl & 63, s = cl >> 6; return (c & ~127) + 8 * (i >> 2) + 2 * (i & 3) + s;
}
__device__ __forceinline__ void titem_load(float (&wv)[32], const TItem& t, int lane) {
    const float* s = t.src + (size_t)(t.k0 + (lane >> 3)) * t.N + t.n0 + (lane & 7) * 4;
#pragma unroll
    for (int i = 0; i < 8; ++i) { const f32x4 v = *(const f32x4*)(s + (size_t)(8 * i) * t.N); wv[4 * i] = v[0]; wv[4 * i + 1] = v[1]; wv[4 * i + 2] = v[2]; wv[4 * i + 3] = v[3]; }
}
__device__ __forceinline__ void titem_store(const float (&wv)[32], const TItem& t, LAS float* scr, int lane) {
#pragma unroll
    for (int i = 0; i < 8; ++i) { LAS float* d = scr + ((lane >> 3) + 8 * i) * 33 + (lane & 7) * 4; d[0] = wv[4 * i]; d[1] = wv[4 * i + 1]; d[2] = wv[4 * i + 2]; d[3] = wv[4 * i + 3]; }
    asm volatile("s_waitcnt lgkmcnt(0)" ::: "memory");
    const int c = lane & 7;
#pragma unroll
    for (int j = 0; j < 4; ++j) { const int n = (lane >> 3) + 8 * j; const LAS float* s = scr + (8 * c) * 33 + n;
        u32x4 o; o.x = pk2(s[0 * 33], s[1 * 33]); o.y = pk2(s[2 * 33], s[3 * 33]); o.z = pk2(s[4 * 33], s[5 * 33]); o.w = pk2(s[6 * 33], s[7 * 33]);
        const int row = t.qperm ? qkv_pos(t.n0 + n) : t.n0 + n;
        *(u32x4*)(t.dst + (size_t)row * t.K + t.k0 + 8 * c) = o; }
    asm volatile("s_waitcnt lgkmcnt(0)" ::: "memory");
}
__device__ __forceinline__ void transpose_run(const CP& p, LAS float* scr, int lane, int first, int start, int stride, int end) {
    if (start >= end) return;
    float wa[32], wb[32]; TItem ta = titem_decode(p, first, start), tb = ta;
    titem_load(wa, ta, lane);
    int it = start;
    for (;;) {
        const int i1 = it + stride; const bool h1 = i1 < end;
        if (h1) { tb = titem_decode(p, first, i1); titem_load(wb, tb, lane); }
        asm volatile("" ::: "memory");
        titem_store(wa, ta, scr, lane);
        if (!h1) break;
        const int i2 = i1 + stride; const bool h2 = i2 < end;
        if (h2) { ta = titem_decode(p, first, i2); titem_load(wa, ta, lane); }
        asm volatile("" ::: "memory");
        titem_store(wb, tb, scr, lane);
        if (!h2) break;
        it = i2;
    }
}
__device__ __forceinline__ void ph_prologue(const CP& p, LAS unsigned char* L, int lane, int wave) {
    const int gw = blockIdx.x * NWAVES + wave, NGW = gridDim.x * NWAVES;
    LAS float* sl = (LAS float*)(L + RING_OFF + 8 * 8704);
    for (int j = threadIdx.x; j < 3 * D; j += NWAVES * 64) { const int cls = j / D, k = j - cls * D; const float c0 = (cls == 0) ? p.c_ctx[k] : p.c[(cls - 1) * D + k]; sl[j] = c0 / (1.f + expf(-c0)); }
    __syncthreads();
    for (int it = gw; it < 2 * KCH * 48; it += NGW) {
        const int cb = it % 48, kc = (it / 48) % KCH, l = it / (48 * KCH);
        const float* w = p.ada_w + ((size_t)l * D + kc * 128) * NMOD + cb * 256 + lane * 4;
        f32x4 a0 = {0, 0, 0, 0}, a1 = a0, a2 = a0;
#pragma unroll 16
        for (int kk = 0; kk < 128; ++kk) {
            const int k = kc * 128 + kk;
            const float s0 = sl[k], s1 = sl[D + k], s2 = sl[2 * D + k];
            const f32x4 wv = *(const f32x4*)(w + (size_t)kk * NMOD);
            a0 += wv * s0; a1 += wv * s1; a2 += wv * s2;
        }
        float* o = (float*)(p.ws + WS_MODP) + ((size_t)(l * KCH + kc) * 3) * NMOD + cb * 256 + lane * 4;
        *(f32x4*)(o) = a0; *(f32x4*)(o + NMOD) = a1; *(f32x4*)(o + 2 * NMOD) = a2;
    }
    {
        LAS float* scr = (LAS float*)(L + RING_OFF + wave * 8704);
        constexpr int I_QKV = (D / 64) * (NQKV / 32), I_SQ = (D / 64) * (D / 32), I_W1 = (D / 64) * (DFF / 32), I_W2 = (DFF / 64) * (D / 32);
        constexpr int NITEMS0 = I_QKV + I_SQ + I_W1 + I_W2, NGEMV = 2 * KCH * 48;
        const int ng = NGW < NGEMV ? NGW : NGEMV;
        const int split = (NGW > ng) ? 8 * ng : NITEMS0;
        if (gw < ng) transpose_run(p, scr, lane, 0, gw, ng, split);
        else transpose_run(p, scr, lane, 0, split + (gw - ng), NGW - ng, NITEMS0);
    }
    for (int i = gw * 64 + lane; i < LQ * 64; i += NGW * 64) {
        const int t = i >> 6, j = i & 63;
        const float inv = powf(10000.f, -(float)(j & 31) / 32.f);
        const float pos = (j < 32) ? (float)(t >> 6) : (float)(t & 63);
        const float ang = pos * inv;
        ((f32x2*)(p.ws + WS_ROPE))[i] = (f32x2){cosf(ang), sinf(ang)};
    }
    for (int i2 = gw * 64 + lane; i2 < 2 * 128 * 64 * 16; i2 += NGW * 64) {
        const int c = i2 & 15, i = i2 >> 4, n = i & 63, kg = i >> 6;
        const float are = p.ssm_a_re[i], aim = p.ssm_a_im[i], dt = expf(p.ssm_log_dt[kg]);
        const float er = expf(are * dt), abr = er * cosf(aim * dt), abi = er * sinf(aim * dt);
        const float nr = abr - 1.f, ni = abi, den = are * are + aim * aim; const float cr = (nr * are + ni * aim) / den, ci = (ni * are - nr * aim) / den;
        if (c == 0) {
            ((f32x2*)(p.ws + WS_ABAR))[i] = (f32x2){abr, abi};
            float pr = abr, pi_ = abi;
#pragma unroll
            for (int s = 0; s < 8; ++s) { const float t = pr * pr - pi_ * pi_; pi_ = 2.f * pr * pi_; pr = t; }
            ((f32x2*)(p.ws + WS_A256))[i] = (f32x2){pr, pi_};
        }
        bf16_t* bbar = (bf16_t*)(p.ws + WS_BBAR) + (size_t)kg * 4 * 512; bf16_t* cmat = (bf16_t*)(p.ws + WS_CMAT) + (size_t)kg * 4 * 512;
        const int nn = n & 31, nh = n >> 5;
        const float br = p.ssm_b_re[(size_t)i * 16 + c], bi = p.ssm_b_im[(size_t)i * 16 + c];
        const int ln = (c >> 3) * 32 + nn, j = c & 7;
        bbar[(nh) * 512 + ln * 8 + j] = (bf16_t)f2bf(cr * br - ci * bi);
        bbar[(2 + nh) * 512 + ln * 8 + j] = (bf16_t)f2bf(cr * bi + ci * br);
        {
          const float vr = cr * br - ci * bi, vi = cr * bi + ci * br; float pr = 1.f, pi_ = 0.f;
#pragma unroll
          for (int e = 0; e < 4; ++e) {
              bf16_t* b4 = (bf16_t*)(p.ws + WS_BB4) + ((size_t)(3 - e) * 256 + kg) * 4 * 512;
              b4[(nh) * 512 + ln * 8 + j] = (bf16_t)f2bf(pr * vr - pi_ * vi); b4[(2 + nh) * 512 + ln * 8 + j] = (bf16_t)f2bf(pr * vi + pi_ * vr);
              const float t = pr * abr - pi_ * abi; pi_ = pr * abi + pi_ * abr; pr = t; }
          if (c == 0) ((f32x2*)(p.ws + WS_A4))[i] = (f32x2){pr, pi_}; }
        const float c_re = p.ssm_c_re[((size_t)kg * 16 + c) * 64 + n], c_im = p.ssm_c_im[((size_t)kg * 16 + c) * 64 + n];
        const int K0 = 4 * nn + 2 * nh;
        { const int K = K0, s = K >> 5, l2 = c + 16 * ((K & 31) >> 3), jj = K & 7; cmat[s * 512 + l2 * 8 + jj] = (bf16_t)f2bf(c_re); }
        { const int K = K0 + 1, s = K >> 5, l2 = c + 16 * ((K & 31) >> 3), jj = K & 7; cmat[s * 512 + l2 * 8 + jj] = (bf16_t)f2bf(-c_im); }
    }
    bf16_t* KBf = (bf16_t*)(p.ws + WS_KB); bf16_t* VBf = (bf16_t*)(p.ws + WS_VB);
    for (int r = gw; r < 512; r += NGW) {
        const int b = r >> 8, t = r & 255; const size_t kr = (size_t)(MP + b * LKV + LQ + t) * KVW;
        for (int c = lane * 2; c < 256; c += 128) { const size_t s = ((size_t)(b * 256 + t)) * 256 + c;
            KBf[kr + qkv_pos(c)] = (bf16_t)f2bf(p.cache_a_k[s]); KBf[kr + qkv_pos(c + 1)] = (bf16_t)f2bf(p.cache_a_k[s + 1]); *(unsigned*)(VBf + kr + c) = pk2(p.cache_a_v[s], p.cache_a_v[s + 1]); }
        for (int c = lane * 2; c < 1024; c += 128) { const size_t s = ((size_t)(b * 256 + t)) * 1024 + c;
            KBf[kr + 256 + qkv_pos(c)] = (bf16_t)f2bf(p.cache_b_k[s]); KBf[kr + 256 + qkv_pos(c + 1)] = (bf16_t)f2bf(p.cache_b_k[s + 1]); *(unsigned*)(VBf + kr + 256 + c) = pk2(p.cache_b_v[s], p.cache_b_v[s + 1]); }
    }
}


__device__ __forceinline__ void ph_late_weights(const CP& p, LAS unsigned char* L, int lane, int wave, int widx, int nw) {
    LAS float* scr = (LAS float*)(L + RING_OFF + wave * 8704);
    constexpr int I_SQ = (D / 64) * (D / 32), I_W1 = (D / 64) * (DFF / 32), I_W2 = (DFF / 64) * (D / 32);
    transpose_run(p, scr, lane, 1, widx, nw, 3 * I_SQ + I_W1 + I_W2);
}

template <bool FINAL>
__device__ __forceinline__ void ld_mod(const CP& p, LAS float* dst, int l, int cls, int idx, int tid) {
    for (int j = tid; j < D; j += NWAVES * 64) {
        if (FINAL) { dst[j] = ((const float*)(p.ws + WS_MOD))[((size_t)(l * 3 + cls) * 6 + idx) * D + j]; }
        else {
            float s = p.ada_b[l * NMOD + idx * D + j];
            const float* mp = (const float*)(p.ws + WS_MODP) + ((size_t)(l * KCH) * 3 + cls) * NMOD + idx * D + j;
#pragma unroll
            for (int kc = 0; kc < KCH; ++kc) s += mp[(size_t)kc * 3 * NMOD];
            dst[j] = s;
        }
    }
}
__device__ __forceinline__ void mod_finish(const CP& p, int tid) {
    const int per = (2 * 3 * NMOD + (int)gridDim.x - 1) / (int)gridDim.x;
    for (int i = (int)blockIdx.x * per + tid; i < ((int)blockIdx.x + 1) * per && i < 2 * 3 * NMOD; i += NWAVES * 64) {
        const int j = i % NMOD, cls = (i / NMOD) % 3, l = i / (3 * NMOD);
        float s = p.ada_b[l * NMOD + j];
        const float* mp = (const float*)(p.ws + WS_MODP) + ((size_t)(l * KCH) * 3 + cls) * NMOD + j;
#pragma unroll
        for (int kc = 0; kc < KCH; ++kc) s += mp[(size_t)kc * 3 * NMOD];
        ((float*)(p.ws + WS_MOD))[i] = s;
    }
}
struct RowIn { f32x4 xf[8]; u32x2 xh[8]; u32x2 ow[8]; };
template <bool BR, bool XIN16>
__device__ __forceinline__ void row_load(RowIn& in, int m, int lane, const float* xin_row, const bf16_t* xin16, const bf16_t* o) {
    if (XIN16) {
#pragma unroll
        for (int j = 0; j < 8; ++j) in.xh[j] = *(const u32x2*)(xin16 + (size_t)m * D + j * 256 + lane * 4);
    } else {
#pragma unroll
        for (int j = 0; j < 8; ++j) in.xf[j] = *(const f32x4*)(xin_row + j * 256 + lane * 4);
    }
    if (BR) {
#pragma unroll
        for (int j = 0; j < 8; ++j) in.ow[j] = *(const u32x2*)(o + (size_t)m * D + j * 256 + lane * 4);
    }
}
template <bool BR, bool NX, bool XIN16, bool XOUT16>
__device__ __forceinline__ void row_compute(const CP& p, const RowIn& in, int m, int lane, bf16_t* xout16, bf16_t* xn,
                                            const LAS float* gate, const float* gp, const LAS float* sh, const LAS float* sc, const float* gn) {
    f32x4 x[8];
#pragma unroll
    for (int j = 0; j < 8; ++j) {
        if (XIN16) { const u32x2 w = in.xh[j]; x[j] = (f32x4){__uint_as_float(w.x << 16), __uint_as_float(w.x & 0xffff0000u), __uint_as_float(w.y << 16), __uint_as_float(w.y & 0xffff0000u)}; }
        else x[j] = in.xf[j];
    }
    if (BR) {
        f32x4 ov[8]; float ss = 0.f;
#pragma unroll
        for (int j = 0; j < 8; ++j) { const u32x2 w = in.ow[j];
            ov[j] = (f32x4){__uint_as_float(w.x << 16), __uint_as_float(w.x & 0xffff0000u), __uint_as_float(w.y << 16), __uint_as_float(w.y & 0xffff0000u)};
            ss += ov[j].x * ov[j].x + ov[j].y * ov[j].y + ov[j].z * ov[j].z + ov[j].w * ov[j].w; }
        const float r = 1.0f / sqrtf(wave_sum(ss) * (1.f / D) + EPS);
        float* xo = p.out + OUT_Y + (size_t)m * D;
#pragma unroll
        for (int j = 0; j < 8; ++j) { const f32x4 g4 = *(const LAS f32x4*)(gate + j * 256 + lane * 4);
            x[j] = x[j] + g4 * (ov[j] * r);
            if (XOUT16) { u32x2 w; w.x = pk2(x[j].x, x[j].y); w.y = pk2(x[j].z, x[j].w); *(u32x2*)(xout16 + (size_t)m * D + j * 256 + lane * 4) = w; }
            else *(f32x4*)(xo + j * 256 + lane * 4) = x[j]; }
    }
    if (NX) {
        float ss = 0.f;
#pragma unroll
        for (int j = 0; j < 8; ++j) ss += x[j].x * x[j].x + x[j].y * x[j].y + x[j].z * x[j].z + x[j].w * x[j].w;
        const float r = 1.0f / sqrtf(wave_sum(ss) * (1.f / D) + EPS);
#pragma unroll
        for (int j = 0; j < 8; ++j) { const f32x4 s4 = *(const LAS f32x4*)(sh + j * 256 + lane * 4), c4 = *(const LAS f32x4*)(sc + j * 256 + lane * 4);
            const f32x4 v = (x[j] * r) * c4 + s4;
            u32x2 w; w.x = pk2(v.x, v.y); w.y = pk2(v.z, v.w); *(u32x2*)(xn + (size_t)m * D + j * 256 + lane * 4) = w; }
    }
}
template <bool BR, bool NX, bool XIN16, bool XOUT16>
__device__ __forceinline__ void rows8(const CP& p, int mbase, int lane, const bf16_t* xin16, bf16_t* xout16, const bf16_t* o, bf16_t* xn,
                                      const LAS float* gate, const float* gp, const LAS float* sh, const LAS float* sc, const float* gn) {
#define ROW_LD(R, mm) row_load<BR, XIN16>(R, (mm), lane, XIN16 ? nullptr : x_row(p, (mm)), xin16, o); asm volatile("" ::: "memory")
#define ROW_DO(R, mm) row_compute<BR, NX, XIN16, XOUT16>(p, R, (mm), lane, xout16, xn, gate, gp, sh, sc, gn)
    RowIn A, B; ROW_LD(A, mbase);
#pragma unroll 1
    for (int i = 0; i < 6; i += 2) {
        ROW_LD(B, mbase + i + 1); ROW_DO(A, mbase + i);
        ROW_LD(A, mbase + i + 2); ROW_DO(B, mbase + i + 1);
    }
    ROW_LD(B, mbase + 7); ROW_DO(A, mbase + 6); ROW_DO(B, mbase + 7);
#undef ROW_LD
#undef ROW_DO
}
template <int MODE>
__device__ __forceinline__ void ph_rowop(const CP& p, LAS unsigned char* L, int tid, int lane, int wave, int l, const bf16_t* o, bf16_t* xn) {
    LAS float* vg = (LAS float*)(L + RING_OFF); LAS float* vs = vg + D; LAS float* vc = vs + D;
    constexpr bool BR = MODE != 0, NX = MODE != 3;
    const int lb = l, ib = (MODE == 1) ? 0 : 3, ln = (MODE == 2) ? l + 1 : l, in_ = (MODE == 1) ? 3 : 0;
    int cur = -1;
    const bool own = gridDim.x == 256;
    for (int mb_ = blockIdx.x * 64; mb_ < M; mb_ += gridDim.x * 64) {
        const int c_ = (int)blockIdx.x, m0 = own ? (8 * (c_ % 8) + (c_ / 8) % 8) * 256 + 64 * (c_ / 64) : mb_;
        const int cls = row_class(m0);
        if (cls != cur) {
            __syncthreads();
            const float* gp = p.norm_g + (size_t)(lb * 4 + (ib == 0 ? 1 : 3)) * D; const float* gn = p.norm_g + (size_t)(ln * 4 + (in_ == 0 ? 0 : 2)) * D;
            if (BR) ld_mod<MODE != 0>(p, vg, lb, cls, ib + 2, tid);
            if (NX) { ld_mod<MODE != 0>(p, vs, ln, cls, in_, tid); ld_mod<MODE != 0>(p, vc, ln, cls, in_ + 1, tid); }
            for (int j = tid; j < D; j += NWAVES * 64) {
                if (BR) vg[j] = vg[j] * gp[j];
                if (NX) vc[j] = (vc[j] + 1.0f) * gn[j]; }
            __syncthreads(); cur = cls;
        }
        const float* gp = nullptr; const float* gn = nullptr;
        { const int mb = m0 + wave * 8;
            bf16_t* XR = (bf16_t*)(p.ws + WS_QH);
            if (MODE == 0) rows8<BR, NX, false, true>(p, mb, lane, nullptr, nullptr, o, xn, vg, gp, vs, vc, gn);
            else if (MODE == 1 && l == 0) rows8<BR, NX, false, true>(p, mb, lane, nullptr, XR, o, xn, vg, gp, vs, vc, gn);
            else if (MODE == 3) rows8<BR, NX, true, false>(p, mb, lane, XR, nullptr, o, xn, vg, gp, vs, vc, gn);
            else rows8<BR, NX, true, true>(p, mb, lane, XR, XR, o, xn, vg, gp, vs, vc, gn); }
    }
    if (MODE == 0) mod_finish(p, tid);
    __syncthreads();
}

__device__ __forceinline__ void ph_combine(const CP& p, int lane, int wave, bf16_t* OC) {
    const int gw = blockIdx.x * NWAVES + wave, NGW = gridDim.x * NWAVES;
    const bf16_t* O = (const bf16_t*)(p.ws + WS_O);
    const float* lp = p.diff_lambda;
    const float s1 = wave_sum(lp[2 * lane] * lp[128 + 2 * lane] + lp[2 * lane + 1] * lp[128 + 2 * lane + 1]);
    const float s2 = wave_sum(lp[256 + 2 * lane] * lp[384 + 2 * lane] + lp[256 + 2 * lane + 1] * lp[384 + 2 * lane + 1]);
    const float lam_init = 0.2f, lam = expf(s1) - expf(s2) + lam_init;
    for (int m = gw; m < M; m += NGW) {
        const bf16_t* orow = O + (size_t)m * D - 1024; bf16_t* oc = OC + (size_t)m * D;
#pragma unroll
        for (int h = 0; h < 4; ++h) {
            float v[2][2]; float ss = 0.f;
#pragma unroll
            for (int vh = 0; vh < 2; ++vh) {
                const unsigned w0 = *(const unsigned*)(orow + 1024 + (4 * h + vh) * 128 + 2 * lane), w1 = *(const unsigned*)(orow + 1024 + (4 * h + 2 + vh) * 128 + 2 * lane);
                v[vh][0] = __uint_as_float(w0 << 16) - lam * __uint_as_float(w1 << 16); v[vh][1] = __uint_as_float(w0 & 0xffff0000u) - lam * __uint_as_float(w1 & 0xffff0000u);
                ss += v[vh][0] * v[vh][0] + v[vh][1] * v[vh][1];
            }
            const float r = (1.0f / sqrtf(wave_sum(ss) * (1.f / 256.f) + EPS)) * (1.f - lam_init);
#pragma unroll
            for (int vh = 0; vh < 2; ++vh) { const float* g = p.diff_subln + vh * 128 + 2 * lane;
                *(unsigned*)(oc + 1024 + h * 256 + vh * 128 + 2 * lane) = pk2(v[vh][0] * r * g[0], v[vh][1] * r * g[1]); }
        }
    }
}

template <int ACT>
__device__ __forceinline__ void ph_gemm(LAS unsigned char* L, const bf16_t* A, const bf16_t* Bt, int N, int K, bf16_t* C, const bf16_t* aux, int wgm = pg8::WGM) {
    pg8::Gemm g{A, Bt, M, N, K}; pg8::StaticOrder S; S.init(M, N, (int)gridDim.x, (int)blockIdx.x, wgm);
    pg8::EpiStore<ACT> E{C, N, aux};
    pg8::gemm_phase<pg8::EpiStore<ACT>, pg8::StaticOrder, true, true>(L + RING_OFF, g, S, E);
}


__device__ __forceinline__ void ph_gemm_qkv(const CP& p, LAS unsigned char* L, const bf16_t* A, const bf16_t* Bt, int lane, int wave) {
    pg8::Gemm g{A, Bt, M, NQKV, D}; pg8::StaticOrder S; S.init(M, NQKV, (int)gridDim.x, (int)blockIdx.x);
    pg8::EpiQKV E{(bf16_t*)(p.ws + WS_QH), (bf16_t*)(p.ws + WS_KB), (bf16_t*)(p.ws + WS_VB), p.out, p.qk_norm, (const float*)(p.ws + WS_ROPE), (LAS float*)(L + 131072)};
    pg8::gemm_phase<pg8::EpiQKV, pg8::StaticOrder, true, true>(L + RING_OFF, g, S, E);
    const int G = (int)gridDim.x, nfull = 1152 / G, first_idle = 1152 - nfull * G;
    if ((int)blockIdx.x >= first_idle) ph_late_weights(p, L, lane, wave, ((int)blockIdx.x - first_idle) * NWAVES + wave, (G - first_idle) * NWAVES);
}

__device__ __forceinline__ void ph_attn(const CP& p, unsigned char* lds, bf16_t* OC) {
    const int G = gridDim.x, bx = blockIdx.x;
    const int vcu = (G % 8 == 0) ? (bx % 8) * (G / 8) + bx / 8 : bx;
    const bf16_t* QH = (const bf16_t*)(p.ws + WS_QH); const bf16_t* KBf = (const bf16_t*)(p.ws + WS_KB); const bf16_t* VBf = (const bf16_t*)(p.ws + WS_VB);
    bf16_t* O = (bf16_t*)(p.ws + WS_O);
    for (int U = vcu; U < 256; U += G) {
        const int b = U >> 7, hm = (U >> 4) & 7, qb = U & 15, qrow0 = MP + b * LQ + qb * 256, krow0 = MP + b * LKV;
        int seq = LKV; asm volatile("" : "+s"(seq));
        att::attn_wide_body<2>((const att::bf16*)(QH + (size_t)qrow0 * D + 1024 + hm * 128), (const att::bf16*)(KBf + (size_t)krow0 * KVW + 256 + hm * 128),
                            (const att::bf16*)(VBf + (size_t)krow0 * KVW + 256 + (hm >> 1) * 256), O + (size_t)qrow0 * D + hm * 256, D, seq, (char*)lds);
    }
    for (int U = vcu; U < 256; U += G) {
        const int b = U >> 7, inst = (U >> 4) & 7, qb = U & 15, qrow0 = MP + b * LQ + qb * 256, krow0 = MP + b * LKV;
        int seq = LKV; asm volatile("" : "+s"(seq));
        const int koff = (inst >> 2) * 128;
        att::attn_wide_body<1>((const att::bf16*)(QH + (size_t)qrow0 * D + inst * 128), (const att::bf16*)(KBf + (size_t)krow0 * KVW + koff),
                               (const att::bf16*)(VBf + (size_t)krow0 * KVW + koff), OC + (size_t)qrow0 * D + inst * 128, D, seq, (char*)lds);
    }
    __syncthreads();
    for (int t = vcu; t < 768; t += G) {
        const int b = (int)t / 24, inst = (int)t % 24, qrow0 = b * 256, krow0 = b * 256;
        int qoff, koff, voff, ooff;
        if (inst < 8) { qoff = inst * 128; koff = (inst >> 2) * 128; voff = koff; ooff = inst * 128; }
        else { const int i2 = inst - 8, hm = i2 >> 1, vh = i2 & 1; qoff = 1024 + hm * 128; koff = 256 + hm * 128; voff = 256 + (hm >> 1) * 256 + vh * 128; ooff = 1024 + i2 * 128; }
        bf16_t* op = (inst < 8) ? OC + (size_t)qrow0 * D + ooff : O + (size_t)qrow0 * D + (ooff - 1024);
        att::attn_small_body((const att::bf16*)(QH + (size_t)qrow0 * D + qoff), (const att::bf16*)(KBf + (size_t)krow0 * KVW + koff),
                             (const att::bf16*)(VBf + (size_t)krow0 * KVW + voff), op, D, (char*)lds);
    }
}


typedef short s16x8 __attribute__((ext_vector_type(8)));
typedef float f32x16 __attribute__((ext_vector_type(16)));
constexpr int SSM_IMG_ROW = 272, SSM_IMG = 16 * SSM_IMG_ROW, SSM_YBUF = 8192, SSM_WAVE_LDS = 2 * SSM_IMG + SSM_YBUF;
__device__ __forceinline__ float gelu_fast(float v) { const float u = 0.7978845608028654f * (v + 0.044715f * v * v * v); return v * __builtin_amdgcn_rcpf(1.f + __builtin_amdgcn_exp2f(-2.8853900817779268f * u)); }
struct SsmItem {
    f32x2 alo, ahi; const s16x8* BB; const s16x8* CM; unsigned fo; f32x4 dd4; unsigned uo; int ustep; const bf16_t* U; bf16_t* Z; int t0, g, hh;
    LAS unsigned char* img; LAS unsigned char* ybuf; int nn, half, ti, cq;
};
template <int MODE>
__device__ __forceinline__ void ssm_tile(const SsmItem& S, int tau, f32x16 (&acur)[4], f32x16 (&anxt)[4], const s16x8& ux, s16x8& uy, f32x2& hlo, f32x2& hhi, u32x2& uf4n, u32x2& ub4n, s16x8 (&bfw)[4], s16x8 (&bbw)[4]) {
    const u32x2 uf4 = uf4n, ub4 = ub4n;
    if (tau + 2 < 16) uy = *(const s16x8*)(S.U + (unsigned)((int)S.uo + (tau + 2) * S.ustep));
    if (MODE == 1 && tau >= 7 && tau < 15) {
        uf4n = *(const u32x2*)(S.U + (unsigned)((S.t0 + 16 * (tau + 1) + S.ti) * D + 16 * S.g + 4 * S.cq));
        ub4n = *(const u32x2*)(S.U + (unsigned)((S.t0 + 255 - 16 * (tau + 1) - S.ti) * D + 16 * S.g + 4 * S.cq)); }
    if (tau + 1 < 16) {
        const s16x8 z8 = {0, 0, 0, 0, 0, 0, 0, 0};
        const s16x8 uf = S.hh ? z8 : ux, ub = S.hh ? ux : z8;
#pragma unroll
        for (int q = 0; q < 4; ++q) { anxt[q] = __builtin_amdgcn_mfma_f32_32x32x16_bf16(uf, bfw[q], (f32x16){0.f}, 0, 0, 0); anxt[q] = __builtin_amdgcn_mfma_f32_32x32x16_bf16(ub, bbw[q], anxt[q], 0, 0, 0); }
    }
    const f32x2 alo = S.alo, ahi = S.ahi;
    s16x8 cfw[4], cbw[4];
#pragma unroll
    for (int i = 0; i < 16; ++i) {
        float lr = __builtin_fmaf(alo.x, hlo.x, __builtin_fmaf(-alo.y, hlo.y, acur[0][i])); asm volatile("" : "+v"(lr));
        float li = __builtin_fmaf(alo.x, hlo.y, __builtin_fmaf(alo.y, hlo.x, acur[2][i])); asm volatile("" : "+v"(li));
        float hr = __builtin_fmaf(ahi.x, hhi.x, __builtin_fmaf(-ahi.y, hhi.y, acur[1][i])); asm volatile("" : "+v"(hr));
        float hi2 = __builtin_fmaf(ahi.x, hhi.y, __builtin_fmaf(ahi.y, hhi.x, acur[3][i])); asm volatile("" : "+v"(hi2));
        hlo = (f32x2){lr, li}; hhi = (f32x2){hr, hi2};
        if (MODE == 1) { u32x2 w; w.x = pk2(lr, li); w.y = pk2(hr, hi2); *(LAS u32x2*)(S.img + S.half * SSM_IMG + i * SSM_IMG_ROW + S.nn * 8) = w; }
        if (MODE == 1 && i == 11 && tau + 2 < 16) {
            asm volatile("" ::: "memory");
#pragma unroll
            for (int q = 0; q < 4; ++q) { bfw[q] = S.BB[S.fo + q * 64]; bbw[q] = S.BB[S.fo + 32768u + q * 64]; }
        }
        if (MODE == 1 && i == 7) {
            asm volatile("" ::: "memory");
#pragma unroll
            for (int q = 0; q < 4; ++q) { cfw[q] = S.CM[S.fo + q * 64]; cbw[q] = S.CM[S.fo + 32768u + q * 64]; }
        }
    }
    if (MODE == 1) {
        const int ti = S.ti, cq = S.cq, g = S.g, t0 = S.t0;
        asm volatile("" ::: "memory");
        f32x4 y0 = {0.f, 0.f, 0.f, 0.f}, y1 = {0.f, 0.f, 0.f, 0.f};
#pragma unroll
        for (int s = 0; s < 4; ++s) {
            const s16x8 b0 = *(const LAS s16x8*)(S.img + ti * SSM_IMG_ROW + 64 * s + 16 * cq), b1 = *(const LAS s16x8*)(S.img + SSM_IMG + ti * SSM_IMG_ROW + 64 * s + 16 * cq);
            y0 = __builtin_amdgcn_mfma_f32_16x16x32_bf16(cfw[s], b0, y0, 0, 0, 0); y1 = __builtin_amdgcn_mfma_f32_16x16x32_bf16(cbw[s], b1, y1, 0, 0, 0);
        }
        asm volatile("s_nop 15\n\ts_nop 7" : "+v"(y0), "+v"(y1) :: "memory");
        LAS unsigned char* af = S.ybuf + tau * 512 + ti * 32 + 8 * cq; LAS unsigned char* ab = S.ybuf + (15 - tau) * 512 + (15 - ti) * 32 + 8 * cq;
        if (tau < 8) {
            u32x2 w; w.x = pk2(y0[0], y0[1]); w.y = pk2(y0[2], y0[3]); *(LAS u32x2*)af = w;
            w.x = pk2(y1[0], y1[1]); w.y = pk2(y1[2], y1[3]); *(LAS u32x2*)ab = w;
        } else {
            const u32x2 sf = *(const LAS u32x2*)af, sb = *(const LAS u32x2*)ab;
            const unsigned tokf = (unsigned)(t0 + 16 * tau + ti), tokb = (unsigned)(t0 + 255 - 16 * tau - ti);
            f32x4 tf = y0 + (f32x4){__uint_as_float(sf.x << 16), __uint_as_float(sf.x & 0xffff0000u), __uint_as_float(sf.y << 16), __uint_as_float(sf.y & 0xffff0000u)};
            f32x4 tb = y1 + (f32x4){__uint_as_float(sb.x << 16), __uint_as_float(sb.x & 0xffff0000u), __uint_as_float(sb.y << 16), __uint_as_float(sb.y & 0xffff0000u)};
            tf = tf + S.dd4 * (f32x4){__uint_as_float(uf4.x << 16), __uint_as_float(uf4.x & 0xffff0000u), __uint_as_float(uf4.y << 16), __uint_as_float(uf4.y & 0xffff0000u)};
            tb = tb + S.dd4 * (f32x4){__uint_as_float(ub4.x << 16), __uint_as_float(ub4.x & 0xffff0000u), __uint_as_float(ub4.y << 16), __uint_as_float(ub4.y & 0xffff0000u)};
            u32x2 w; w.x = pk2(gelu_fast(tf[0]), gelu_fast(tf[1])); w.y = pk2(gelu_fast(tf[2]), gelu_fast(tf[3])); *(u32x2*)(S.Z + (tokf * D + 16 * g + 4 * cq)) = w;
            w.x = pk2(gelu_fast(tb[0]), gelu_fast(tb[1])); w.y = pk2(gelu_fast(tb[2]), gelu_fast(tb[3])); *(u32x2*)(S.Z + (tokb * D + 16 * g + 4 * cq)) = w;
        }
        asm volatile("" ::: "memory");
    }
}
template <int MODE  >
__device__ __forceinline__ void ph_ssm_scan(const CP& p, LAS unsigned char* L, int lane, int wave, const bf16_t* U, bf16_t* Z) {
    const int gw = blockIdx.x * NWAVES + wave, NGW = gridDim.x * NWAVES;
    const f32x2* ABAR = (const f32x2*)(p.ws + WS_ABAR); const f32x2* SST = (const f32x2*)(p.ws + WS_SST);
    const s16x8* BBAR = (const s16x8*)(p.ws + WS_BBAR); const s16x8* CMAT = (const s16x8*)(p.ws + WS_CMAT);
    constexpr int NITEMS = (MODE == 0 ? 32 : 64) * 128;
    SsmItem S;
    S.img = L + RING_OFF + wave * SSM_WAVE_LDS; S.ybuf = S.img + 2 * SSM_IMG;
    S.nn = lane & 31; S.half = lane >> 5; S.ti = lane & 15; S.cq = lane >> 4; S.U = U; S.Z = Z;
    const int nn = S.nn, half = S.half;
#pragma unroll 1
    for (int it = gw; it < NITEMS; it += NGW) {
        const int g = it & 127, ci = it >> 7;
        const bool samp = (MODE == 0) || ci >= 32; const int sc = (MODE == 0) ? ci : ci - 32;
        const int t0 = samp ? MP + sc * 256 : ci * 256;
        const int pidx = (half * 128 + g) * 64;
        S.g = g; S.t0 = t0;
        S.alo = ABAR[pidx + nn]; S.ahi = ABAR[pidx + nn + 32];
        S.BB = BBAR; S.CM = CMAT; S.fo = (unsigned)(g * 256 + lane);
        s16x8 bfw[4], bbw[4];
#pragma unroll
        for (int q = 0; q < 4; ++q) { bfw[q] = BBAR[S.fo + q * 64]; bbw[q] = BBAR[S.fo + 32768u + q * 64]; }
        f32x2 hlo = {0.f, 0.f}, hhi = {0.f, 0.f};
        if (MODE == 1 && samp) {
            const int bq = sc >> 4, cq2 = sc & 15; const f32x2* A256 = (const f32x2*)(p.ws + WS_A256);
            const f32x2 qlo = A256[pidx + nn], qhi = A256[pidx + nn + 32];
            const float* st = p.state_ssm + ((size_t)(bq * 2 + half) * 128 + g) * 128;
            hlo = (f32x2){st[2 * nn], st[2 * nn + 1]}; hhi = (f32x2){st[2 * nn + 64], st[2 * nn + 65]};
            const int nst = half ? 15 - cq2 : cq2;
            f32x2 s0[15], s1[15];
#pragma unroll
            for (int k = 0; k < 15; ++k) { const int j = half ? 15 - k : k; const size_t o = ((size_t)((bq * 16 + j) * 2 + half) * 128 + g) * 64; s0[k] = SST[o + nn]; s1[k] = SST[o + nn + 32]; }
#pragma unroll
            for (int k = 0; k < 15; ++k) {
                const f32x2 nl = {qlo.x * hlo.x - qlo.y * hlo.y + s0[k].x, qlo.x * hlo.y + qlo.y * hlo.x + s0[k].y};
                const f32x2 nh = {qhi.x * hhi.x - qhi.y * hhi.y + s1[k].x, qhi.x * hhi.y + qhi.y * hhi.x + s1[k].y};
                hlo = (k < nst) ? nl : hlo; hhi = (k < nst) ? nh : hhi;
            }
        }
        const int r = lane & 31, hh = (r >> 2) & 1, si = 4 * (r >> 3) + (r & 3);
        S.hh = hh;
        S.uo = (unsigned)((hh ? t0 + 255 - si : t0 + si) * D + 16 * g + 8 * (lane >> 5));
        S.ustep = hh ? -16 * D : 16 * D;
        S.dd4 = *(const f32x4*)(p.ssm_d + 16 * g + 4 * S.cq);
        const s16x8 u0 = *(const s16x8*)(U + S.uo); s16x8 uX = *(const s16x8*)(U + (unsigned)((int)S.uo + S.ustep)), uY = uX;
        u32x2 uf4n = {0u, 0u}, ub4n = {0u, 0u};
        f32x16 accA[4], accB[4];
        { const s16x8 z8 = {0, 0, 0, 0, 0, 0, 0, 0}; const s16x8 uf = hh ? z8 : u0, ub = hh ? u0 : z8;
#pragma unroll
          for (int q = 0; q < 4; ++q) { accA[q] = __builtin_amdgcn_mfma_f32_32x32x16_bf16(uf, bfw[q], (f32x16){0.f}, 0, 0, 0); accA[q] = __builtin_amdgcn_mfma_f32_32x32x16_bf16(ub, bbw[q], accA[q], 0, 0, 0); } }
#pragma unroll 1
        for (int tau = 0; tau < 16; tau += 2) {
            ssm_tile<MODE>(S, tau, accA, accB, uX, uY, hlo, hhi, uf4n, ub4n, bfw, bbw);
            ssm_tile<MODE>(S, tau + 1, accB, accA, uY, uX, hlo, hhi, uf4n, ub4n, bfw, bbw);
        }
        if (MODE == 0) { f32x2* o = (f32x2*)(p.ws + WS_SST) + ((size_t)(sc * 2 + half) * 128 + g) * 64; o[nn] = hlo; o[nn + 32] = hhi; }
        else if (!samp) { f32x2* o = (f32x2*)(p.out + OUT_ST) + ((size_t)(ci * 2 + half) * 128 + g) * 64; o[nn] = hlo; o[nn + 32] = hhi; }
    }
}
__device__ __forceinline__ void ph_ssm_state4(const CP& p, int lane, int wave, const bf16_t* U) {
    const int gw = blockIdx.x * NWAVES + wave, NGW = gridDim.x * NWAVES;
    const int nn = lane & 31, half = lane >> 5;
    const f32x2* A4 = (const f32x2*)(p.ws + WS_A4); const s16x8* BB4 = (const s16x8*)(p.ws + WS_BB4);
    const int r = lane & 31, hh = (r >> 2) & 1, sg = 4 * (r >> 3) + (r & 3);
    int gcur = -1; s16x8 bf4[4][4], bb4[4][4]; f32x2 alo = {0.f, 0.f}, ahi = {0.f, 0.f};
#pragma unroll 1
    for (int it = gw; it < 32 * 128; it += NGW) {
        const int g = it & 127, sc = it >> 7, t0 = MP + sc * 256;
        if (g != gcur) {
#pragma unroll
            for (int j = 0; j < 4; ++j)
#pragma unroll
                for (int q = 0; q < 4; ++q) { bf4[j][q] = BB4[((size_t)(j * 256 + g) * 4 + q) * 64 + lane]; bb4[j][q] = BB4[((size_t)(j * 256 + 128 + g) * 4 + q) * 64 + lane]; }
            const int pidx = (half * 128 + g) * 64; alo = A4[pidx + nn]; ahi = A4[pidx + nn + 32]; gcur = g;
        }
        const bf16_t* ua = U + ((size_t)(t0 >> 8) * 128 + g) * 4096 + (hh ? 255 - 4 * sg : 4 * sg) * 16 + 8 * (lane >> 5);
        const long js = hh ? -16L : 16L;
        s16x8 u[4];
#pragma unroll
        for (int j = 0; j < 4; ++j) u[j] = *(const s16x8*)(ua + j * js);
        f32x2 hlo = {0.f, 0.f}, hhi = {0.f, 0.f};
#pragma unroll 1
        for (int m = 0; m < 4; ++m) {
            f32x16 acc[4]; const s16x8 z8 = {0, 0, 0, 0, 0, 0, 0, 0};
#pragma unroll
            for (int j = 0; j < 4; ++j) { const s16x8 uf = hh ? z8 : u[j], ub = hh ? u[j] : z8;
#pragma unroll
                for (int q = 0; q < 4; ++q) {
                    if (j == 0) acc[q] = __builtin_amdgcn_mfma_f32_32x32x16_bf16(uf, bf4[j][q], (f32x16){0.f}, 0, 0, 0); else acc[q] = __builtin_amdgcn_mfma_f32_32x32x16_bf16(uf, bf4[j][q], acc[q], 0, 0, 0);
                    acc[q] = __builtin_amdgcn_mfma_f32_32x32x16_bf16(ub, bb4[j][q], acc[q], 0, 0, 0); } }
            const long mo = (long)(m + 1 < 4 ? m + 1 : 3) * 64 * js;
#pragma unroll
            for (int j = 0; j < 4; ++j) u[j] = *(const s16x8*)(ua + mo + j * js);
#pragma unroll
            for (int i = 0; i < 16; ++i) {
                float lr = __builtin_fmaf(alo.x, hlo.x, __builtin_fmaf(-alo.y, hlo.y, acc[0][i])); asm volatile("" : "+v"(lr));
                float li = __builtin_fmaf(alo.x, hlo.y, __builtin_fmaf(alo.y, hlo.x, acc[2][i])); asm volatile("" : "+v"(li));
                float hr = __builtin_fmaf(ahi.x, hhi.x, __builtin_fmaf(-ahi.y, hhi.y, acc[1][i])); asm volatile("" : "+v"(hr));
                float hi2 = __builtin_fmaf(ahi.x, hhi.y, __builtin_fmaf(ahi.y, hhi.x, acc[3][i])); asm volatile("" : "+v"(hi2));
                hlo = (f32x2){lr, li}; hhi = (f32x2){hr, hi2};
            }
        }
        f32x2* o = (f32x2*)(p.ws + WS_SST) + ((size_t)(sc * 2 + half) * 128 + g) * 64; o[nn] = hlo; o[nn + 32] = hhi;
    }
}
__device__ __forceinline__ void ssm_tables4(const CP& p, LAS unsigned char* L, int tid, int gw, int NGW, int lane) {
    for (int i2 = gw * 64 + lane; i2 < 2 * 128 * 64 * 16; i2 += NGW * 64) {
        const int c = i2 & 15, i = i2 >> 4, n = i & 63, kg = i >> 6;
        const f32x2 ab = ((const f32x2*)(p.ws + WS_ABAR))[i]; const float abr = ab.x, abi = ab.y;
        const float c_re = p.ssm_c_re[((size_t)kg * 16 + c) * 64 + n], c_im = p.ssm_c_im[((size_t)kg * 16 + c) * 64 + n];
        const int nn = n & 31, nh = n >> 5, K0 = 4 * nn + 2 * nh;
        float pr = abr, pi_ = abi;
#pragma unroll
        for (int j = 0; j < 4; ++j) {
            bf16_t* cj = (bf16_t*)(p.ws + WS_CJ) + ((size_t)j * 256 + kg) * 4 * 512;
            const float e_r = c_re * pr - c_im * pi_, e_i = c_re * pi_ + c_im * pr;
            { const int K = K0, s = K >> 5, l2 = c + 16 * ((K & 31) >> 3), jj = K & 7; cj[s * 512 + l2 * 8 + jj] = (bf16_t)f2bf(e_r); }
            { const int K = K0 + 1, s = K >> 5, l2 = c + 16 * ((K & 31) >> 3), jj = K & 7; cj[s * 512 + l2 * 8 + jj] = (bf16_t)f2bf(-e_i); }
            const float t = pr * abr - pi_ * abi; pi_ = pr * abi + pi_ * abr; pr = t;
        }
    }
    LAS float* sA = (LAS float*)(L + RING_OFF); LAS float* sB = sA + 128; LAS float* sC = sB + 2048;
    for (int kg = (int)blockIdx.x; kg < 256; kg += (int)gridDim.x) {
        __syncthreads();
        for (int e = tid; e < 1024; e += NWAVES * 64) { const int n = e >> 4, c = e & 15, i = kg * 64 + n;
            const float are = p.ssm_a_re[i], aim = p.ssm_a_im[i]; const f32x2 ab = ((const f32x2*)(p.ws + WS_ABAR))[i]; const float abr = ab.x, abi = ab.y;
            const float nr = abr - 1.f, ni = abi, den = are * are + aim * aim; const float cr = (nr * are + ni * aim) / den, ci = (ni * are - nr * aim) / den;
            const float br = p.ssm_b_re[(size_t)i * 16 + c], bi = p.ssm_b_im[(size_t)i * 16 + c];
            sB[2 * e] = cr * br - ci * bi; sB[2 * e + 1] = cr * bi + ci * br;
            if (c == 0) { sA[2 * n] = abr; sA[2 * n + 1] = abi; } }
        for (int e = tid; e < 1024; e += NWAVES * 64) { sC[2 * e] = p.ssm_c_re[(size_t)kg * 1024 + e]; sC[2 * e + 1] = p.ssm_c_im[(size_t)kg * 1024 + e]; }
        __syncthreads();
        if (tid < 256) {
            const int cp = tid >> 4, c = tid & 15;
            float k0 = 0.f, k1 = 0.f, k2 = 0.f, k3 = 0.f;
#pragma unroll 8
            for (int n = 0; n < 64; ++n) {
                const float abr = sA[2 * n], abi = sA[2 * n + 1], bbr = sB[2 * (n * 16 + c)], bbi = sB[2 * (n * 16 + c) + 1], c_re = sC[2 * (cp * 64 + n)], c_im = sC[2 * (cp * 64 + n) + 1];
                float zr = c_re * bbr - c_im * bbi, zi = c_re * bbi + c_im * bbr, t;
                k0 += zr; t = zr * abr - zi * abi; zi = zr * abi + zi * abr; zr = t;
                k1 += zr; t = zr * abr - zi * abi; zi = zr * abi + zi * abr; zr = t;
                k2 += zr; t = zr * abr - zi * abi; zi = zr * abi + zi * abr; zr = t;
                k3 += zr;
            }
            if (kg < 128 && cp == c) k0 += p.ssm_d[16 * kg + c];
            bf16_t* kc = (bf16_t*)(p.ws + WS_KC) + (size_t)kg * 4 * 512;
            const int e0 = (cp + 16 * (0 * 2 + (c >> 3))) * 8 + (c & 7), e1 = (cp + 16 * (1 * 2 + (c >> 3))) * 8 + (c & 7);
            kc[0 * 512 + e0] = (bf16_t)f2bf(k0); kc[0 * 512 + e1] = 0;
            kc[1 * 512 + e0] = (bf16_t)f2bf(k1); kc[1 * 512 + e1] = (bf16_t)f2bf(k0);
            kc[2 * 512 + e0] = (bf16_t)f2bf(k2); kc[2 * 512 + e1] = (bf16_t)f2bf(k1);
            kc[3 * 512 + e0] = (bf16_t)f2bf(k3); kc[3 * 512 + e1] = (bf16_t)f2bf(k2);
        }
    }
    __syncthreads();
}
__device__ __forceinline__ void ph_ssm_out4(const CP& p, LAS unsigned char* L, int lane, int wave, const bf16_t* U, bf16_t* Z) {
    LAS unsigned char* TB = L + RING_OFF;
    LAS unsigned char* img = L + RING_OFF + 73728 + wave * (2 * SSM_IMG);
    const int nn = lane & 31, half = lane >> 5, ti = lane & 15, cq = lane >> 4;
    const int r = lane & 31, hh = (r >> 2) & 1, sg = 4 * (r >> 3) + (r & 3);
    const int tb_ = (int)(size_t)TB + lane * 16;
    const int tk_ = tb_ + 65536;
    const f32x2* A4 = (const f32x2*)(p.ws + WS_A4); const f32x2* SST = (const f32x2*)(p.ws + WS_SST);
    const s16x8* BB4 = (const s16x8*)(p.ws + WS_BB4); const s16x8* CJ = (const s16x8*)(p.ws + WS_CJ); const s16x8* KC = (const s16x8*)(p.ws + WS_KC);
    const int Gq = (int)gridDim.x, cb_ = (int)blockIdx.x, vcu = (Gq % 8 == 0) ? (cb_ % 8) * (Gq / 8) + cb_ / 8 : cb_;
#pragma unroll 1
    for (int u_ = vcu; u_ < 256; u_ += Gq) {
        const int g = u_ >> 1, hsel = u_ & 1;
        __syncthreads();
        for (int f = wave; f < 64; f += NWAVES) { const int isC = f >> 5, dir = (f >> 4) & 1, j = (f >> 2) & 3, q = f & 3;
            const s16x8* src = (isC ? CJ : BB4) + ((size_t)(j * 256 + dir * 128 + g) * 4 + q) * 64 + lane;
            *(LAS s16x8*)(TB + f * 1024 + lane * 16) = *src; }
        { const int f = wave;
          *(LAS s16x8*)(TB + 65536 + f * 1024 + lane * 16) = KC[((size_t)((f >> 2) * 128 + g) * 4 + (f & 3)) * 64 + lane]; }
        __syncthreads();
        const int pidx = (half * 128 + g) * 64;
        const f32x2 alo = A4[pidx + nn], ahi = A4[pidx + nn + 32];
#pragma unroll 1
        for (int k = 0; k < 4; ++k) {
            const int ci = hsel * 32 + wave * 4 + k;
            const bool samp = ci >= 32; const int sc = ci - 32;
            const int t0 = samp ? MP + sc * 256 : ci * 256;
            f32x2 hlo = {0.f, 0.f}, hhi = {0.f, 0.f};
            if (samp) {
                const int bq = sc >> 4, cq2 = sc & 15; const f32x2* A256 = (const f32x2*)(p.ws + WS_A256);
                const f32x2 qlo = A256[pidx + nn], qhi = A256[pidx + nn + 32];
                const float* st = p.state_ssm + ((size_t)(bq * 2 + half) * 128 + g) * 128;
                hlo = (f32x2){st[2 * nn], st[2 * nn + 1]}; hhi = (f32x2){st[2 * nn + 64], st[2 * nn + 65]};
                const int nst = half ? 15 - cq2 : cq2;
                f32x2 s0[15], s1[15];
#pragma unroll
                for (int kk = 0; kk < 15; ++kk) { const int jx = half ? 15 - kk : kk; const size_t o = ((size_t)((bq * 16 + jx) * 2 + half) * 128 + g) * 64; s0[kk] = SST[o + nn]; s1[kk] = SST[o + nn + 32]; }
#pragma unroll
                for (int kk = 0; kk < 15; ++kk) {
                    const f32x2 nl = {qlo.x * hlo.x - qlo.y * hlo.y + s0[kk].x, qlo.x * hlo.y + qlo.y * hlo.x + s0[kk].y};
                    const f32x2 nh2 = {qhi.x * hhi.x - qhi.y * hhi.y + s1[kk].x, qhi.x * hhi.y + qhi.y * hhi.x + s1[kk].y};
                    hlo = (kk < nst) ? nl : hlo; hhi = (kk < nst) ? nh2 : hhi;
                }
            }
            const unsigned gb = (unsigned)(((t0 >> 8) * 128 + g) * 4096);
            const unsigned uo = gb + (unsigned)((hh ? 255 - 4 * sg : 4 * sg) * 16 + 8 * (lane >> 5));
            const int js = hh ? -16 : 16;
            const unsigned vfo = gb + (unsigned)((4 * ti + (cq >> 1)) * 16 + 8 * (cq & 1));
            const unsigned vbo = gb + (unsigned)((255 - 4 * ti - (cq >> 1)) * 16 + 8 * (cq & 1));
            bf16_t* park = (bf16_t*)(p.ws + WS_PARK) + ((size_t)ci * 128 + g) * 4096;
            s16x8 u[4];
#pragma unroll
            for (int j = 0; j < 4; ++j) u[j] = *(const s16x8*)(U + (unsigned)((int)uo + j * js));
            s16x8 w01f = *(const s16x8*)(U + vfo), w23f = *(const s16x8*)(U + (vfo + 32u)), w01b = *(const s16x8*)(U + vbo), w23b = *(const s16x8*)(U + (vbo - 32u));
#pragma unroll 1
            for (int m = 0; m < 4; ++m) {
                u32x2 pkf[4], pkb[4];
                int lz = lane; asm volatile("" : "+v"(lz));
                const int tiz = lz & 15, cqz = lz >> 4;
                const unsigned pf0 = (unsigned)((64 * m + 4 * tiz) * 16 + 4 * cqz), pb0 = (unsigned)((255 - 64 * m - 4 * tiz) * 16 + 4 * cqz);
                const unsigned zf0 = gb + (unsigned)((64 * m + 4 * tiz) * 16 + 4 * cqz), zb0 = gb + (unsigned)((255 - 64 * m - 4 * tiz) * 16 + 4 * cqz);

                f32x16 acc[4]; const s16x8 z8 = {0, 0, 0, 0, 0, 0, 0, 0};
                s16x8 tfr[4], tbr[4], ufc = z8, ubc = z8;
#define S4RD(SLOT_, P_) do { tfr[SLOT_] = att::rd128<(P_) * 1024>(tb_); tbr[SLOT_] = att::rd128<16384 + (P_) * 1024>(tb_); } while (0)
#define S4STEP(P_, W_) do { if (((P_) & 3) == 0) { ufc = hh ? z8 : u[(P_) >> 2]; ubc = hh ? u[(P_) >> 2] : z8; } LGKM(W_); SBAR();                                                       \
        if ((P_) < 4) acc[(P_) & 3] = __builtin_amdgcn_mfma_f32_32x32x16_bf16(ufc, tfr[(P_) & 3], (f32x16){0.f}, 0, 0, 0); else acc[(P_) & 3] = __builtin_amdgcn_mfma_f32_32x32x16_bf16(ufc, tfr[(P_) & 3], acc[(P_) & 3], 0, 0, 0); \
        acc[(P_) & 3] = __builtin_amdgcn_mfma_f32_32x32x16_bf16(ubc, tbr[(P_) & 3], acc[(P_) & 3], 0, 0, 0); SBAR(); if constexpr ((P_) + 4 < 16) S4RD((P_) & 3, ((P_) + 4) & 15); } while (0)
                SBAR(); S4RD(0, 0); S4RD(1, 1); S4RD(2, 2); S4RD(3, 3);
                S4STEP(0, 6); S4STEP(1, 6); S4STEP(2, 6); S4STEP(3, 6); S4STEP(4, 6); S4STEP(5, 6); S4STEP(6, 6); S4STEP(7, 6);
                S4STEP(8, 6); S4STEP(9, 6); S4STEP(10, 6); S4STEP(11, 6); S4STEP(12, 6); S4STEP(13, 4); S4STEP(14, 2); S4STEP(15, 0);
#undef S4RD
#undef S4STEP
                if (m == 2) asm volatile("s_waitcnt vmcnt(0)" ::: "memory");
                if (m >= 2) {
#pragma unroll
                    for (int j = 0; j < 4; ++j) { pkf[j] = *(const u32x2*)(park + (pf0 + 16u * j)); pkb[j] = *(const u32x2*)(park + (pb0 - 16u * j)); }
                }
#define CJRD(F_, B_, J_) do { F_[0] = att::rd128<32768 + ((J_) * 4 + 0) * 1024>(tb_); B_[0] = att::rd128<32768 + ((4 + (J_)) * 4 + 0) * 1024>(tb_); F_[1] = att::rd128<32768 + ((J_) * 4 + 1) * 1024>(tb_); B_[1] = att::rd128<32768 + ((4 + (J_)) * 4 + 1) * 1024>(tb_); \
        F_[2] = att::rd128<32768 + ((J_) * 4 + 2) * 1024>(tb_); B_[2] = att::rd128<32768 + ((4 + (J_)) * 4 + 2) * 1024>(tb_); F_[3] = att::rd128<32768 + ((J_) * 4 + 3) * 1024>(tb_); B_[3] = att::rd128<32768 + ((4 + (J_)) * 4 + 3) * 1024>(tb_); } while (0)
                const int mn = m + 1 < 4 ? m + 1 : 3;
#pragma unroll
                for (int j = 0; j < 4; ++j) u[j] = *(const s16x8*)(U + (unsigned)((int)uo + (mn * 64 + j) * js));
#pragma unroll
                for (int i = 0; i < 16; ++i) {
                    { u32x2 w; w.x = pk2(hlo.x, hlo.y); w.y = pk2(hhi.x, hhi.y); *(LAS u32x2*)(img + half * SSM_IMG + i * SSM_IMG_ROW + nn * 8) = w; }
                    float lr = __builtin_fmaf(alo.x, hlo.x, __builtin_fmaf(-alo.y, hlo.y, acc[0][i])); asm volatile("" : "+v"(lr));
                    float li = __builtin_fmaf(alo.x, hlo.y, __builtin_fmaf(alo.y, hlo.x, acc[2][i])); asm volatile("" : "+v"(li));
                    float hr = __builtin_fmaf(ahi.x, hhi.x, __builtin_fmaf(-ahi.y, hhi.y, acc[1][i])); asm volatile("" : "+v"(hr));
                    float hi2 = __builtin_fmaf(ahi.x, hhi.y, __builtin_fmaf(ahi.y, hhi.x, acc[3][i])); asm volatile("" : "+v"(hi2));
                    hlo = (f32x2){lr, li}; hhi = (f32x2){hr, hi2};
                }
                asm volatile("" ::: "memory");
                s16x8 b0[4], b1[4]; s16x8 cfa[4], cba[4], kfa, kba, kfc, kbc;
#pragma unroll
                for (int s = 0; s < 4; ++s) { b0[s] = *(const LAS s16x8*)(img + ti * SSM_IMG_ROW + 64 * s + 16 * cq); b1[s] = *(const LAS s16x8*)(img + SSM_IMG + ti * SSM_IMG_ROW + 64 * s + 16 * cq); }
#define KJRD(J_) do { kfa = att::rd128<(J_) * 1024>(tk_); kba = att::rd128<(4 + (J_)) * 1024>(tk_); if constexpr ((J_) >= 2) { kfc = att::rd128<(((J_) - 2) & 3) * 1024>(tk_); kbc = att::rd128<(4 + (((J_) - 2) & 3)) * 1024>(tk_); } } while (0)
                SBAR(); CJRD(cfa, cba, 0); KJRD(0); SBAR();
#pragma unroll
                for (int j = 0; j < 4; ++j) {
                    f32x4 y0 = {0.f, 0.f, 0.f, 0.f}, y1 = {0.f, 0.f, 0.f, 0.f};
                    SBAR();
                    LGKM(0); SBAR();
#pragma unroll
                    for (int s = 0; s < 4; ++s) { y0 = __builtin_amdgcn_mfma_f32_16x16x32_bf16(cfa[s], b0[s], y0, 0, 0, 0); y1 = __builtin_amdgcn_mfma_f32_16x16x32_bf16(cba[s], b1[s], y1, 0, 0, 0); }
                    SBAR();
                    y0 = __builtin_amdgcn_mfma_f32_16x16x32_bf16(kfa, w01f, y0, 0, 0, 0); y1 = __builtin_amdgcn_mfma_f32_16x16x32_bf16(kba, w01b, y1, 0, 0, 0);
                    if (j >= 2) { y0 = __builtin_amdgcn_mfma_f32_16x16x32_bf16(kfc, w23f, y0, 0, 0, 0); y1 = __builtin_amdgcn_mfma_f32_16x16x32_bf16(kbc, w23b, y1, 0, 0, 0); }
                    SBAR();
                    if (j == 0) { CJRD(cfa, cba, 1); KJRD(1); } else if (j == 1) { CJRD(cfa, cba, 2); KJRD(2); } else if (j == 2) { CJRD(cfa, cba, 3); KJRD(3); }
                    SBAR();
                    asm volatile("s_nop 15\n\ts_nop 7" : "+v"(y0), "+v"(y1) :: "memory");
                    if (m < 2) {
                        u32x2 w; w.x = pk2(y0[0], y0[1]); w.y = pk2(y0[2], y0[3]); *(u32x2*)(park + (pf0 + 16u * j)) = w;
                        w.x = pk2(y1[0], y1[1]); w.y = pk2(y1[2], y1[3]); *(u32x2*)(park + (pb0 - 16u * j)) = w;
                    } else {
                        const u32x2 sf = pkf[j], sb = pkb[j];
                        const f32x4 tfv = y0 + (f32x4){__uint_as_float(sf.x << 16), __uint_as_float(sf.x & 0xffff0000u), __uint_as_float(sf.y << 16), __uint_as_float(sf.y & 0xffff0000u)};
                        const f32x4 tbv = y1 + (f32x4){__uint_as_float(sb.x << 16), __uint_as_float(sb.x & 0xffff0000u), __uint_as_float(sb.y << 16), __uint_as_float(sb.y & 0xffff0000u)};
                        u32x2 w; w.x = pk2(gelu_fast(tfv[0]), gelu_fast(tfv[1])); w.y = pk2(gelu_fast(tfv[2]), gelu_fast(tfv[3])); *(u32x2*)(Z + (zf0 + (unsigned)(j * 16))) = w;
                        w.x = pk2(gelu_fast(tbv[0]), gelu_fast(tbv[1])); w.y = pk2(gelu_fast(tbv[2]), gelu_fast(tbv[3])); *(u32x2*)(Z + (zb0 - (unsigned)(j * 16))) = w;
                    }
                }
                asm volatile("" ::: "memory");
                w01f = *(const s16x8*)(U + (vfo + (unsigned)(mn * 1024))); w23f = *(const s16x8*)(U + (vfo + (unsigned)(mn * 1024 + 32)));
                w01b = *(const s16x8*)(U + (vbo - (unsigned)(mn * 1024))); w23b = *(const s16x8*)(U + (vbo - (unsigned)(mn * 1024 + 32)));
            }
            if (!samp) { f32x2* o = (f32x2*)(p.out + OUT_ST) + ((size_t)(ci * 2 + half) * 128 + g) * 64; o[nn] = hlo; o[nn + 32] = hhi; }
        }
    }
}
#undef CJRD
#undef KJRD
template <int MODE  >
__device__ __forceinline__ void ph_ssm_scan_np(const CP& p, LAS unsigned char* L, int lane, int wave, const bf16_t* U, bf16_t* Z) {
    const int gw = blockIdx.x * NWAVES + wave, NGW = gridDim.x * NWAVES;
    LAS unsigned char* img = L + RING_OFF + wave * SSM_WAVE_LDS;
    LAS unsigned char* ybuf = img + 2 * SSM_IMG;
    const int nn = lane & 31, half = lane >> 5, ti = lane & 15, cq = lane >> 4;
    const f32x2* ABAR = (const f32x2*)(p.ws + WS_ABAR); const f32x2* SST = (const f32x2*)(p.ws + WS_SST);
    const s16x8* BBAR = (const s16x8*)(p.ws + WS_BBAR); const s16x8* CMAT = (const s16x8*)(p.ws + WS_CMAT);
    constexpr int NITEMS = (MODE == 0 ? 32 : 64) * 128;
#pragma unroll 1
    for (int it = gw; it < NITEMS; it += NGW) {
        const int g = it & 127, ci = it >> 7;
        const bool samp = (MODE == 0) || ci >= 32; const int sc = (MODE == 0) ? ci : ci - 32;
        const int t0 = samp ? MP + sc * 256 : ci * 256;
        const int pidx = (half * 128 + g) * 64;
        const f32x2 alo = ABAR[pidx + nn], ahi = ABAR[pidx + nn + 32];
        s16x8 bfw[4], bbw[4], cfw[4], cbw[4];
#pragma unroll
        for (int q = 0; q < 4; ++q) { bfw[q] = BBAR[((size_t)(0 * 128 + g) * 4 + q) * 64 + lane]; bbw[q] = BBAR[((size_t)(1 * 128 + g) * 4 + q) * 64 + lane]; }
        if (MODE == 1) {
#pragma unroll
            for (int q = 0; q < 4; ++q) { cfw[q] = CMAT[((size_t)(0 * 128 + g) * 4 + q) * 64 + lane]; cbw[q] = CMAT[((size_t)(1 * 128 + g) * 4 + q) * 64 + lane]; }
        }
        f32x2 hlo = {0.f, 0.f}, hhi = {0.f, 0.f};
        if (MODE == 1 && samp) {
            const int bq = sc >> 4, cq2 = sc & 15; const f32x2* A256 = (const f32x2*)(p.ws + WS_A256);
            const f32x2 qlo = A256[pidx + nn], qhi = A256[pidx + nn + 32];
            const float* st = p.state_ssm + ((size_t)(bq * 2 + half) * 128 + g) * 128;
            hlo = (f32x2){st[2 * nn], st[2 * nn + 1]}; hhi = (f32x2){st[2 * nn + 64], st[2 * nn + 65]};
            const int nst = half ? 15 - cq2 : cq2;
            f32x2 s0[15], s1[15];
#pragma unroll
            for (int k = 0; k < 15; ++k) { const int j = half ? 15 - k : k; const size_t o = ((size_t)((bq * 16 + j) * 2 + half) * 128 + g) * 64; s0[k] = SST[o + nn]; s1[k] = SST[o + nn + 32]; }
#pragma unroll
            for (int k = 0; k < 15; ++k) {
                const f32x2 nl = {qlo.x * hlo.x - qlo.y * hlo.y + s0[k].x, qlo.x * hlo.y + qlo.y * hlo.x + s0[k].y};
                const f32x2 nh = {qhi.x * hhi.x - qhi.y * hhi.y + s1[k].x, qhi.x * hhi.y + qhi.y * hhi.x + s1[k].y};
                hlo = (k < nst) ? nl : hlo; hhi = (k < nst) ? nh : hhi;
            }
        }
        const int r = lane & 31, hh = (r >> 2) & 1, si = 4 * (r >> 3) + (r & 3);
        bf16_t* zg = Z + ((size_t)(t0 >> 8) * 128 + g) * 4096;
        const bf16_t* ug = U + ((size_t)(t0 >> 8) * 128 + g) * 4096;
        const bf16_t* ua = ug + (hh ? 255 - si : si) * 16 + 8 * (lane >> 5);
        const long ustep = hh ? -256L : 256L;
        const f32x4 dd4 = *(const f32x4*)(p.ssm_d + 16 * g + 4 * cq);
        const s16x8 z8 = {0, 0, 0, 0, 0, 0, 0, 0};
        s16x8 un = *(const s16x8*)(ua + ustep);
        u32x2 uf4n = {0u, 0u}, ub4n = {0u, 0u};
        f32x16 acc[4];
        { const s16x8 u0 = *(const s16x8*)ua; const s16x8 uf = hh ? z8 : u0, ub = hh ? u0 : z8;
#pragma unroll
          for (int q = 0; q < 4; ++q) { acc[q] = __builtin_amdgcn_mfma_f32_32x32x16_bf16(uf, bfw[q], (f32x16){0.f}, 0, 0, 0); acc[q] = __builtin_amdgcn_mfma_f32_32x32x16_bf16(ub, bbw[q], acc[q], 0, 0, 0); } }
#define SSM_NP_TILE(FIN_) do { \
            const s16x8 uc = un; const u32x2 uf4 = uf4n, ub4 = ub4n; \
            un = *(const s16x8*)(ua + (long)(tau + 2 < 16 ? tau + 2 : 15) * ustep); \
            if (MODE == 1) { const int tn_ = FIN_ ? (tau + 1 < 16 ? tau + 1 : 15) : 8; \
                uf4n = *(const u32x2*)(ug + (16 * tn_ + ti) * 16 + 4 * cq); \
                ub4n = *(const u32x2*)(ug + (255 - 16 * tn_ - ti) * 16 + 4 * cq); } \
_Pragma("unroll") \
            for (int i = 0; i < 16; ++i) { \
                float lr = __builtin_fmaf(alo.x, hlo.x, __builtin_fmaf(-alo.y, hlo.y, acc[0][i])); asm volatile("" : "+v"(lr)); \
                float li = __builtin_fmaf(alo.x, hlo.y, __builtin_fmaf(alo.y, hlo.x, acc[2][i])); asm volatile("" : "+v"(li)); \
                float hr = __builtin_fmaf(ahi.x, hhi.x, __builtin_fmaf(-ahi.y, hhi.y, acc[1][i])); asm volatile("" : "+v"(hr)); \
                float hi2 = __builtin_fmaf(ahi.x, hhi.y, __builtin_fmaf(ahi.y, hhi.x, acc[3][i])); asm volatile("" : "+v"(hi2)); \
                hlo = (f32x2){lr, li}; hhi = (f32x2){hr, hi2}; \
                if (MODE == 1) { u32x2 w; w.x = pk2(lr, li); w.y = pk2(hr, hi2); *(LAS u32x2*)(img + half * SSM_IMG + i * SSM_IMG_ROW + nn * 8) = w; } \
            } \
            if (!FIN_ || tau < 15) { \
                const s16x8 uf = hh ? z8 : uc, ub = hh ? uc : z8; \
_Pragma("unroll") \
                for (int q = 0; q < 4; ++q) { acc[q] = __builtin_amdgcn_mfma_f32_32x32x16_bf16(uf, bfw[q], (f32x16){0.f}, 0, 0, 0); acc[q] = __builtin_amdgcn_mfma_f32_32x32x16_bf16(ub, bbw[q], acc[q], 0, 0, 0); } \
            } \
            if (MODE == 1) { \
                asm volatile("" ::: "memory"); \
                f32x4 y0 = {0.f, 0.f, 0.f, 0.f}, y1 = {0.f, 0.f, 0.f, 0.f}; \
_Pragma("unroll") \
                for (int s = 0; s < 4; ++s) { \
                    const s16x8 b0 = *(const LAS s16x8*)(img + ti * SSM_IMG_ROW + 64 * s + 16 * cq), b1 = *(const LAS s16x8*)(img + SSM_IMG + ti * SSM_IMG_ROW + 64 * s + 16 * cq); \
                    y0 = __builtin_amdgcn_mfma_f32_16x16x32_bf16(cfw[s], b0, y0, 0, 0, 0); y1 = __builtin_amdgcn_mfma_f32_16x16x32_bf16(cbw[s], b1, y1, 0, 0, 0); \
                } \
                asm volatile("s_nop 15\n\ts_nop 7" : "+v"(y0), "+v"(y1) :: "memory"); \
                LAS unsigned char* af = ybuf + tau * 512 + ti * 32 + 8 * cq; LAS unsigned char* ab = ybuf + (15 - tau) * 512 + (15 - ti) * 32 + 8 * cq; \
                if (!FIN_) { \
                    u32x2 w; w.x = pk2(y0[0], y0[1]); w.y = pk2(y0[2], y0[3]); *(LAS u32x2*)af = w; \
                    w.x = pk2(y1[0], y1[1]); w.y = pk2(y1[2], y1[3]); *(LAS u32x2*)ab = w; \
                } else { \
                    const u32x2 sf = *(const LAS u32x2*)af, sb = *(const LAS u32x2*)ab; \
                    const size_t tokf = (size_t)(t0 + 16 * tau + ti), tokb = (size_t)(t0 + 255 - 16 * tau - ti); \
                    f32x4 tf = y0 + (f32x4){__uint_as_float(sf.x << 16), __uint_as_float(sf.x & 0xffff0000u), __uint_as_float(sf.y << 16), __uint_as_float(sf.y & 0xffff0000u)}; \
                    f32x4 tb = y1 + (f32x4){__uint_as_float(sb.x << 16), __uint_as_float(sb.x & 0xffff0000u), __uint_as_float(sb.y << 16), __uint_as_float(sb.y & 0xffff0000u)}; \
                    tf = tf + dd4 * (f32x4){__uint_as_float(uf4.x << 16), __uint_as_float(uf4.x & 0xffff0000u), __uint_as_float(uf4.y << 16), __uint_as_float(uf4.y & 0xffff0000u)}; \
                    tb = tb + dd4 * (f32x4){__uint_as_float(ub4.x << 16), __uint_as_float(ub4.x & 0xffff0000u), __uint_as_float(ub4.y << 16), __uint_as_float(ub4.y & 0xffff0000u)}; \
                    u32x2 w; w.x = pk2(gelu_fast(tf[0]), gelu_fast(tf[1])); w.y = pk2(gelu_fast(tf[2]), gelu_fast(tf[3])); *(u32x2*)(zg + (16 * tau + ti) * 16 + 4 * cq) = w; \
                    w.x = pk2(gelu_fast(tb[0]), gelu_fast(tb[1])); w.y = pk2(gelu_fast(tb[2]), gelu_fast(tb[3])); *(u32x2*)(zg + (255 - 16 * tau - ti) * 16 + 4 * cq) = w; \
                } \
                asm volatile("" ::: "memory"); \
            } \
        } while (0)
#pragma unroll 1
        for (int tau = 0; tau < 8; ++tau) SSM_NP_TILE(false);
#pragma unroll 1
        for (int tau = 8; tau < 16; ++tau) SSM_NP_TILE(true);
#undef SSM_NP_TILE
        if (MODE == 0) { f32x2* o = (f32x2*)(p.ws + WS_SST) + ((size_t)(sc * 2 + half) * 128 + g) * 64; o[nn] = hlo; o[nn + 32] = hhi; }
        else if (!samp) { f32x2* o = (f32x2*)(p.out + OUT_ST) + ((size_t)(ci * 2 + half) * 128 + g) * 64; o[nn] = hlo; o[nn + 32] = hhi; }
    }
}

#ifndef UP_WGM
#define UP_WGM 4
#endif
enum Phase { PH_PRO = 0, PH_XN0, PH_QKV, PH_ATTN, PH_COMBINE, PH_AO, PH_ROW1_0, PH_UP0, PH_DOWN0, PH_ROW2_0, PH_SSMIN, PH_SSMA, PH_SSM, PH_GLU, PH_SO, PH_ROW1_1, PH_UP1, PH_DOWN1, PH_ROW3, PH_N };
__global__ void __launch_bounds__(NWAVES * 64, 2) mk_fwd(Params p_, int ph_lo, int ph_hi, int li) {
    const CP& p = *(const CP*)__builtin_amdgcn_kernarg_segment_ptr();
    extern __shared__ __attribute__((aligned(16))) unsigned char lds[];
    LAS unsigned char* L = (LAS unsigned char*)lds;
    volatile LAS unsigned* MISC = (volatile LAS unsigned*)(L + MISC_OFF);
    const int tid = threadIdx.x, lane = tid & 63, wave = __builtin_amdgcn_readfirstlane(tid >> 6);
    for (int u = tid; u < (LDS_BYTES - LDSCTL_OFF) / 4; u += NWAVES * 64) ((LAS unsigned*)(L + LDSCTL_OFF))[u] = 0u;
    __syncthreads();
    XcdBarrier bar = xcd_barrier_post((unsigned*)(p.ws + WS_CTL) + CW_BAR + li * XCD_BAR_WORDS, MISC + 8);
    unsigned char* ws = p.ws; unsigned char* wb = ws + WS_W;
    bf16_t* A1 = (bf16_t*)(ws + WS_A1); bf16_t* A2 = (bf16_t*)(ws + WS_A2); bf16_t* BIG = (bf16_t*)(ws + WS_BIG);
#define IN(k) (ph_lo <= (k) && (k) < ph_hi)
#define SEAM(k) do { if (IN(k) && IN((k) + 1)) xcd_barrier(bar); } while (0)
    if (IN(PH_PRO)) { ph_prologue(p, L, lane, wave); } SEAM(PH_PRO);
    if (IN(PH_XN0)) { ph_rowop<0>(p, L, tid, lane, wave, 0, nullptr, A1); } SEAM(PH_XN0);
    if (IN(PH_QKV)) { ph_gemm_qkv(p, L, A1, (const bf16_t*)(wb + WO_QKV), lane, wave); } SEAM(PH_QKV);
    if (IN(PH_ATTN)) { ph_attn(p, lds, A1); }
    SEAM(PH_ATTN);
    if (IN(PH_COMBINE)) { ph_combine(p, lane, wave, A1); } SEAM(PH_COMBINE);
    if (IN(PH_AO)) { ph_gemm<0>(L, A1, (const bf16_t*)(wb + WO_AO), D, D, A2, nullptr); } SEAM(PH_AO);
    if (IN(PH_ROW1_0)) { ph_rowop<1>(p, L, tid, lane, wave, 0, A2, A1); } SEAM(PH_ROW1_0);
    if (IN(PH_UP0)) { ph_gemm<1>(L, A1, (const bf16_t*)(wb + WO_W1), DFF, D, BIG, nullptr, UP_WGM); } SEAM(PH_UP0);
    if (IN(PH_DOWN0)) { ph_gemm<0>(L, BIG, (const bf16_t*)(wb + WO_W2), D, DFF, A2, nullptr); } SEAM(PH_DOWN0);
    if (IN(PH_ROW2_0)) { ph_rowop<2>(p, L, tid, lane, wave, 0, A2, A1); } SEAM(PH_ROW2_0);
    if (IN(PH_SSMIN)) { ph_gemm<3>(L, A1, (const bf16_t*)(wb + WO_SI), D, D, A2, nullptr); } SEAM(PH_SSMIN);
    if (IN(PH_SSMA)) { ssm_tables4(p, L, tid, (int)blockIdx.x * NWAVES + wave, (int)gridDim.x * NWAVES, lane); ph_ssm_state4(p, lane, wave, A2); } SEAM(PH_SSMA);
    if (IN(PH_SSM)) { ph_ssm_out4(p, L, lane, wave, A2, A1); }
    SEAM(PH_SSM);
    if (IN(PH_GLU)) { ph_gemm<2>(L, A1, (const bf16_t*)(wb + WO_GL), D, D, A2, A1); } SEAM(PH_GLU);
    if (IN(PH_SO)) { ph_gemm<0>(L, A2, (const bf16_t*)(wb + WO_SO), D, D, A1, nullptr); } SEAM(PH_SO);
    if (IN(PH_ROW1_1)) { ph_rowop<1>(p, L, tid, lane, wave, 1, A1, A2); } SEAM(PH_ROW1_1);
    if (IN(PH_UP1)) { ph_gemm<1>(L, A2, (const bf16_t*)(wb + WO_W1 + 32 * MiB), DFF, D, BIG, nullptr, UP_WGM); } SEAM(PH_UP1);
    if (IN(PH_DOWN1)) { ph_gemm<0>(L, BIG, (const bf16_t*)(wb + WO_W2 + 32 * MiB), D, DFF, A1, nullptr); } SEAM(PH_DOWN1);
    if (IN(PH_ROW3)) { ph_rowop<3>(p, L, tid, lane, wave, 1, A1, nullptr); }
#undef IN
#undef SEAM
}

extern "C" void kernel_launch(void* const* d_in, const int* in_sizes, int n_in, void* d_out, int out_size, void* d_ws, size_t ws_size, hipStream_t stream) {
    static int grid = 0;
    if (grid == 0) {
        if (n_in != 30 || out_size != (int)OUT_END || ws_size < WS_END) { fprintf(stderr, "kernel_launch: unexpected shapes: n_in %d out %d ws %zu (need %zu)\n", n_in, out_size, ws_size, (size_t)WS_END); grid = -1; return; }
        int dev = 0, cus = 0;
        if (hipGetDevice(&dev) != hipSuccess || hipDeviceGetAttribute(&cus, hipDeviceAttributeMultiprocessorCount, dev) != hipSuccess) { grid = -1; return; }
        if (hipFuncSetAttribute((const void*)mk_fwd, hipFuncAttributeMaxDynamicSharedMemorySize, LDS_BYTES) != hipSuccess) { fprintf(stderr, "kernel_launch: hipFuncSetAttribute failed\n"); grid = -1; return; }
        int per_cu = 0;
        if (hipOccupancyMaxActiveBlocksPerMultiprocessor(&per_cu, (const void*)mk_fwd, NWAVES * 64, LDS_BYTES) != hipSuccess || per_cu < 1) fprintf(stderr, "kernel_launch: occupancy query reports %d\n", per_cu);
        (void)hipGetLastError();
        grid = cus;
    }
    if (grid < 0) return;
    Params p{};
    const float** pp = (const float**)&p;
    for (int i = 0; i < 30; ++i) pp[i] = (const float*)d_in[i];
    p.out = (float*)d_out; p.ws = (unsigned char*)d_ws;
    unsigned char* ws = p.ws;
    bf16_t* A1 = (bf16_t*)(ws + WS_A1); bf16_t* A2 = (bf16_t*)(ws + WS_A2); bf16_t* BIG = (bf16_t*)(ws + WS_BIG);
    (void)hipMemsetAsync(ws + WS_CTL, 0, 1 * MiB, stream);
    int li = 0;
#if ONE_PER_PHASE
    for (int ph = PH_PRO; ph < PH_N; ++ph) hipLaunchKernelGGL(mk_fwd, dim3(grid), dim3(NWAVES * 64), LDS_BYTES, stream, p, ph, ph + 1, li++);
#else
    hipLaunchKernelGGL(mk_fwd, dim3(grid), dim3(NWAVES * 64), LDS_BYTES, stream, p, (int)PH_PRO, (int)PH_N, li++);
#endif
    const hipError_t le = hipPeekAtLastError();
    if (le != hipSuccess) fprintf(stderr, "kernel_launch: launch failed: %s\n", hipGetErrorName(le));
}
```
